# Optimizing an MI355X kernel written in HIP

```python
import math
import jax, jax.numpy as jnp
from jax import lax
import numpy as np

D_MODEL = 1024
BATCH = 8
SEQ = 4096
DEPTH = 2

CHUNK = 64
D_FF = 2816
MACARON_WEIGHT = 0.5
RMS_EPS = 1e-6
A_WIDTH = D_MODEL // 2
A_GROUPS = 8
CONV_WIDTH = 3
SB_HEADS = 8
SB_HEAD_DIM = (D_MODEL // 2) // SB_HEADS
B_WIDTH = SB_HEADS * SB_HEAD_DIM
SB_BLOCK = 128
AB_IN_COLS = 3 * A_WIDTH + 3 * B_WIDTH
C_WIDTH = D_MODEL
C_HEAD_DIM = 128
C_HEADS = C_WIDTH // C_HEAD_DIM
C_IN_COLS = 4 * C_WIDTH
N_EVEN = (DEPTH + 1) // 2
N_ODD = DEPTH // 2

kernel_name = "hybrid_shortconv_stickbreak_hgrn2_macaron"


def rms_norm(x, gain):
    x32 = x.astype(jnp.float32)
    y = x32 * lax.rsqrt(jnp.mean(x32 * x32, axis=-1, keepdims=True) + RMS_EPS)
    return (y * gain.astype(jnp.float32)).astype(x.dtype)


def swiglu(h, w_gate, w_up, w_down):
    return (jax.nn.silu(h @ w_gate) * (h @ w_up)) @ w_down


def stick_breaking_attention(q, k, v):
    bsz, nh, s_len, dh = q.shape
    nb = s_len // SB_BLOCK
    scale = 1.0 / math.sqrt(dh)
    qb = jnp.moveaxis(q.reshape(bsz, nh, nb, SB_BLOCK, dh), 2, 0)
    starts = jnp.arange(nb, dtype=jnp.int32) * SB_BLOCK
    kpos = jnp.arange(s_len, dtype=jnp.int32)

    def one_block(args):
        qi, start = args
        qpos = start + jnp.arange(SB_BLOCK, dtype=jnp.int32)
        mask = kpos[None, :] < qpos[:, None]
        z = jnp.einsum('bhqd,bhkd->bhqk', qi, k) * scale
        log_beta = jax.nn.log_sigmoid(z)
        log_keep = jnp.where(mask, jax.nn.log_sigmoid(-z), 0.0)
        later = lax.cumsum(log_keep, axis=3, reverse=True) - log_keep
        w = jnp.where(mask, jnp.exp(log_beta + later), 0.0)
        return jnp.einsum('bhqk,bhkd->bhqd', w, v)

    out = lax.map(one_block, (qb, starts))
    return jnp.moveaxis(out, 0, 2).reshape(bsz, nh, s_len, dh)


def shortconv_stickbreak_mixer(h, w_in, conv_w, w_out):
    bsz, s_len, _ = h.shape
    proj = h @ w_in
    a_b, a_c, a_x, q, k, v = jnp.split(proj, 6, axis=-1)
    u = a_c * a_x
    conv = lax.conv_general_dilated(
        u, conv_w[:, None, :].astype(u.dtype), window_strides=(1,),
        padding=[(CONV_WIDTH - 1, 0)], dimension_numbers=('NWC', 'WIO', 'NWC'),
        feature_group_count=A_WIDTH)
    y_a = a_b * conv
    def heads(t):
        return t.reshape(bsz, s_len, SB_HEADS, SB_HEAD_DIM).transpose(0, 2, 1, 3).astype(jnp.float32)
    y_b = stick_breaking_attention(heads(q), heads(k), heads(v))
    y_b = y_b.transpose(0, 2, 1, 3).reshape(bsz, s_len, B_WIDTH).astype(h.dtype)
    return jnp.concatenate([y_a, y_b], axis=-1) @ w_out


def chunkwise_gated_recurrence(q, log_f, k, v):
    bsz, nh, s_len, dk = q.shape
    dv = v.shape[-1]
    n_chunks = s_len // CHUNK

    def to_chunks(t):
        return jnp.moveaxis(t.reshape(bsz, nh, n_chunks, CHUNK, t.shape[-1]), 2, 0)

    tri = jnp.tril(jnp.ones((CHUNK, CHUNK), dtype=bool))

    def step(state, inp):
        qc, gc, kc, vc = inp
        b = jnp.cumsum(gc, axis=2)
        o_inter = jnp.einsum('bhtk,bhkv->bhtv', qc * jnp.exp(b), state)
        diff = b[:, :, :, None, :] - b[:, :, None, :, :]
        decay = jnp.exp(jnp.where(tri[None, None, :, :, None], diff, -jnp.inf))
        scores = jnp.einsum('bhtk,bhsk,bhtsk->bhts', qc, kc, decay)
        o_intra = jnp.einsum('bhts,bhsv->bhtv', scores, vc)
        b_last = b[:, :, -1:, :]
        new_state = (jnp.exp(b_last[:, :, 0, :])[..., None] * state
                     + jnp.einsum('bhsk,bhsv->bhkv', kc * jnp.exp(b_last - b), vc))
        return new_state, o_inter + o_intra

    state0 = jnp.zeros((bsz, nh, dk, dv), jnp.float32)
    _, out = lax.scan(step, state0, (to_chunks(q), to_chunks(log_f), to_chunks(k), to_chunks(v)))
    return jnp.moveaxis(out, 0, 2).reshape(bsz, nh, s_len, dv)


def hgrn2_mixer(h, w_in, lower_bound, out_norm, w_out):
    bsz, s_len, _ = h.shape
    proj = h @ w_in
    q, f, i, g = jnp.split(proj, 4, axis=-1)
    lb = lower_bound.astype(jnp.float32)
    log_f = jnp.logaddexp(jnp.log(lb), jnp.log1p(-lb) + jax.nn.log_sigmoid(f.astype(jnp.float32)))
    k = -jnp.expm1(log_f)
    q = jax.nn.silu(q.astype(jnp.float32))

    def heads(t):
        return t.reshape(bsz, s_len, C_HEADS, C_HEAD_DIM).transpose(0, 2, 1, 3).astype(jnp.float32)

    o = chunkwise_gated_recurrence(heads(q), heads(log_f), heads(k), heads(i))
    o = o * lax.rsqrt(jnp.mean(o * o, axis=-1, keepdims=True) + RMS_EPS) * out_norm.astype(jnp.float32)
    o = o.transpose(0, 2, 1, 3).reshape(bsz, s_len, C_WIDTH)
    o = (o * jax.nn.silu(g.astype(jnp.float32))).astype(h.dtype)
    return o @ w_out


def setup_inputs(seed: int = 0) -> dict:
    key = jax.random.key(seed)
    ks = jax.random.split(key, 20)
    f32 = jnp.float32

    def w(k, shape, fan_in):
        return jax.random.normal(k, shape, f32) * (fan_in ** -0.5)

    def gain(k, shape):
        return 1.0 + 0.02 * jax.random.normal(k, shape, f32)

    return {
        "x": jax.random.normal(ks[0], (BATCH, SEQ, D_MODEL), f32),
        "ffn_pre_norm": gain(ks[1], (DEPTH, D_MODEL)),
        "ffn_pre_w_gate": w(ks[2], (DEPTH, D_MODEL, D_FF), D_MODEL),
        "ffn_pre_w_up": w(ks[3], (DEPTH, D_MODEL, D_FF), D_MODEL),
        "ffn_pre_w_down": w(ks[4], (DEPTH, D_FF, D_MODEL), D_FF),
        "mix_norm": gain(ks[5], (DEPTH, D_MODEL)),
        "ffn_post_norm": gain(ks[6], (DEPTH, D_MODEL)),
        "ffn_post_w_gate": w(ks[7], (DEPTH, D_MODEL, D_FF), D_MODEL),
        "ffn_post_w_up": w(ks[8], (DEPTH, D_MODEL, D_FF), D_MODEL),
        "ffn_post_w_down": w(ks[9], (DEPTH, D_FF, D_MODEL), D_FF),
        "ab_w_in": w(ks[10], (N_EVEN, D_MODEL, AB_IN_COLS), D_MODEL),
        "ab_conv_w": w(ks[11], (N_EVEN, CONV_WIDTH, A_WIDTH), CONV_WIDTH),
        "ab_w_out": w(ks[12], (N_EVEN, A_WIDTH + B_WIDTH, D_MODEL), A_WIDTH + B_WIDTH),
        "c_w_in": w(ks[13], (N_ODD, D_MODEL, C_IN_COLS), D_MODEL),
        "c_lower_bounds": 0.1 * jax.random.normal(ks[14], (DEPTH, C_WIDTH), f32),
        "c_out_norm": gain(ks[15], (N_ODD, C_HEAD_DIM)),
        "c_w_out": w(ks[16], (N_ODD, C_WIDTH, D_MODEL), C_WIDTH),
        "final_norm": gain(ks[17], (D_MODEL,)),
    }


def reference(x, ffn_pre_norm, ffn_pre_w_gate, ffn_pre_w_up, ffn_pre_w_down, mix_norm,
              ffn_post_norm, ffn_post_w_gate, ffn_post_w_up, ffn_post_w_down,
              ab_w_in, ab_conv_w, ab_w_out, c_w_in, c_lower_bounds, c_out_norm, c_w_out,
              final_norm):
    lb_soft = jax.nn.softmax(c_lower_bounds.astype(jnp.float32), axis=0)
    lb_cum = jnp.cumsum(lb_soft, axis=0)
    lower_bounds = lb_cum - lb_cum[0:1]

    h = x
    for layer in range(DEPTH):
        h = h + MACARON_WEIGHT * swiglu(rms_norm(h, ffn_pre_norm[layer]), ffn_pre_w_gate[layer],
                                        ffn_pre_w_up[layer], ffn_pre_w_down[layer])
        hn = rms_norm(h, mix_norm[layer])
        if layer % 2 == 0:
            e = layer // 2
            h = h + shortconv_stickbreak_mixer(hn, ab_w_in[e], ab_conv_w[e], ab_w_out[e])
        else:
            o = layer // 2
            h = h + hgrn2_mixer(hn, c_w_in[o], lower_bounds[layer], c_out_norm[o], c_w_out[o])
        h = h + MACARON_WEIGHT * swiglu(rms_norm(h, ffn_post_norm[layer]), ffn_post_w_gate[layer],
                                        ffn_post_w_up[layer], ffn_post_w_down[layer])
    return rms_norm(h, final_norm)
```

```cpp
#include <hip/hip_runtime.h>
#include <hip/hip_cooperative_groups.h>
#include <cstdio>
#include <cstdint>
namespace cg = cooperative_groups;
#define MK_ONE_LAUNCH 1
namespace pg8 {
#define PG8_LAS __attribute__((address_space(3)))
typedef unsigned short bf16_t;
typedef short bf16x8 __attribute__((ext_vector_type(8)));
typedef float f32x4 __attribute__((ext_vector_type(4)));
typedef unsigned u32x4 __attribute__((ext_vector_type(4)));
constexpr int BM = 256, BK = 64, HALF = 128, HTB = HALF * BK * 2  , STAGE_BYTES = 8 * HTB, NXCD = 8, WGM = 8;

__host__ __device__ __forceinline__ int lds_byte(int r, int c) { const int st = (r >> 4) * 2 + (c >> 5), rr = r & 15, cc = c & 31, ob = rr * 64 + cc * 2; return st * 1024 + (ob ^ (((ob >> 9) & 1) << 5)); }
__host__ __device__ __forceinline__ void stage_rc(int b, int& R, int& C) { const int st = b / 1024, sb = b % 1024, swz = sb ^ (((sb >> 9) & 1) << 5); R = (st >> 1) * 16 + swz / 64; C = (st & 1) * 32 + (swz % 64) / 2; }
__host__ __device__ __forceinline__ int perm32(int rho) { const int n = rho >> 4, i = rho & 15; return 8 * (i >> 2) + 4 * n + (i & 3); }

struct Unit { int pm, pn; };
struct Gemm { const bf16_t* A; const bf16_t* Bt; int M, N, K; };

struct StaticOrder {
    int nM, nN, nwg, G, c;
    __host__ __device__ void init(int M, int N, int G_, int c_) { nM = M / BM; nN = N / BM; nwg = nM * nN; G = G_; c = c_; }
    __host__ __device__ bool next(int i, Unit& u) const {
        const long L = (long)i * G + c; if (L >= nwg) return false;
        int wgid = (int)L; { const int q = nwg / NXCD, r = nwg % NXCD, xcd = wgid % NXCD, off = wgid / NXCD; wgid = (xcd < r ? xcd * (q + 1) : r * (q + 1) + (xcd - r) * q) + off; }
        const int nig = WGM * nN, gid = wgid / nig, fm = gid * WGM, gsz = (nM - fm) < WGM ? (nM - fm) : WGM;
        u.pm = fm + ((wgid % nig) % gsz); u.pn = (wgid % nig) / gsz; return true;
    }
    __device__ __forceinline__ void a_ready(const Unit&) const {}
    __device__ __forceinline__ void done(const Unit&) const {}
};

__device__ __forceinline__ unsigned cvt_pk_bf16(float lo, float hi) { unsigned r; asm volatile("v_cvt_pk_bf16_f32 %0, %1, %2" : "=v"(r) : "v"(lo), "v"(hi)); return r; }
typedef float f32x2 __attribute__((ext_vector_type(2)));
__device__ __forceinline__ float row_rstd(const float* ss, int row) {
    const f32x4* p = (const f32x4*)(ss + (size_t)row * 16);
    const f32x4 a = p[0], b = p[1], c = p[2], d = p[3];
    const float s = ((a[0] + a[1]) + (a[2] + a[3])) + ((b[0] + b[1]) + (b[2] + b[3])) + ((c[0] + c[1]) + (c[2] + c[3])) + ((d[0] + d[1]) + (d[2] + d[3]));
    return __builtin_amdgcn_rsqf(s * (1.0f / 1024.0f) + 1e-6f);
}
struct RsTab { const PG8_LAS float* tab; int pmA, pmB; const float* ss; };
template <class Sched> __device__ __forceinline__ RsTab rs_table_build(PG8_LAS unsigned char* lds_tab, const float* ss, const Sched& S, int tid) {
    RsTab t; t.tab = (const PG8_LAS float*)lds_tab; t.pmA = -1; t.pmB = -1; t.ss = ss;
    Unit u; for (int i = 0; S.next(i, u); ++i) { if (t.pmA < 0) t.pmA = u.pm; else if (u.pm != t.pmA && t.pmB < 0) t.pmB = u.pm; }
    const int pm = tid < 256 ? t.pmA : t.pmB;
    if (pm >= 0) ((PG8_LAS float*)lds_tab)[tid] = row_rstd(ss, pm * BM + (tid & 255));
    __syncthreads();
    return t;
}
__device__ __forceinline__ float rs_lookup(const RsTab& t, const Unit& u, int r  ) {
    if (u.pm == t.pmA) return t.tab[r];
    if (u.pm == t.pmB) return t.tab[256 + r];
    return row_rstd(t.ss, u.pm * BM + r);
}
__device__ __forceinline__ float sigmoidf_(float x) { return __builtin_amdgcn_rcpf(1.0f + __builtin_amdgcn_exp2f(-1.4426950408889634f * x)); }
__device__ __forceinline__ float siluf_(float x) { return x * sigmoidf_(x); }
__device__ __forceinline__ float bf_lo(unsigned w) { return __uint_as_float(w << 16); }
__device__ __forceinline__ float bf_hi(unsigned w) { return __uint_as_float(w & 0xffff0000u); }

struct EpiSwiGLU {
    static constexpr bool PERM = true, AFTER_DRAIN = false;
    bf16_t* O; RsTab rt; int ldo;
    struct Pre {};
    __device__ __forceinline__ Pre pre(const Unit&, int, int) const { return Pre{}; }
    __device__ __forceinline__ void operator()(const f32x4 (&acc)[2][2][4][2], const Unit& u, int wr, int wc, int fr, int fq, const Pre&) const {
        const int row0 = u.pm * BM + wr * 64 + fr, col0 = u.pn * HALF + wc * 32 + 8 * fq;
#pragma unroll
        for (int ai = 0; ai < 2; ++ai)
#pragma unroll
            for (int m = 0; m < 4; ++m) {
                const int row = row0 + ai * HALF + m * 16; const float rs = rs_lookup(rt, u, ai * HALF + wr * 64 + m * 16 + fr), c1 = -1.4426950408889634f * rs, rs2 = rs * rs;
                float h[8];
#pragma unroll
                for (int n = 0; n < 2; ++n)
#pragma unroll
                    for (int i = 0; i < 4; ++i) { const float g = acc[ai][0][m][n][i], up = acc[ai][1][m][n][i];
                        h[4 * n + i] = (g * up) * (rs2 * __builtin_amdgcn_rcpf(1.0f + __builtin_amdgcn_exp2f(g * c1))); }
                u32x4 w; w.x = cvt_pk_bf16(h[0], h[1]); w.y = cvt_pk_bf16(h[2], h[3]); w.z = cvt_pk_bf16(h[4], h[5]); w.w = cvt_pk_bf16(h[6], h[7]);
                *(u32x4*)(O + (size_t)row * ldo + col0) = w;
            }
    }
};
template <bool F32OUT> struct EpiResid {
    static constexpr bool PERM = true, AFTER_DRAIN = false;
    bf16_t* H; float* ssout; float alpha; float* out32;
    struct Pre {};
    __device__ __forceinline__ Pre pre(const Unit&, int, int) const { return Pre{}; }
    __device__ __forceinline__ void operator()(const f32x4 (&acc)[2][2][4][2], const Unit& u, int wr, int wc, int fr, int fq, const Pre&) const {
        const int row0 = u.pm * BM + wr * 64 + fr, col0 = u.pn * BM + wc * 32 + 8 * fq;
#pragma unroll
        for (int ai = 0; ai < 2; ++ai) {
            u32x4 old[4][2];
#pragma unroll
            for (int m = 0; m < 4; ++m)
#pragma unroll
                for (int bj = 0; bj < 2; ++bj) old[m][bj] = *(const u32x4*)(H + (size_t)(row0 + ai * HALF + m * 16) * 1024 + col0 + bj * HALF);
#pragma unroll
            for (int m = 0; m < 4; ++m) {
                const int row = row0 + ai * HALF + m * 16; float sq = 0.f;
#pragma unroll
                for (int bj = 0; bj < 2; ++bj) {
                    bf16_t* hp = H + (size_t)row * 1024 + col0 + bj * HALF;
                    const u32x4 o4 = old[m][bj];
                    float v[8];
                    v[0] = bf_lo(o4.x); v[1] = bf_hi(o4.x); v[2] = bf_lo(o4.y); v[3] = bf_hi(o4.y); v[4] = bf_lo(o4.z); v[5] = bf_hi(o4.z); v[6] = bf_lo(o4.w); v[7] = bf_hi(o4.w);
#pragma unroll
                    for (int n = 0; n < 2; ++n)
#pragma unroll
                        for (int i = 0; i < 4; ++i) { v[4 * n + i] += alpha * acc[ai][bj][m][n][i]; sq += v[4 * n + i] * v[4 * n + i]; }
                    u32x4 w; w.x = cvt_pk_bf16(v[0], v[1]); w.y = cvt_pk_bf16(v[2], v[3]); w.z = cvt_pk_bf16(v[4], v[5]); w.w = cvt_pk_bf16(v[6], v[7]);
                    *(u32x4*)hp = w;
                    if (F32OUT) { float* op = out32 + (size_t)row * 1024 + col0 + bj * HALF; *(f32x4*)op = (f32x4){v[0], v[1], v[2], v[3]}; *(f32x4*)(op + 4) = (f32x4){v[4], v[5], v[6], v[7]}; }
                }
                sq += __shfl_xor(sq, 16); sq += __shfl_xor(sq, 32);
                if (fq == 0) ssout[(size_t)row * 16 + u.pn * 4 + wc] = sq;
            }
        }
    }
};
struct EpiProjAB {
    static constexpr bool PERM = true, AFTER_DRAIN = false;
    bf16_t* O; RsTab rt; float qscale;
    struct Pre {};
    __device__ __forceinline__ Pre pre(const Unit&, int, int) const { return Pre{}; }
    __device__ __forceinline__ void operator()(const f32x4 (&acc)[2][2][4][2], const Unit& u, int wr, int wc, int fr, int fq, const Pre&) const {
        const int row0 = u.pm * BM + wr * 64 + fr, col0 = u.pn * BM + wc * 32 + 8 * fq;
        const float sc = (u.pn == 6 || u.pn == 7) ? qscale : 1.0f;
#pragma unroll
        for (int ai = 0; ai < 2; ++ai)
#pragma unroll
            for (int m = 0; m < 4; ++m) {
                const int row = row0 + ai * HALF + m * 16; const float rs = rs_lookup(rt, u, ai * HALF + wr * 64 + m * 16 + fr) * sc;
#pragma unroll
                for (int bj = 0; bj < 2; ++bj) {
                    const f32x4 a = acc[ai][bj][m][0] * rs, b = acc[ai][bj][m][1] * rs;
                    u32x4 w; w.x = cvt_pk_bf16(a[0], a[1]); w.y = cvt_pk_bf16(a[2], a[3]); w.z = cvt_pk_bf16(b[0], b[1]); w.w = cvt_pk_bf16(b[2], b[3]);
                    *(u32x4*)(O + (size_t)row * 3072 + col0 + bj * HALF) = w;
                }
            }
    }
};
struct EpiProjC {
    static constexpr bool PERM = true, AFTER_DRAIN = false;
    bf16_t* Qs; float* LF; bf16_t* Iv; bf16_t* Gs; RsTab rt; const float* clb;
    struct Pre {};
    __device__ __forceinline__ Pre pre(const Unit&, int, int) const { return Pre{}; }
    __device__ __forceinline__ void operator()(const f32x4 (&acc)[2][2][4][2], const Unit& u, int wr, int wc, int fr, int fq, const Pre&) const {
        const int kind = u.pn >> 2;
        const int row0 = u.pm * BM + wr * 64 + fr, col0 = (u.pn & 3) * BM + wc * 32 + 8 * fq;
        if (kind == 1) {
            float lb[2][8];
#pragma unroll
            for (int bj = 0; bj < 2; ++bj)
#pragma unroll
                for (int j = 0; j < 8; ++j) { const int c = col0 + bj * HALF + j; lb[bj][j] = sigmoidf_(clb[1024 + c] - clb[c]); }
#pragma unroll
            for (int ai = 0; ai < 2; ++ai)
#pragma unroll
                for (int m = 0; m < 4; ++m) {
                    const int row = row0 + ai * HALF + m * 16; const float rs = rs_lookup(rt, u, ai * HALF + wr * 64 + m * 16 + fr);
#pragma unroll
                    for (int bj = 0; bj < 2; ++bj) {
                        float v[8];
#pragma unroll
                        for (int n = 0; n < 2; ++n)
#pragma unroll
                            for (int i = 0; i < 4; ++i) { const float x = acc[ai][bj][m][n][i] * rs, l = lb[bj][4 * n + i]; v[4 * n + i] = __builtin_amdgcn_logf(l + (1.0f - l) * sigmoidf_(x)); }
                        float* op = LF + (size_t)row * 1024 + col0 + bj * HALF; *(f32x4*)op = (f32x4){v[0], v[1], v[2], v[3]}; *(f32x4*)(op + 4) = (f32x4){v[4], v[5], v[6], v[7]};
                    }
                }
        } else {
            bf16_t* O = Qs + (kind ? ((size_t)(64 + 64 * kind) << 19) : (size_t)0);
            const bool act = kind != 2;
#pragma unroll
            for (int ai = 0; ai < 2; ++ai)
#pragma unroll
                for (int m = 0; m < 4; ++m) {
                    const int row = row0 + ai * HALF + m * 16; const float rs = rs_lookup(rt, u, ai * HALF + wr * 64 + m * 16 + fr);
#pragma unroll
                    for (int bj = 0; bj < 2; ++bj) {
                        float v[8];
#pragma unroll
                        for (int n = 0; n < 2; ++n)
#pragma unroll
                            for (int i = 0; i < 4; ++i) { const float x = acc[ai][bj][m][n][i] * rs; v[4 * n + i] = act ? siluf_(x) : x; }
                        u32x4 w; w.x = cvt_pk_bf16(v[0], v[1]); w.y = cvt_pk_bf16(v[2], v[3]); w.z = cvt_pk_bf16(v[4], v[5]); w.w = cvt_pk_bf16(v[6], v[7]);
                        *(u32x4*)(O + (size_t)row * 1024 + col0 + bj * HALF) = w;
                    }
                }
        }
    }
};
template <class Epi, class Sched, bool ALIGN_EPI = false, bool SP2 = false>
__device__ __forceinline__ void gemm_phase(PG8_LAS unsigned char* lds, const Gemm g, const Sched& S, const Epi& E) {
    const int tid = threadIdx.x, wid = __builtin_amdgcn_readfirstlane(tid >> 6), lane = tid & 63, wr = wid >> 2, wc = wid & 3, fr = lane & 15, fq = lane >> 4;
    const int K = g.K, nt = K / BK;
    unsigned voffA[2], voffB[2];
#pragma unroll
    for (int i = 0; i < 2; ++i) { int R, C; stage_rc(tid * 16 + i * 8192, R, C); const int Rb = Epi::PERM ? ((R & ~31) + perm32(R & 31)) : R;
        voffA[i] = (unsigned)(R * K + C) * 2u; voffB[i] = (unsigned)(Rb * K + C) * 2u; }
    const size_t kstep = (size_t)(BK * 2);
    const size_t hstep = (size_t)HALF * K * 2;
    const size_t tstep = 2 * hstep;
    const unsigned ldsw = (unsigned)wid * 1024u;
    const int aoff = lds_byte(wr * 64 + fr, fq * 8), boff = lds_byte(wc * 32 + fr, fq * 8);
#define PG8_SA(b, h) (((b) * 2 + (h)) * HTB)
#define PG8_SB(b, h) ((4 + (b) * 2 + (h)) * HTB)
#define PG8_STAGE(bufoff, gbase, voff) do { _Pragma("unroll") for (int _i = 0; _i < 2; ++_i) \
        __builtin_amdgcn_global_load_lds((const unsigned*)((const char*)(gbase) + (voff)[_i]), (PG8_LAS unsigned*)(lds + (bufoff) + ldsw + _i * 8192), 16, 0, 0); } while (0)
#define PG8_LDA(dst, b, h) do { _Pragma("unroll") for (int m = 0; m < 4; ++m) _Pragma("unroll") for (int k = 0; k < 2; ++k) dst[m][k] = *(const PG8_LAS bf16x8*)(lds + PG8_SA(b, h) + aoff + m * 2048 + k * 1024); } while (0)
#define PG8_LDB(dst, b, h) do { _Pragma("unroll") for (int n = 0; n < 2; ++n) _Pragma("unroll") for (int k = 0; k < 2; ++k) dst[n][k] = *(const PG8_LAS bf16x8*)(lds + PG8_SB(b, h) + boff + n * 2048 + k * 1024); } while (0)
#define PG8_MMA(ai, bj, At, Bt) do { __builtin_amdgcn_s_setprio(1); _Pragma("unroll") for (int m = 0; m < 4; ++m) _Pragma("unroll") for (int n = 0; n < 2; ++n) _Pragma("unroll") for (int k = 0; k < 2; ++k) \
        acc[ai][bj][m][n] = __builtin_amdgcn_mfma_f32_16x16x32_bf16(Bt[n][k], At[m][k], acc[ai][bj][m][n], 0, 0, 0); __builtin_amdgcn_s_setprio(0); } while (0)
#define PG8_WAIT_V(n) asm volatile("s_waitcnt vmcnt(" #n ")" ::: "memory")
#define PG8_WAIT_L(n) asm volatile("s_waitcnt lgkmcnt(" #n ")" ::: "memory")
#define PG8_BAR __builtin_amdgcn_s_barrier()
#define PG8_SCHED __builtin_amdgcn_sched_barrier(0)
    Unit cur, nxt; int ui = 0;
    if (!S.next(0, cur)) return;
    f32x4 acc[2][2][4][2];
#pragma unroll
    for (int a = 0; a < 2; ++a)
#pragma unroll
        for (int b = 0; b < 2; ++b)
#pragma unroll
            for (int m = 0; m < 4; ++m)
#pragma unroll
                for (int n = 0; n < 2; ++n) acc[a][b][m][n] = (f32x4){0.f, 0.f, 0.f, 0.f};
    bf16x8 At[4][2], B0[2][2], B1[2][2];
    const char* cA = (const char*)g.A + (size_t)cur.pm * tstep; const char* cB = (const char*)g.Bt + (size_t)cur.pn * tstep;
    S.a_ready(cur);
    if constexpr (SP2) {
        PG8_STAGE(PG8_SB(0, 0), cB, voffB); PG8_STAGE(PG8_SB(0, 1), cB + hstep, voffB); PG8_STAGE(PG8_SA(0, 0), cA, voffA); PG8_STAGE(PG8_SA(0, 1), cA + hstep, voffA);
        if (wr == 1) PG8_BAR;
        PG8_WAIT_V(2); PG8_BAR;
        PG8_STAGE(PG8_SB(1, 0), cB + kstep, voffB); PG8_STAGE(PG8_SA(1, 0), cA + kstep, voffA); PG8_STAGE(PG8_SB(1, 1), cB + hstep + kstep, voffB);
        PG8_WAIT_V(6); PG8_BAR;
    } else {
        PG8_STAGE(PG8_SB(0, 0), cB, voffB); PG8_STAGE(PG8_SA(0, 0), cA, voffA); PG8_STAGE(PG8_SB(0, 1), cB + hstep, voffB); PG8_STAGE(PG8_SA(0, 1), cA + hstep, voffA);
        if (wr == 1) PG8_BAR;
        PG8_WAIT_V(4); PG8_BAR;
        PG8_STAGE(PG8_SB(1, 0), cB + kstep, voffB); PG8_STAGE(PG8_SA(1, 0), cA + kstep, voffA); PG8_STAGE(PG8_SB(1, 1), cB + hstep + kstep, voffB);
        PG8_WAIT_V(6); PG8_BAR;
    }
    for (;;) {
        const bool has_next = S.next(ui + 1, nxt);
        const char* nA = has_next ? (const char*)g.A + (size_t)nxt.pm * tstep : cA; const char* nB = has_next ? (const char*)g.Bt + (size_t)nxt.pn * tstep : cB;
        for (int t = 0; t < nt; t += 2) {
            const bool last = (t == nt - 2);
            const char* a1 = cA + (size_t)(t + 1) * kstep;
            const char* a2 = last ? nA : cA + (size_t)(t + 2) * kstep; const char* b2 = last ? nB : cB + (size_t)(t + 2) * kstep;
            const char* a3 = a2 + kstep; const char* b3 = b2 + kstep;
            if (last && has_next) S.a_ready(nxt);
            if constexpr (SP2) {
            PG8_LDB(B0, 0, 0); PG8_LDB(B1, 0, 1); PG8_SCHED; PG8_LDA(At, 0, 0); PG8_STAGE(PG8_SA(1, 1), a1 + hstep, voffA);
            PG8_WAIT_V(8); PG8_WAIT_L(0); PG8_BAR; PG8_MMA(0, 0, At, B0); PG8_MMA(0, 1, At, B1); PG8_BAR; PG8_SCHED;
            PG8_LDA(At, 0, 1); PG8_STAGE(PG8_SB(0, 0), b2, voffB); PG8_STAGE(PG8_SB(0, 1), b2 + hstep, voffB); PG8_STAGE(PG8_SA(0, 0), a2, voffA);
            PG8_WAIT_V(8); PG8_WAIT_L(0); PG8_BAR; PG8_MMA(1, 0, At, B0); PG8_MMA(1, 1, At, B1); PG8_BAR; PG8_SCHED;
            PG8_LDB(B0, 1, 0); PG8_LDB(B1, 1, 1); PG8_SCHED; PG8_LDA(At, 1, 0); PG8_STAGE(PG8_SA(0, 1), a2 + hstep, voffA);
            PG8_WAIT_V(8); PG8_WAIT_L(0); PG8_BAR; PG8_MMA(0, 0, At, B0); PG8_MMA(0, 1, At, B1); PG8_BAR; PG8_SCHED;
            PG8_LDA(At, 1, 1); PG8_STAGE(PG8_SB(1, 0), b3, voffB); PG8_STAGE(PG8_SB(1, 1), b3 + hstep, voffB); PG8_STAGE(PG8_SA(1, 0), a3, voffA);
            PG8_WAIT_V(8); PG8_WAIT_L(0); PG8_BAR; PG8_MMA(1, 0, At, B0); PG8_MMA(1, 1, At, B1); PG8_BAR; PG8_SCHED;
            } else {
            PG8_LDB(B0, 0, 0); PG8_SCHED; PG8_LDA(At, 0, 0); PG8_STAGE(PG8_SA(1, 1), a1 + hstep, voffA);
            PG8_WAIT_L(8); PG8_BAR; PG8_WAIT_L(0); PG8_MMA(0, 0, At, B0); PG8_BAR; PG8_SCHED;
            PG8_LDB(B1, 0, 1); PG8_STAGE(PG8_SB(0, 0), b2, voffB);
            PG8_BAR; PG8_WAIT_L(0); PG8_MMA(0, 1, At, B1); PG8_BAR;
            PG8_LDA(At, 0, 1); PG8_STAGE(PG8_SA(0, 0), a2, voffA);
            PG8_BAR; PG8_WAIT_L(0); PG8_MMA(1, 0, At, B0); PG8_BAR; PG8_SCHED;
            PG8_STAGE(PG8_SB(0, 1), b2 + hstep, voffB);
            PG8_WAIT_V(6); PG8_BAR; PG8_MMA(1, 1, At, B1); PG8_BAR;
            PG8_LDB(B0, 1, 0); PG8_SCHED; PG8_LDA(At, 1, 0); PG8_STAGE(PG8_SA(0, 1), a2 + hstep, voffA);
            PG8_WAIT_L(8); PG8_BAR; PG8_WAIT_L(0); PG8_MMA(0, 0, At, B0); PG8_BAR; PG8_SCHED;
            PG8_LDB(B1, 1, 1); PG8_STAGE(PG8_SB(1, 0), b3, voffB);
            PG8_BAR; PG8_WAIT_L(0); PG8_MMA(0, 1, At, B1); PG8_BAR;
            PG8_LDA(At, 1, 1); PG8_STAGE(PG8_SA(1, 0), a3, voffA);
            PG8_BAR; PG8_WAIT_L(0); PG8_MMA(1, 0, At, B0); PG8_BAR; PG8_SCHED;
            PG8_STAGE(PG8_SB(1, 1), b3 + hstep, voffB);
            PG8_WAIT_V(6); PG8_BAR; PG8_MMA(1, 1, At, B1); PG8_BAR;
            }
        }
        if constexpr (ALIGN_EPI) { if (wr == 0) PG8_BAR; }
        if constexpr (!Epi::AFTER_DRAIN) { E(acc, cur, wr, wc, fr, fq, E.pre(cur, wr, lane)); S.done(cur); }
        if (!has_next) break;
#pragma unroll
        for (int a = 0; a < 2; ++a)
#pragma unroll
            for (int b = 0; b < 2; ++b)
#pragma unroll
                for (int m = 0; m < 4; ++m)
#pragma unroll
                    for (int n = 0; n < 2; ++n) acc[a][b][m][n] = (f32x4){0.f, 0.f, 0.f, 0.f};
        cur = nxt; cA = nA; cB = nB; ++ui;
        if constexpr (ALIGN_EPI) { if (wr == 1) PG8_BAR; }
    }
    PG8_WAIT_V(0);
    if constexpr (!ALIGN_EPI) { if (wr == 0) PG8_BAR; }
    PG8_BAR;
    if constexpr (Epi::AFTER_DRAIN) { E.fused(acc, cur, wr, wc, fr, fq, lds, wid, lane); S.done(cur); }
#undef PG8_SA
#undef PG8_SB
#undef PG8_STAGE
#undef PG8_LDA
#undef PG8_LDB
#undef PG8_MMA
#undef PG8_WAIT_V
#undef PG8_WAIT_L
#undef PG8_BAR
#undef PG8_SCHED
}
}
using pg8::bf16_t; using pg8::bf16x8; using pg8::f32x4; using pg8::u32x4;
typedef float f32x16 __attribute__((ext_vector_type(16)));
typedef short s16x4 __attribute__((ext_vector_type(4)));
typedef unsigned u32x2 __attribute__((ext_vector_type(2)));
#define LAS __attribute__((address_space(3)))
constexpr int NWAVES = 8, NTHREADS = 512;
constexpr int BATCH = 8, SEQ = 4096, D = 1024, FF = 2816, M = BATCH * SEQ;
constexpr float QSCALE = 0.125f * 1.4426950408889634f;
constexpr size_t MiB = 1u << 20;
constexpr size_t WS_GU = 1 * MiB;
constexpr size_t WS_DN = WS_GU + 44 * MiB;
constexpr size_t WS_ABIN = WS_DN + 22 * MiB;
constexpr size_t WS_ABOUT = WS_ABIN + 6 * MiB;
constexpr size_t WS_CIN = WS_ABOUT + 2 * MiB;
constexpr size_t WS_COUT = WS_CIN + 8 * MiB;
constexpr size_t WS_H = WS_COUT + 2 * MiB;
constexpr size_t WS_SS = WS_H + 64 * MiB;
constexpr size_t WS_R = WS_SS + 14 * MiB;
constexpr size_t WS_HID = WS_R, WS_PROJ = WS_R, WS_Y = WS_R + 192 * MiB;
constexpr size_t WS_QS = WS_R, WS_LF = WS_R + 64 * MiB, WS_IV = WS_R + 192 * MiB, WS_GS = WS_R + 256 * MiB;
constexpr size_t WS_END = WS_R + 320 * MiB;
static_assert(WS_END <= 512 * MiB, "workspace map");
constexpr int LDS_BYTES = 147456;

__device__ __forceinline__ unsigned f2bf(float f) { unsigned u = __builtin_bit_cast(unsigned, f); return (u + 0x7fffu + ((u >> 16) & 1u)) >> 16; }
__device__ __forceinline__ unsigned pk2(float lo, float hi) { return pg8::cvt_pk_bf16(lo, hi); }
__device__ __forceinline__ float wave_sum(float v) {
#pragma unroll
    for (int o = 1; o < 64; o <<= 1) v += __shfl_xor(v, o);
    return v;
}
constexpr int P0_SCR = 64 * 65 * 4;
__device__ __forceinline__ void p0_transpose_item(const float* W, int K, int N, const float* gain, bf16_t* WT, int k0, int n0, int orow0, LAS float* scr, int lane) {
    const int lr = lane >> 4, lc = (lane & 15) * 4;
    f32x4 v[16];
#pragma unroll
    for (int j = 0; j < 16; ++j) v[j] = __builtin_nontemporal_load((const f32x4*)(W + (size_t)(k0 + 4 * j + lr) * N + n0 + lc));
    if (gain) {
#pragma unroll
        for (int j = 0; j < 16; ++j) v[j] = v[j] * gain[k0 + 4 * j + lr];
    }
#pragma unroll
    for (int j = 0; j < 16; ++j) { LAS float* d = scr + (4 * j + lr) * 65 + lc; d[0] = v[j][0]; d[1] = v[j][1]; d[2] = v[j][2]; d[3] = v[j][3]; }
    asm volatile("s_waitcnt lgkmcnt(0)" ::: "memory");
    const int c = lane & 7;
#pragma unroll
    for (int j = 0; j < 8; ++j) { const int n = (lane >> 3) + 8 * j; const LAS float* s = scr + (8 * c) * 65 + n;
        u32x4 o; o.x = pk2(s[0 * 65], s[1 * 65]); o.y = pk2(s[2 * 65], s[3 * 65]); o.z = pk2(s[4 * 65], s[5 * 65]); o.w = pk2(s[6 * 65], s[7 * 65]);
        *(u32x4*)(WT + (size_t)(orow0 + n) * K + k0 + 8 * c) = o; }
    asm volatile("s_waitcnt lgkmcnt(0)" ::: "memory");
}
struct Ptrs {
    const float* in[18]; float* out; unsigned char* ws;
};
__device__ __forceinline__ void p0_prologue(const Ptrs& P, LAS unsigned char* lds, int gw, int NGW, int wave, int lane) {
    unsigned char* ws = P.ws;
    const float* x = P.in[0]; bf16_t* H = (bf16_t*)(ws + WS_H); float* ss0 = (float*)(ws + WS_SS);
    for (int m0 = gw * 4; m0 < M; m0 += NGW * 4) {
        f32x4 v[4][4];
#pragma unroll
        for (int r = 0; r < 4; ++r)
#pragma unroll
            for (int j = 0; j < 4; ++j) v[r][j] = __builtin_nontemporal_load((const f32x4*)(x + (size_t)(m0 + r) * D) + lane + 64 * j);
#pragma unroll
        for (int r = 0; r < 4; ++r) {
            float s = 0.f;
#pragma unroll
            for (int j = 0; j < 4; ++j) s += (v[r][j][0] * v[r][j][0] + v[r][j][1] * v[r][j][1]) + (v[r][j][2] * v[r][j][2] + v[r][j][3] * v[r][j][3]);
            s = wave_sum(s);
            u32x2* o8 = (u32x2*)(H + (size_t)(m0 + r) * D) + lane;
#pragma unroll
            for (int j = 0; j < 4; ++j) { u32x2 w; w.x = pk2(v[r][j][0], v[r][j][1]); w.y = pk2(v[r][j][2], v[r][j][3]); o8[64 * j] = w; }
            if (lane < 16) ss0[(size_t)(m0 + r) * 16 + lane] = lane == 0 ? s : 0.f;
        }
    }
    LAS float* scr = (LAS float*)(lds + wave * P0_SCR);
    constexpr int I_FFN = 704;
    constexpr int I_ABIN = 16 * 48, I_ABOUT = 16 * 16, I_CIN = 16 * 64, I_COUT = 16 * 16;
    constexpr int NITEMS = 12 * I_FFN + I_ABIN + I_ABOUT + I_CIN + I_COUT;
    for (int it = gw; it < NITEMS; it += NGW) {
        int r = it;
        if (r < 12 * I_FFN) {
            const int mat = r / I_FFN, item = r % I_FFN, f = mat / 3, type = mat % 3;
            const int layer = f >> 1, post = f & 1;
            if (type < 2) {
                const float* Wg = post ? P.in[7] : P.in[2]; const float* Wu = post ? P.in[8] : P.in[3]; const float* W = (type == 0 ? Wg : Wu) + (size_t)layer * D * FF;
                const float* gain = (post ? P.in[6] : P.in[1]) + layer * D;
                const int nblk = FF / 64, kb = item / nblk, nb = item % nblk, n0 = 64 * nb;
                const int orow0 = (n0 >> 7) * 256 + (n0 & 127) + (type == 1 ? 128 : 0);
                p0_transpose_item(W, D, FF, gain, (bf16_t*)(ws + WS_GU) + (size_t)f * 5632 * 1024, 64 * kb, n0, orow0, scr, lane);
            } else {
                const float* W = (post ? P.in[9] : P.in[4]) + (size_t)layer * FF * D;
                const int nblk = D / 64, kb = item / nblk, nb = item % nblk, n0 = 64 * nb;
                p0_transpose_item(W, FF, D, nullptr, (bf16_t*)(ws + WS_DN) + (size_t)f * 1024 * 2816, 64 * kb, n0, n0, scr, lane);
            }
            continue;
        }
        r -= 12 * I_FFN;
        if (r < I_ABIN) { const int nblk = 48, kb = r / nblk, nb = r % nblk; p0_transpose_item(P.in[10], D, 3072, P.in[5], (bf16_t*)(ws + WS_ABIN), 64 * kb, 64 * nb, 64 * nb, scr, lane); continue; }
        r -= I_ABIN;
        if (r < I_ABOUT) { const int nblk = 16, kb = r / nblk, nb = r % nblk; p0_transpose_item(P.in[12], D, D, nullptr, (bf16_t*)(ws + WS_ABOUT), 64 * kb, 64 * nb, 64 * nb, scr, lane); continue; }
        r -= I_ABOUT;
        if (r < I_CIN) { const int nblk = 64, kb = r / nblk, nb = r % nblk; p0_transpose_item(P.in[13], D, 4096, P.in[5] + D, (bf16_t*)(ws + WS_CIN), 64 * kb, 64 * nb, 64 * nb, scr, lane); continue; }
        r -= I_CIN;
        { const int nblk = 16, kb = r / nblk, nb = r % nblk; p0_transpose_item(P.in[16], D, D, nullptr, (bf16_t*)(ws + WS_COUT), 64 * kb, 64 * nb, 64 * nb, scr, lane); }
    }
}
__device__ __forceinline__ void final_norm(const Ptrs& P, int gw, int NGW, int lane) {
    const float* ss = (const float*)(P.ws + WS_SS) + (size_t)6 * M * 16; const float* gain = P.in[17]; const bf16_t* H = (const bf16_t*)(P.ws + WS_H);
    f32x4 g[4];
#pragma unroll
    for (int j = 0; j < 4; ++j) g[j] = ((const f32x4*)gain)[lane + 64 * j];
    for (int m0 = gw * 4; m0 < M; m0 += NGW * 4) {
        u32x2 w[4][4]; float rs[4];
#pragma unroll
        for (int r = 0; r < 4; ++r) { rs[r] = pg8::row_rstd(ss, m0 + r);
#pragma unroll
            for (int j = 0; j < 4; ++j) w[r][j] = ((const u32x2*)(H + (size_t)(m0 + r) * D))[lane + 64 * j]; }
#pragma unroll
        for (int r = 0; r < 4; ++r) { f32x4* orow = (f32x4*)(P.out + (size_t)(m0 + r) * D) + lane;
#pragma unroll
            for (int j = 0; j < 4; ++j) { const f32x4 v = (f32x4){pg8::bf_lo(w[r][j].x), pg8::bf_hi(w[r][j].x), pg8::bf_lo(w[r][j].y), pg8::bf_hi(w[r][j].y)}; orow[64 * j] = v * rs[r] * g[j]; } }
    }
}
#define XB_TMO      128
#define XB_XCNT(j)  (256  + 64 * (j))
#define XB_XSUB(j)  (1280 + 64 * (j))
#define XB_XGEN(j)  (2304 + 64 * (j))
#define XB_TOP      3328
#define XB_TOPGEN   3392
#define XCD_BAR_WORDS 3456
#define XB_SPIN_CAP (1u << 18)

__device__ __forceinline__ unsigned xb_ld(unsigned* p)              { return __hip_atomic_load(p, __ATOMIC_RELAXED, __HIP_MEMORY_SCOPE_AGENT); }
__device__ __forceinline__ unsigned xb_add(unsigned* p, unsigned v) { return __hip_atomic_fetch_add(p, v, __ATOMIC_RELAXED, __HIP_MEMORY_SCOPE_AGENT); }
__device__ __forceinline__ unsigned xb_xcc_id() { return (unsigned)__builtin_amdgcn_s_getreg((3 << 11) | 20) & 0xFu; }
#define XB_SPIN(cond, bar) do { unsigned _sp = 0; while (cond) { __builtin_amdgcn_s_sleep(1); \
    if ((++_sp & 255u) == 0u) { if (xb_ld(&(bar)[XB_TMO])) break; if (_sp > XB_SPIN_CAP) { atomicAdd(&(bar)[XB_TMO], 1u); break; } } } } while (0)

struct XcdBarrier {
    unsigned* bar; unsigned x;
    volatile LAS unsigned* st;
};

__device__ __forceinline__ XcdBarrier xcd_barrier_post(unsigned* bar, volatile LAS unsigned* st) {
    XcdBarrier b; b.bar = bar; b.x = xb_xcc_id(); b.st = st;
    if (threadIdx.x == 0) (void)xb_add(&bar[XB_XCNT(b.x)], 1u);
    return b;
}
__device__ __forceinline__ void xcd_barrier_complete(unsigned* bar, unsigned x, unsigned& nloc, unsigned& nx) {
    const unsigned G = gridDim.x * gridDim.y * gridDim.z;
    unsigned sum, cnt, mine, sp = 0u;
    for (;;) {
        sum = 0u; cnt = 0u; mine = 0u;
#pragma unroll
        for (unsigned j = 0; j < 16; ++j) { const unsigned c = xb_ld(&bar[XB_XCNT(j)]); sum += c; cnt += (c > 0u) ? 1u : 0u; mine = (j == x) ? c : mine; }
        if (sum == G) break;
        __builtin_amdgcn_s_sleep(1);
        if ((++sp & 255u) == 0u) { if (xb_ld(&bar[XB_TMO])) break; if (sp > XB_SPIN_CAP) { atomicAdd(&bar[XB_TMO], 1u); break; } }
    }
    nloc = mine > 0u ? mine : 1u; nx = cnt > 0u ? cnt : 1u;
}

__device__ __forceinline__ void xcd_barrier(const XcdBarrier& b) {
    asm volatile("s_waitcnt vmcnt(0)" ::: "memory");
    __syncthreads();
    if (threadIdx.x == 0) {
        unsigned* bar = b.bar;
        __builtin_amdgcn_s_waitcnt(0);
        unsigned nloc = b.st[0], nx = b.st[1];
        if (nloc == 0u) { xcd_barrier_complete(bar, b.x, nloc, nx); b.st[0] = nloc; b.st[1] = nx; }
        const unsigned old = xb_add(&bar[XB_XSUB(b.x)], 1u);
        const unsigned gen = old / nloc;
        if (old + 1u == (gen + 1u) * nloc) {
            __builtin_amdgcn_fence(__ATOMIC_RELEASE, "agent");
            asm volatile("s_waitcnt vmcnt(0)" ::: "memory");
            const unsigned og = xb_add(&bar[XB_TOP], 1u);
            const unsigned tg = og / nx;
            if (og + 1u == (tg + 1u) * nx) xb_add(&bar[XB_TOPGEN], 1u);
            else XB_SPIN(xb_ld(&bar[XB_TOPGEN]) == tg, bar);
            __builtin_amdgcn_fence(__ATOMIC_ACQUIRE, "agent");
            xb_add(&bar[XB_XGEN(b.x)], 1u);
            asm volatile("s_waitcnt vmcnt(0)" ::: "memory");
        } else {
            XB_SPIN(xb_ld(&bar[XB_XGEN(b.x)]) == gen, bar);
            __builtin_amdgcn_fence(__ATOMIC_ACQUIRE, "agent");
            asm volatile("s_waitcnt vmcnt(0)" ::: "memory");
        }
    }
    __syncthreads();
}
__device__ __forceinline__ void unpack8(const u32x4 w, float (&v)[8]) {
    v[0] = pg8::bf_lo(w.x); v[1] = pg8::bf_hi(w.x); v[2] = pg8::bf_lo(w.y); v[3] = pg8::bf_hi(w.y); v[4] = pg8::bf_lo(w.z); v[5] = pg8::bf_hi(w.z); v[6] = pg8::bf_lo(w.w); v[7] = pg8::bf_hi(w.w);
}
__device__ __forceinline__ void conv_item(const bf16_t* PROJ, const float* cw, bf16_t* Y, int item, int lane) {
    const int r0 = item * 16, c0 = lane * 8;
    float w0[8], w1[8], w2[8];
#pragma unroll
    for (int j = 0; j < 8; ++j) { w0[j] = cw[c0 + j]; w1[j] = cw[512 + c0 + j]; w2[j] = cw[1024 + c0 + j]; }
    float um1[8], um2[8];
#pragma unroll
    for (int j = 0; j < 8; ++j) { um1[j] = 0.f; um2[j] = 0.f; }
    if ((r0 & (SEQ - 1)) != 0) {
        float a[8], b[8];
        const bf16_t* p2 = PROJ + (size_t)(r0 - 2) * 3072 + c0; unpack8(*(const u32x4*)(p2 + 512), a); unpack8(*(const u32x4*)(p2 + 1024), b);
#pragma unroll
        for (int j = 0; j < 8; ++j) um2[j] = a[j] * b[j];
        const bf16_t* p1 = PROJ + (size_t)(r0 - 1) * 3072 + c0; unpack8(*(const u32x4*)(p1 + 512), a); unpack8(*(const u32x4*)(p1 + 1024), b);
#pragma unroll
        for (int j = 0; j < 8; ++j) um1[j] = a[j] * b[j];
    }
#pragma unroll 4
    for (int r = 0; r < 16; ++r) {
        const bf16_t* p = PROJ + (size_t)(r0 + r) * 3072 + c0;
        float g[8], a[8], b[8], o[8];
        unpack8(*(const u32x4*)p, g); unpack8(*(const u32x4*)(p + 512), a); unpack8(*(const u32x4*)(p + 1024), b);
#pragma unroll
        for (int j = 0; j < 8; ++j) { const float u = a[j] * b[j]; o[j] = g[j] * (w0[j] * um2[j] + w1[j] * um1[j] + w2[j] * u); um2[j] = um1[j]; um1[j] = u; }
        u32x4 w; w.x = pk2(o[0], o[1]); w.y = pk2(o[2], o[3]); w.z = pk2(o[4], o[5]); w.w = pk2(o[6], o[7]);
        *(u32x4*)(Y + (size_t)(r0 + r) * 1024 + c0) = w;
    }
}
__device__ __forceinline__ s16x4 vtr(const LAS unsigned char* p) { typedef short v4i16_t __attribute__((ext_vector_type(4))); return __builtin_bit_cast(s16x4, __builtin_amdgcn_ds_read_tr16_b64_v4i16((LAS v4i16_t*)p)); }
__device__ __forceinline__ bf16x8 cat8(s16x4 a, s16x4 b) { bf16x8 r; r[0] = a[0]; r[1] = a[1]; r[2] = a[2]; r[3] = a[3]; r[4] = b[0]; r[5] = b[1]; r[6] = b[2]; r[7] = b[3]; return r; }
constexpr int AV_STRIDE = 144;
__device__ __forceinline__ void attn_unit(const bf16_t* PROJ, bf16_t* Y, int b, int h, int qb, LAS unsigned char* vlds, int lane) {
    const int r32 = lane & 31, hi = lane >> 5;
    const size_t rowbase = (size_t)b * SEQ;
    const int t0 = qb * 32;
    bf16x8 qf[4];
    { const bf16_t* qp = PROJ + (rowbase + t0 + r32) * 3072 + 1536 + h * 64 + 8 * hi;
#pragma unroll
      for (int kk = 0; kk < 4; ++kk) qf[kk] = *(const bf16x8*)(qp + 16 * kk); }
    f32x16 o0, o1;
#pragma unroll
    for (int i = 0; i < 16; ++i) { o0[i] = 0.f; o1[i] = 0.f; }
    float carry = 0.f;
    const int g4 = lane >> 4, li = lane & 15;
    const LAS unsigned char* trbase = vlds + (4 * (g4 >> 1) + (li >> 2)) * AV_STRIDE + (16 * (g4 & 1) + 4 * (li & 3)) * 2;
    bf16x8 kf[4]; u32x4 vr[4];
#define AT_LOAD(KF, VR, K0) do { const bf16_t* kp_ = PROJ + (rowbase + (K0) + r32) * 3072 + 2048 + h * 64 + 8 * hi; \
        _Pragma("unroll") for (int kk = 0; kk < 4; ++kk) KF[kk] = *(const bf16x8*)(kp_ + 16 * kk); \
        _Pragma("unroll") for (int j = 0; j < 4; ++j) VR[j] = *(const u32x4*)(PROJ + (rowbase + (K0) + (lane >> 3) + 8 * j) * 3072 + 2560 + h * 64 + 8 * (lane & 7)); } while (0)
    AT_LOAD(kf, vr, t0);
    for (int kt = qb; kt >= 0; --kt) {
#pragma unroll
        for (int j = 0; j < 4; ++j) *(LAS u32x4*)(vlds + ((lane >> 3) + 8 * j) * AV_STRIDE + 16 * (lane & 7)) = vr[j];
        bf16x8 kfn[4]; u32x4 vrn[4];
#pragma unroll
        for (int j = 0; j < 4; ++j) { kfn[j] = kf[j]; vrn[j] = vr[j]; }
        if (kt > 0) AT_LOAD(kfn, vrn, (kt - 1) * 32);
        f32x16 sc;
#pragma unroll
        for (int i = 0; i < 16; ++i) sc[i] = 0.f;
#pragma unroll
        for (int kk = 0; kk < 4; ++kk) sc = __builtin_amdgcn_mfma_f32_32x32x16_bf16(kf[kk], qf[kk], sc, 0, 0, 0);
        const bool diag = (kt == qb);
        float lk[16], lb[16];
#pragma unroll
        for (int r = 0; r < 16; ++r) {
            const float z = sc[r], az = __builtin_fabsf(z);
            const float L = __builtin_amdgcn_logf(1.0f + __builtin_amdgcn_exp2f(-az));
            float lbv = __builtin_fminf(z, 0.f) - L, lkv = lbv - z;
            if (diag) { const int key = (r & 3) + 8 * (r >> 2) + 4 * hi; if (!(key < r32)) { lkv = 0.f; lbv = -1.0e30f; } }
            lk[r] = lkv; lb[r] = lbv;
        }
        float gs[4], pg[4], T[4];
#pragma unroll
        for (int j = 0; j < 4; ++j) { gs[j] = (lk[4 * j] + lk[4 * j + 1]) + (lk[4 * j + 2] + lk[4 * j + 3]); pg[j] = __shfl_xor(gs[j], 32); T[j] = gs[j] + pg[j]; }
        float w[16];
        float suf = carry;
#pragma unroll
        for (int j = 3; j >= 0; --j) {
            float run = suf + (hi == 0 ? pg[j] : 0.f);
#pragma unroll
            for (int i = 3; i >= 0; --i) { w[4 * j + i] = __builtin_amdgcn_exp2f(lb[4 * j + i] + run); run += lk[4 * j + i]; }
            suf += T[j];
        }
        carry = suf;
        u32x4 p0, p1;
        p0.x = pk2(w[0], w[1]); p0.y = pk2(w[2], w[3]); p0.z = pk2(w[4], w[5]); p0.w = pk2(w[6], w[7]);
        p1.x = pk2(w[8], w[9]); p1.y = pk2(w[10], w[11]); p1.z = pk2(w[12], w[13]); p1.w = pk2(w[14], w[15]);
        const bf16x8 pf0 = __builtin_bit_cast(bf16x8, p0), pf1 = __builtin_bit_cast(bf16x8, p1);
        asm volatile("s_waitcnt lgkmcnt(0)" ::: "memory");
        const bf16x8 v00 = cat8(vtr(trbase), vtr(trbase + 8 * AV_STRIDE));
        const bf16x8 v01 = cat8(vtr(trbase + 16 * AV_STRIDE), vtr(trbase + 24 * AV_STRIDE));
        const bf16x8 v10 = cat8(vtr(trbase + 64), vtr(trbase + 8 * AV_STRIDE + 64));
        const bf16x8 v11 = cat8(vtr(trbase + 16 * AV_STRIDE + 64), vtr(trbase + 24 * AV_STRIDE + 64));
        o0 = __builtin_amdgcn_mfma_f32_32x32x16_bf16(v00, pf0, o0, 0, 0, 0);
        o0 = __builtin_amdgcn_mfma_f32_32x32x16_bf16(v01, pf1, o0, 0, 0, 0);
        o1 = __builtin_amdgcn_mfma_f32_32x32x16_bf16(v10, pf0, o1, 0, 0, 0);
        o1 = __builtin_amdgcn_mfma_f32_32x32x16_bf16(v11, pf1, o1, 0, 0, 0);
        if (__builtin_amdgcn_ballot_w64(carry > -160.0f) == 0ull) break;
#pragma unroll
        for (int j = 0; j < 4; ++j) { kf[j] = kfn[j]; vr[j] = vrn[j]; }
    }
#undef AT_LOAD
    bf16_t* yp = Y + (rowbase + t0 + r32) * 1024 + 512 + h * 64 + 4 * hi;
#pragma unroll
    for (int j = 0; j < 4; ++j) {
        u32x2 a; a.x = pk2(o0[4 * j], o0[4 * j + 1]); a.y = pk2(o0[4 * j + 2], o0[4 * j + 3]); *(u32x2*)(yp + 8 * j) = a;
        u32x2 c; c.x = pk2(o1[4 * j], o1[4 * j + 1]); c.y = pk2(o1[4 * j + 2], o1[4 * j + 3]); *(u32x2*)(yp + 32 + 8 * j) = c;
    }
}
__device__ __forceinline__ void mix0_phase(const Ptrs& P, LAS unsigned char* lds, int gw, int NGW, int wave, int lane) {
    const bf16_t* PROJ = (const bf16_t*)(P.ws + WS_PROJ); bf16_t* Y = (bf16_t*)(P.ws + WS_Y);
    LAS unsigned char* vlds = lds + wave * 8192;
#ifndef DBG_NO_ATTN
    for (int it = gw; it < BATCH * 8 * (SEQ / 32); it += NGW) { const int bh = it / (SEQ / 32), qb = it % (SEQ / 32); attn_unit(PROJ, Y, bh >> 3, bh & 7, qb, vlds, lane); }
#else
    for (int m = gw; m < M; m += NGW) { *(u32x4*)(Y + (size_t)m * 1024 + 512 + 8 * lane) = (u32x4){0u, 0u, 0u, 0u}; }
#endif
    for (int it = gw; it < M / 16; it += NGW) conv_item(PROJ, P.in[11], Y, it, lane);
}
constexpr int HS = 272;
constexpr int HL_QT = 0, HL_KT = 64 * HS, HL_KH = 2 * 64 * HS, HL_V = 3 * 64 * HS, HL_V2 = 4 * 64 * HS, HL_OUT = 4 * 64 * HS;
constexpr int HSC = 144;
constexpr int HL_SC = 5 * 64 * HS, HL_SEG = HL_SC + 64 * HSC, HL_DEC = HL_SEG + 8 * 128 * 4, HL_OSQ = HL_DEC + 512, HL_END = HL_OSQ + 64 * 8 * 4;
static_assert(HL_END <= 131072, "hgrn LDS map");
constexpr size_t WS_DTOT = 256 * 1024;
#define HG_BAR() do { asm volatile("s_waitcnt lgkmcnt(0)" ::: "memory"); __builtin_amdgcn_s_barrier(); asm volatile("" ::: "memory"); } while (0)
#define MFMA16(a, b, c) __builtin_amdgcn_mfma_f32_16x16x32_bf16((a), (b), (c), 0, 0, 0)
typedef float f32x2v __attribute__((ext_vector_type(2)));
template <bool FULL>
__device__ __forceinline__ void hgrn_unit(const Ptrs& P, LAS unsigned char* lds, int bh, int sc, int tid, int wave, int lane) {
    const bf16_t* Qs = (const bf16_t*)(P.ws + WS_QS); const float* LF = (const float*)(P.ws + WS_LF); const bf16_t* Iv = (const bf16_t*)(P.ws + WS_IV); const bf16_t* Gs = (const bf16_t*)(P.ws + WS_GS);
    bf16_t* Ob = (bf16_t*)P.out;
    float* SLOC = (float*)((unsigned char*)P.out + 64 * MiB);
    float* DTOT = (float*)(P.ws + WS_DTOT);
    const int b = bh >> 3, h = bh & 7, hc = h * 128;
    const int fr = lane & 15, fq = lane >> 4;
    const int kp = lane, seg = wave;
    f32x4 S[8];
    if (FULL && sc > 0) {
        const float* sp = SLOC + ((size_t)(bh * 16 + sc - 1) << 14) + 16 * wave + fr;
#pragma unroll
        for (int kt = 0; kt < 8; ++kt)
#pragma unroll
            for (int r = 0; r < 4; ++r) S[kt][r] = sp[(16 * kt + 4 * fq + r) * 128];
    } else {
#pragma unroll
        for (int kt = 0; kt < 8; ++kt) S[kt] = (f32x4){0.f, 0.f, 0.f, 0.f};
    }
    LAS float* segtot = (LAS float*)(lds + HL_SEG); LAS float* dec = (LAS float*)(lds + HL_DEC); LAS float* osq = (LAS float*)(lds + HL_OSQ);
    f32x4 on0, on1;
    if (FULL) { const float* onp = P.in[15] + 8 * (tid & 15); on0 = *(const f32x4*)onp; on1 = *(const f32x4*)(onp + 4); }
    float dprod0 = 1.f, dprod1 = 1.f;
    f32x2v lf2[8]; unsigned q2[8]; u32x4 vch[2], gch[2];
    const size_t Rbase = (size_t)b * SEQ + (size_t)sc * 256;
#define HG_LOAD_E(R0_) do { _Pragma("unroll") for (int i = 0; i < 8; ++i) { const size_t off = ((R0_) + 8 * seg + i) * 1024 + hc + 2 * kp; lf2[i] = *(const f32x2v*)(LF + off); if (FULL) q2[i] = *(const unsigned*)(Qs + off); } \
        _Pragma("unroll") for (int j = 0; j < 2; ++j) { const int ch = tid + 512 * j; vch[j] = *(const u32x4*)(Iv + ((R0_) + (ch >> 4)) * 1024 + hc + 8 * (ch & 15)); } } while (0)
#define HG_LOAD_G(R0_) do { _Pragma("unroll") for (int j = 0; j < 2; ++j) { const int ch = tid + 512 * j; gch[j] = *(const u32x4*)(Gs + ((R0_) + (ch >> 4)) * 1024 + hc + 8 * (ch & 15)); } } while (0)
    HG_LOAD_E(Rbase);
    if (FULL) HG_LOAD_G(Rbase);
#pragma unroll 1
    for (int c = 0; c < 4; ++c) {
        const size_t R0 = Rbase + (size_t)c * 64;
        const int vimg = FULL ? HL_V : ((c & 1) ? HL_V2 : HL_V);
        f32x2v cs[8]; { f32x2v run = (f32x2v){0.f, 0.f};
#pragma unroll
          for (int i = 0; i < 8; ++i) { run += lf2[i]; cs[i] = run; } }
        *(LAS f32x2v*)(segtot + seg * 128 + 2 * kp) = cs[7];
#pragma unroll
        for (int j = 0; j < 2; ++j) { const int ch = tid + 512 * j; *(LAS u32x4*)(lds + vimg + (ch >> 4) * HS + 16 * (ch & 15)) = vch[j]; }
        HG_BAR();
        f32x2v pre = (f32x2v){0.f, 0.f}, tot = (f32x2v){0.f, 0.f};
#pragma unroll
        for (int s2 = 0; s2 < 8; ++s2) { const f32x2v v = *(const LAS f32x2v*)(segtot + s2 * 128 + 2 * kp); tot += v; if (s2 < seg) pre += v; }
        const float dl0 = __builtin_amdgcn_exp2f(tot[0]), dl1 = __builtin_amdgcn_exp2f(tot[1]);
        if (seg == 0) { *(LAS f32x2v*)(dec + 2 * kp) = (f32x2v){dl0, dl1}; dprod0 *= dl0; dprod1 *= dl1; }
#pragma unroll
        for (int i = 0; i < 8; ++i) {
            const float b0 = pre[0] + cs[i][0], b1 = pre[1] + cs[i][1];
            const float k0 = (1.0f - __builtin_amdgcn_exp2f(lf2[i][0])) * __builtin_amdgcn_exp2f(-b0), k1 = (1.0f - __builtin_amdgcn_exp2f(lf2[i][1])) * __builtin_amdgcn_exp2f(-b1);
            const int o = (8 * seg + i) * HS + 4 * kp;
            *(LAS unsigned*)(lds + HL_KH + o) = pk2(k0 * dl0, k1 * dl1);
            if (FULL) {
                *(LAS unsigned*)(lds + HL_KT + o) = pk2(k0, k1);
                *(LAS unsigned*)(lds + HL_QT + o) = pk2(pg8::bf_lo(q2[i]) * __builtin_amdgcn_exp2f(b0), pg8::bf_hi(q2[i]) * __builtin_amdgcn_exp2f(b1));
            }
        }
        if (c < 3) HG_LOAD_E(R0 + 64);
        HG_BAR();
        f32x4 o[4];
        bf16x8 vf[2];
        if (FULL) {
            { const int tt = wave >> 1;
#pragma unroll
              for (int e = 0; e < 2; ++e) { const int st = 2 * (wave & 1) + e; const int t = 16 * tt + fr, s0 = 16 * st + 4 * fq;
                  u32x2 w = (u32x2){0u, 0u};
                  if (st <= tt) {
                      f32x4 a4 = (f32x4){0.f, 0.f, 0.f, 0.f};
#pragma unroll
                      for (int ks = 0; ks < 4; ++ks) {
                          const bf16x8 af = *(const LAS bf16x8*)(lds + HL_KT + (16 * st + fr) * HS + (32 * ks + 8 * fq) * 2);
                          const bf16x8 bfr = *(const LAS bf16x8*)(lds + HL_QT + (16 * tt + fr) * HS + (32 * ks + 8 * fq) * 2);
                          a4 = MFMA16(af, bfr, a4);
                      }
                      const float v0 = s0 + 0 <= t ? a4[0] : 0.f, v1 = s0 + 1 <= t ? a4[1] : 0.f, v2 = s0 + 2 <= t ? a4[2] : 0.f, v3 = s0 + 3 <= t ? a4[3] : 0.f;
                      w.x = pk2(v0, v1); w.y = pk2(v2, v3);
                  }
                  *(LAS u32x2*)(lds + HL_SC + t * HSC + s0 * 2) = w;
              } }
#pragma unroll
            for (int tt = 0; tt < 4; ++tt) o[tt] = (f32x4){0.f, 0.f, 0.f, 0.f};
#pragma unroll
            for (int ks = 0; ks < 4; ++ks) {
                u32x4 sb; sb.x = pk2(S[2 * ks][0], S[2 * ks][1]); sb.y = pk2(S[2 * ks][2], S[2 * ks][3]); sb.z = pk2(S[2 * ks + 1][0], S[2 * ks + 1][1]); sb.w = pk2(S[2 * ks + 1][2], S[2 * ks + 1][3]);
                const bf16x8 sfr = __builtin_bit_cast(bf16x8, sb);
#pragma unroll
                for (int tt = 0; tt < 4; ++tt) {
                    const LAS unsigned char* ap = lds + HL_QT + (16 * tt + fr) * HS + (32 * ks + 4 * fq) * 2;
                    const s16x4 a0 = *(const LAS s16x4*)ap, a1 = *(const LAS s16x4*)(ap + 32);
                    o[tt] = MFMA16(cat8(a0, a1), sfr, o[tt]);
                }
            }
        }
        { const LAS unsigned char* tb = lds + vimg + (8 * fq + (fr >> 2)) * HS + (16 * wave + 4 * (fr & 3)) * 2;
#pragma unroll
          for (int ss = 0; ss < 2; ++ss) vf[ss] = cat8(vtr(tb + (32 * ss) * HS), vtr(tb + (32 * ss + 4) * HS)); }
        f32x4 Sn[8];
#pragma unroll
        for (int kt = 0; kt < 8; ++kt) {
            const f32x4 d4 = *(const LAS f32x4*)(dec + 16 * kt + 4 * fq);
            f32x4 a4 = S[kt] * d4;
            const LAS unsigned char* tb = lds + HL_KH + (8 * fq + (fr >> 2)) * HS + (16 * kt + 4 * (fr & 3)) * 2;
#pragma unroll
            for (int ss = 0; ss < 2; ++ss) a4 = MFMA16(cat8(vtr(tb + (32 * ss) * HS), vtr(tb + (32 * ss + 4) * HS)), vf[ss], a4);
            Sn[kt] = a4;
        }
#pragma unroll
        for (int kt = 0; kt < 8; ++kt) S[kt] = Sn[kt];
        if (FULL) {
            HG_BAR();
#pragma unroll
            for (int ss = 0; ss < 2; ++ss)
#pragma unroll
                for (int tt = 0; tt < 4; ++tt) {
                    if (ss == 1 && tt < 2) continue;
                    const bf16x8 af = *(const LAS bf16x8*)(lds + HL_SC + (16 * tt + fr) * HSC + (32 * ss + 8 * fq) * 2);
                    o[tt] = MFMA16(af, vf[ss], o[tt]);
                }
#pragma unroll
            for (int tt = 0; tt < 4; ++tt)
#pragma unroll
                for (int r = 0; r < 4; ++r) { const int t = 16 * tt + 4 * fq + r; const float ov = o[tt][r]; float q = ov * ov;
                    *(LAS unsigned short*)(lds + HL_OUT + t * HS + (16 * wave + fr) * 2) = (unsigned short)f2bf(ov);
                    q += __shfl_xor(q, 1); q += __shfl_xor(q, 2); q += __shfl_xor(q, 4); q += __shfl_xor(q, 8);
                    if (fr == 0) osq[t * 8 + wave] = q; }
            HG_BAR();
#pragma unroll
            for (int j = 0; j < 2; ++j) { const int ch = tid + 512 * j, row = ch >> 4, c16 = ch & 15;
                const f32x4 qa = *(const LAS f32x4*)(osq + row * 8), qb = *(const LAS f32x4*)(osq + row * 8 + 4);
                const float rs = 1.0f / sqrtf((((qa[0] + qa[1]) + (qa[2] + qa[3])) + ((qb[0] + qb[1]) + (qb[2] + qb[3]))) * (1.0f / 128.0f) + 1e-6f);
                const u32x4 ow = *(const LAS u32x4*)(lds + HL_OUT + row * HS + 16 * c16);
                float ov[8], gv[8]; unpack8(ow, ov); unpack8(gch[j], gv);
                u32x4 w; w.x = pk2(ov[0] * rs * on0[0] * gv[0], ov[1] * rs * on0[1] * gv[1]); w.y = pk2(ov[2] * rs * on0[2] * gv[2], ov[3] * rs * on0[3] * gv[3]);
                w.z = pk2(ov[4] * rs * on1[0] * gv[4], ov[5] * rs * on1[1] * gv[5]); w.w = pk2(ov[6] * rs * on1[2] * gv[6], ov[7] * rs * on1[3] * gv[7]);
                *(u32x4*)(Ob + (R0 + row) * 1024 + hc + 8 * c16) = w; }
            if (c < 3) HG_LOAD_G(R0 + 64);
        }
    }
    if (!FULL) {
        float* sp = SLOC + ((size_t)(bh * 16 + sc) << 14) + 16 * wave + fr;
#pragma unroll
        for (int kt = 0; kt < 8; ++kt)
#pragma unroll
            for (int r = 0; r < 4; ++r) sp[(16 * kt + 4 * fq + r) * 128] = S[kt][r];
        if (seg == 0) *(f32x2v*)(DTOT + (bh * 16 + sc) * 128 + 2 * kp) = (f32x2v){dprod0, dprod1};
    }
    HG_BAR();
#undef HG_LOAD_E
#undef HG_LOAD_G
}
__device__ __forceinline__ void hgrn_scan(const Ptrs& P, int gw, int NGW, int lane) {
    float* SLOC = (float*)((unsigned char*)P.out + 64 * MiB); const float* DTOT = (const float*)(P.ws + WS_DTOT);
    for (int it = gw; it < 64 * 64; it += NGW) {
        const int bh = it >> 6, e0 = (it & 63) * 256 + lane * 4, k = e0 >> 7;
        f32x4 v[15]; float d[15];
#pragma unroll
        for (int s = 0; s < 15; ++s) { v[s] = *(const f32x4*)(SLOC + ((size_t)(bh * 16 + s) << 14) + e0); d[s] = DTOT[(bh * 16 + s) * 128 + k]; }
        f32x4 run = v[0];
#pragma unroll
        for (int s = 1; s < 15; ++s) { run = run * d[s] + v[s]; *(f32x4*)(SLOC + ((size_t)(bh * 16 + s) << 14) + e0) = run; }
    }
}
#ifndef MK_ONE_LAUNCH
#define MK_ONE_LAUNCH 1
#endif
#ifndef MK_XCD_BAR
#define MK_XCD_BAR 1
#endif
constexpr int N_PHASES = 18;
constexpr int RS_TAB_OFF = 131072 + 1024;
struct Args { Ptrs p; int ph_lo, ph_hi; };
__global__ void __launch_bounds__(NTHREADS, 2) fwd_kernel(Args args) {
    extern __shared__ __attribute__((aligned(16))) unsigned char lds_raw[];
    LAS unsigned char* lds = (LAS unsigned char*)lds_raw;
    const Ptrs& P = args.p;
    const int tid = threadIdx.x, lane = tid & 63, wave = __builtin_amdgcn_readfirstlane(tid >> 6);
    const int G = gridDim.x, bx = blockIdx.x;
    const int vcu = (G % 8 == 0) ? (bx % 8) * (G / 8) + bx / 8 : bx;
    const int gw = vcu * NWAVES + wave, NGW = G * NWAVES;
    unsigned char* ws = P.ws;
    bf16_t* H = (bf16_t*)(ws + WS_H); bf16_t* HID = (bf16_t*)(ws + WS_HID); float* SS = (float*)(ws + WS_SS);
    const int lo = args.ph_lo, hi = args.ph_hi;
#if MK_XCD_BAR
    volatile LAS unsigned* MISC = (volatile LAS unsigned*)(lds + LDS_BYTES - 256);
    if (tid < 32) MISC[tid] = 0u;
    __syncthreads();
    XcdBarrier bar = xcd_barrier_post((unsigned*)ws + 4096, MISC + 8);
#endif
#define IN(k) (lo <= (k) && (k) < hi)
#if MK_XCD_BAR
#define SEAM(k) do { if (IN(k) && IN((k) + 1)) { if ((k) == 0) cg::this_grid().sync(); else xcd_barrier(bar); } } while (0)
#else
#define SEAM(k) do { if (IN(k) && IN((k) + 1)) { cg::this_grid().sync(); } } while (0)
#endif
#define SSB(i) (SS + (size_t)(i) * M * 16)
#define GEMM_GU(f, ssi) do { pg8::Gemm g{H, (const bf16_t*)(ws + WS_GU) + (size_t)(f) * 5632 * 1024, M, 5632, D}; pg8::StaticOrder S; S.init(M, 5632, G, bx); \
        pg8::EpiSwiGLU E{HID, pg8::rs_table_build(lds + RS_TAB_OFF, SSB(ssi), S, tid), FF}; pg8::gemm_phase<pg8::EpiSwiGLU, pg8::StaticOrder, true, false>(lds, g, S, E); } while (0)
#define GEMM_DN(f, sso) do { pg8::Gemm g{HID, (const bf16_t*)(ws + WS_DN) + (size_t)(f) * 1024 * 2816, M, D, FF}; pg8::StaticOrder S; S.init(M, D, G, bx); \
        pg8::EpiResid<false> E{H, SSB(sso), 0.5f, nullptr}; pg8::gemm_phase<pg8::EpiResid<false>, pg8::StaticOrder, true, true>(lds, g, S, E); } while (0)

    if (IN(0)) { p0_prologue(P, lds, gw, NGW, wave, lane); }
#ifdef PROBE_P0
    __syncthreads(); if (IN(0)) { p0_prologue(P, lds, gw, NGW, wave, lane); }
#endif
    SEAM(0);
#ifdef PROBE_EARLYBAR
    xcd_barrier(bar);
#endif
    if (IN(1)) { GEMM_GU(0, 0); }
#ifdef PROBE_LATE_WG
    if (bx == PROBE_LATE_WG) { for (int d_ = 0; d_ < 400; ++d_) __builtin_amdgcn_s_sleep(127); }
#endif
#ifdef PROBE_BAR10
#if PROBE_BAR10 == 2
    asm volatile("s_waitcnt vmcnt(0)" ::: "memory"); __syncthreads();
    if (tid == 0) { __builtin_amdgcn_fence(__ATOMIC_RELEASE, "agent"); asm volatile("s_waitcnt vmcnt(0)" ::: "memory"); __builtin_amdgcn_fence(__ATOMIC_ACQUIRE, "agent"); asm volatile("s_waitcnt vmcnt(0)" ::: "memory"); }
    __syncthreads();
#elif PROBE_BAR10 == 4
    cg::this_grid().sync();
#elif PROBE_BAR10 == 3
    asm volatile("s_waitcnt vmcnt(0)" ::: "memory"); __syncthreads(); __syncthreads();
#else
    for (int i_ = 0; i_ < PROBE_BAR10; ++i_) { xcd_barrier(bar); }
#endif
#endif
#ifdef PROBE_GU2X
    xcd_barrier(bar); if (IN(1)) { GEMM_GU(0, 0); }
#endif
    SEAM(1);
#ifdef PROBE_DN2X
    if (IN(2)) { pg8::Gemm g{HID, (const bf16_t*)(ws + WS_DN), M, D, FF}; pg8::StaticOrder S; S.init(M, D, G, bx);
        pg8::EpiResid<false> E{H, SSB(1), 0.0f, nullptr}; pg8::gemm_phase<pg8::EpiResid<false>, pg8::StaticOrder, true, true>(lds, g, S, E); }
    xcd_barrier(bar);
#endif
    if (IN(2)) { GEMM_DN(0, 1); }
    SEAM(2);
    if (IN(3)) { pg8::Gemm g{H, (const bf16_t*)(ws + WS_ABIN), M, 3072, D}; pg8::StaticOrder S; S.init(M, 3072, G, bx);
        pg8::EpiProjAB E{(bf16_t*)(ws + WS_PROJ), pg8::rs_table_build(lds + RS_TAB_OFF, SSB(1), S, tid), QSCALE}; pg8::gemm_phase<pg8::EpiProjAB, pg8::StaticOrder, true, true>(lds, g, S, E); }
    SEAM(3);
    if (IN(4)) { mix0_phase(P, lds, gw, NGW, wave, lane); }
#ifdef PROBE_P4
    if (IN(4)) { mix0_phase(P, lds, gw, NGW, wave, lane); }
#endif
    SEAM(4);
    if (IN(5)) { pg8::Gemm g{(const bf16_t*)(ws + WS_Y), (const bf16_t*)(ws + WS_ABOUT), M, D, D}; pg8::StaticOrder S; S.init(M, D, G, bx);
        pg8::EpiResid<false> E{H, SSB(2), 1.0f, nullptr}; pg8::gemm_phase<pg8::EpiResid<false>, pg8::StaticOrder, true, true>(lds, g, S, E); }
    SEAM(5);
#ifdef PROBE_BAR_AT5
    xcd_barrier(bar);
#endif
    if (IN(6)) { GEMM_GU(1, 2); }
    SEAM(6);
#ifdef PROBE_BAR_AT6
    xcd_barrier(bar);
#endif
    if (IN(7)) { GEMM_DN(1, 3); }
    SEAM(7);
    if (IN(8)) { GEMM_GU(2, 3); }
    SEAM(8);
    if (IN(9)) { GEMM_DN(2, 4); }
    SEAM(9);
    if (IN(10)) { pg8::Gemm g{H, (const bf16_t*)(ws + WS_CIN), M, 4096, D}; pg8::StaticOrder S; S.init(M, 4096, G, bx);
        pg8::EpiProjC E{(bf16_t*)(ws + WS_QS), (float*)(ws + WS_LF), (bf16_t*)(ws + WS_IV), (bf16_t*)(ws + WS_GS), pg8::rs_table_build(lds + RS_TAB_OFF, SSB(4), S, tid), P.in[14]};
        pg8::gemm_phase<pg8::EpiProjC, pg8::StaticOrder, true, true>(lds, g, S, E); }
    SEAM(10);
    if (IN(11)) { for (int i = 0; i < 4; ++i) { const int uid = bx * 4 + i, bh = uid >> 4, sc = uid & 15; if (sc < 15 && bh < 64) hgrn_unit<false>(P, lds, bh, sc, tid, wave, lane); } }
    SEAM(11);
    if (IN(12)) { hgrn_scan(P, gw, NGW, lane); }
    SEAM(12);
    if (IN(13)) { for (int i = 0; i < 4; ++i) { const int uid = bx * 4 + i, bh = uid >> 4, sc = uid & 15; if (bh < 64) hgrn_unit<true>(P, lds, bh, sc, tid, wave, lane); } }
    SEAM(13);
    if (IN(14)) { pg8::Gemm g{(const bf16_t*)P.out, (const bf16_t*)(ws + WS_COUT), M, D, D}; pg8::StaticOrder S; S.init(M, D, G, bx);
        pg8::EpiResid<false> E{H, SSB(5), 1.0f, nullptr}; pg8::gemm_phase<pg8::EpiResid<false>, pg8::StaticOrder, true, true>(lds, g, S, E); }
    SEAM(14);
    if (IN(15)) { GEMM_GU(3, 5); }
    SEAM(15);
    if (IN(16)) { pg8::Gemm g{HID, (const bf16_t*)(ws + WS_DN) + (size_t)3 * 1024 * 2816, M, D, FF}; pg8::StaticOrder S; S.init(M, D, G, bx);
        pg8::EpiResid<false> E{H, SSB(6), 0.5f, nullptr}; pg8::gemm_phase<pg8::EpiResid<false>, pg8::StaticOrder, true, true>(lds, g, S, E); }
    SEAM(16);
    if (IN(17)) { final_norm(P, gw, NGW, lane); }
#ifdef PROBE_P17
    if (IN(17)) { final_norm(P, gw, NGW, lane); }
#endif
    if (IN(18)) {
        for (int m = gw; m < M; m += NGW) { const u32x2* hr = (const u32x2*)(H + (size_t)m * D) + lane; f32x4* orow = (f32x4*)(P.out + (size_t)m * D) + lane;
#pragma unroll
            for (int j = 0; j < 4; ++j) { const u32x2 w = hr[64 * j]; orow[64 * j] = (f32x4){pg8::bf_lo(w.x), pg8::bf_hi(w.x), pg8::bf_lo(w.y), pg8::bf_hi(w.y)}; } }
    }
}

extern "C" void kernel_launch(void* const* d_in, const int* in_sizes, int n_in, void* d_out, int out_size, void* d_ws, size_t ws_size, hipStream_t stream) {
    static int grid = 0;
    if (grid == 0) {
        if (n_in != 18 || in_sizes[0] != M * D || out_size != M * D || ws_size < WS_END) { fprintf(stderr, "kernel_launch: unexpected shapes (n_in %d, in0 %d, out %d, ws %zu)\n", n_in, n_in > 0 ? in_sizes[0] : -1, out_size, ws_size); grid = -1; return; }
        int dev = 0, cus = 0, per_cu = 0;
        hipGetDevice(&dev); hipDeviceGetAttribute(&cus, hipDeviceAttributeMultiprocessorCount, dev);
        if (hipFuncSetAttribute((const void*)fwd_kernel, hipFuncAttributeMaxDynamicSharedMemorySize, LDS_BYTES) != hipSuccess) { fprintf(stderr, "kernel_launch: hipFuncSetAttribute failed\n"); grid = -1; return; }
        if (hipOccupancyMaxActiveBlocksPerMultiprocessor(&per_cu, (const void*)fwd_kernel, NTHREADS, LDS_BYTES) != hipSuccess || per_cu < 1) { fprintf(stderr, "kernel_launch: occupancy query gives %d\n", per_cu); per_cu = 1; }
        (void)hipGetLastError();
        grid = cus;
    }
    if (grid < 0) return;
    Args a{};
    for (int i = 0; i < 18; ++i) a.p.in[i] = (const float*)d_in[i];
    a.p.out = (float*)d_out; a.p.ws = (unsigned char*)d_ws;
#if MK_ONE_LAUNCH
    if (hipMemsetAsync(d_ws, 0, 65536, stream) != hipSuccess) { fprintf(stderr, "kernel_launch: memset of the barrier words failed\n"); return; }
    a.ph_lo = 0; a.ph_hi = N_PHASES;
    void* kargs[] = {&a};
    hipError_t e = hipLaunchCooperativeKernel((const void*)fwd_kernel, dim3(grid), dim3(NTHREADS), kargs, LDS_BYTES, stream);
    if (e != hipSuccess) fprintf(stderr, "kernel_launch: cooperative launch failed: %s (grid %d)\n", hipGetErrorString(e), grid);
#else
#ifdef DBG_STOP
    for (int ph = 0; ph <= DBG_STOP; ++ph) { a.ph_lo = ph; a.ph_hi = ph + 1; hipLaunchKernelGGL(fwd_kernel, dim3(grid), dim3(NTHREADS), LDS_BYTES, stream, a); }
    a.ph_lo = 18; a.ph_hi = 19; hipLaunchKernelGGL(fwd_kernel, dim3(grid), dim3(NTHREADS), LDS_BYTES, stream, a);
#else
    for (int ph = 0; ph < N_PHASES; ++ph) { a.ph_lo = ph; a.ph_hi = ph + 1; hipLaunchKernelGGL(fwd_kernel, dim3(grid), dim3(NTHREADS), LDS_BYTES, stream, a); }
#endif
#endif
}
```

```cpp
#include <hip/hip_runtime.h>
#include <hip/hip_cooperative_groups.h>
#include <cstdio>
#include <cstdint>
namespace cg = cooperative_groups;
#define MK_ONE_LAUNCH 1
namespace pg8 {
#define PG8_LAS __attribute__((address_space(3)))
typedef unsigned short bf16_t;
typedef short bf16x8 __attribute__((ext_vector_type(8)));
typedef float f32x4 __attribute__((ext_vector_type(4)));
typedef unsigned u32x4 __attribute__((ext_vector_type(4)));
constexpr int BM = 256, BK = 64, HALF = 128, HTB = HALF * BK * 2  , STAGE_BYTES = 8 * HTB, NXCD = 8, WGM = 8;

__host__ __device__ __forceinline__ int lds_byte(int r, int c) { const int st = (r >> 4) * 2 + (c >> 5), rr = r & 15, cc = c & 31, ob = rr * 64 + cc * 2; return st * 1024 + (ob ^ (((ob >> 9) & 1) << 5)); }
__host__ __device__ __forceinline__ void stage_rc(int b, int& R, int& C) { const int st = b / 1024, sb = b % 1024, swz = sb ^ (((sb >> 9) & 1) << 5); R = (st >> 1) * 16 + swz / 64; C = (st & 1) * 32 + (swz % 64) / 2; }
__host__ __device__ __forceinline__ int perm32(int rho) { const int n = rho >> 4, i = rho & 15; return 8 * (i >> 2) + 4 * n + (i & 3); }

struct Unit { int pm, pn; };
struct Gemm { const bf16_t* A; const bf16_t* Bt; int M, N, K; };

struct StaticOrder {
    int nM, nN, nwg, G, c;
    __host__ __device__ void init(int M, int N, int G_, int c_) { nM = M / BM; nN = N / BM; nwg = nM * nN; G = G_; c = c_; }
    __host__ __device__ bool next(int i, Unit& u) const {
        const long L = (long)i * G + c; if (L >= nwg) return false;
        int wgid = (int)L; { const int q = nwg / NXCD, r = nwg % NXCD, xcd = wgid % NXCD, off = wgid / NXCD; wgid = (xcd < r ? xcd * (q + 1) : r * (q + 1) + (xcd - r) * q) + off; }
        const int nig = WGM * nN, gid = wgid / nig, fm = gid * WGM, gsz = (nM - fm) < WGM ? (nM - fm) : WGM;
        u.pm = fm + ((wgid % nig) % gsz); u.pn = (wgid % nig) / gsz; return true;
    }
    __device__ __forceinline__ void a_ready(const Unit&) const {}
    __device__ __forceinline__ void done(const Unit&) const {}
};

__device__ __forceinline__ unsigned cvt_pk_bf16(float lo, float hi) { unsigned r; asm volatile("v_cvt_pk_bf16_f32 %0, %1, %2" : "=v"(r) : "v"(lo), "v"(hi)); return r; }
typedef float f32x2 __attribute__((ext_vector_type(2)));
__device__ __forceinline__ float row_rstd(const float* ss, int row) {
    const f32x4* p = (const f32x4*)(ss + (size_t)row * 16);
    const f32x4 a = p[0], b = p[1], c = p[2], d = p[3];
    const float s = ((a[0] + a[1]) + (a[2] + a[3])) + ((b[0] + b[1]) + (b[2] + b[3])) + ((c[0] + c[1]) + (c[2] + c[3])) + ((d[0] + d[1]) + (d[2] + d[3]));
    return __builtin_amdgcn_rsqf(s * (1.0f / 1024.0f) + 1e-6f);
}
struct RsTab { const PG8_LAS float* tab; int pmA, pmB; const float* ss; };
template <class Sched> __device__ __forceinline__ RsTab rs_table_build(PG8_LAS unsigned char* lds_tab, const float* ss, const Sched& S, int tid) {
    RsTab t; t.tab = (const PG8_LAS float*)lds_tab; t.pmA = -1; t.pmB = -1; t.ss = ss;
    Unit u; for (int i = 0; S.next(i, u); ++i) { if (t.pmA < 0) t.pmA = u.pm; else if (u.pm != t.pmA && t.pmB < 0) t.pmB = u.pm; }
    const int pm = tid < 256 ? t.pmA : t.pmB;
    if (pm >= 0) ((PG8_LAS float*)lds_tab)[tid] = row_rstd(ss, pm * BM + (tid & 255));
    __syncthreads();
    return t;
}
__device__ __forceinline__ float rs_lookup(const RsTab& t, const Unit& u, int r  ) {
    if (u.pm == t.pmA) return t.tab[r];
    if (u.pm == t.pmB) return t.tab[256 + r];
    return row_rstd(t.ss, u.pm * BM + r);
}
__device__ __forceinline__ float sigmoidf_(float x) { return __builtin_amdgcn_rcpf(1.0f + __builtin_amdgcn_exp2f(-1.4426950408889634f * x)); }
__device__ __forceinline__ float siluf_(float x) { return x * sigmoidf_(x); }
__device__ __forceinline__ float bf_lo(unsigned w) { return __uint_as_float(w << 16); }
__device__ __forceinline__ float bf_hi(unsigned w) { return __uint_as_float(w & 0xffff0000u); }

struct EpiSwiGLU {
    static constexpr bool PERM = true, AFTER_DRAIN = false;
    bf16_t* O; RsTab rt; int ldo;
    struct Pre {};
    __device__ __forceinline__ Pre pre(const Unit&, int, int) const { return Pre{}; }
    __device__ __forceinline__ void operator()(const f32x4 (&acc)[2][2][4][2], const Unit& u, int wr, int wc, int fr, int fq, const Pre&) const {
        const int row0 = u.pm * BM + wr * 64 + fr, col0 = u.pn * HALF + wc * 32 + 8 * fq;
#pragma unroll
        for (int ai = 0; ai < 2; ++ai)
#pragma unroll
            for (int m = 0; m < 4; ++m) {
                const int row = row0 + ai * HALF + m * 16; const float rs = rs_lookup(rt, u, ai * HALF + wr * 64 + m * 16 + fr), c1 = -1.4426950408889634f * rs, rs2 = rs * rs;
                float h[8];
#pragma unroll
                for (int n = 0; n < 2; ++n)
#pragma unroll
                    for (int i = 0; i < 4; ++i) { const float g = acc[ai][0][m][n][i], up = acc[ai][1][m][n][i];
                        h[4 * n + i] = (g * up) * (rs2 * __builtin_amdgcn_rcpf(1.0f + __builtin_amdgcn_exp2f(g * c1))); }
                u32x4 w; w.x = cvt_pk_bf16(h[0], h[1]); w.y = cvt_pk_bf16(h[2], h[3]); w.z = cvt_pk_bf16(h[4], h[5]); w.w = cvt_pk_bf16(h[6], h[7]);
                *(u32x4*)(O + (size_t)row * ldo + col0) = w;
            }
    }
};
template <bool F32OUT> struct EpiResid {
    static constexpr bool PERM = true, AFTER_DRAIN = false;
    bf16_t* H; float* ssout; float alpha; float* out32;
    struct Pre {};
    __device__ __forceinline__ Pre pre(const Unit&, int, int) const { return Pre{}; }
    __device__ __forceinline__ void operator()(const f32x4 (&acc)[2][2][4][2], const Unit& u, int wr, int wc, int fr, int fq, const Pre&) const {
        const int row0 = u.pm * BM + wr * 64 + fr, col0 = u.pn * BM + wc * 32 + 8 * fq;
#pragma unroll
        for (int ai = 0; ai < 2; ++ai) {
            u32x4 old[4][2];
#pragma unroll
            for (int m = 0; m < 4; ++m)
#pragma unroll
                for (int bj = 0; bj < 2; ++bj) old[m][bj] = *(const u32x4*)(H + (size_t)(row0 + ai * HALF + m * 16) * 1024 + col0 + bj * HALF);
#pragma unroll
            for (int m = 0; m < 4; ++m) {
                const int row = row0 + ai * HALF + m * 16; float sq = 0.f;
#pragma unroll
                for (int bj = 0; bj < 2; ++bj) {
                    bf16_t* hp = H + (size_t)row * 1024 + col0 + bj * HALF;
                    const u32x4 o4 = old[m][bj];
                    float v[8];
                    v[0] = bf_lo(o4.x); v[1] = bf_hi(o4.x); v[2] = bf_lo(o4.y); v[3] = bf_hi(o4.y); v[4] = bf_lo(o4.z); v[5] = bf_hi(o4.z); v[6] = bf_lo(o4.w); v[7] = bf_hi(o4.w);
#pragma unroll
                    for (int n = 0; n < 2; ++n)
#pragma unroll
                        for (int i = 0; i < 4; ++i) { v[4 * n + i] += alpha * acc[ai][bj][m][n][i]; sq += v[4 * n + i] * v[4 * n + i]; }
                    u32x4 w; w.x = cvt_pk_bf16(v[0], v[1]); w.y = cvt_pk_bf16(v[2], v[3]); w.z = cvt_pk_bf16(v[4], v[5]); w.w = cvt_pk_bf16(v[6], v[7]);
                    *(u32x4*)hp = w;
                    if (F32OUT) { float* op = out32 + (size_t)row * 1024 + col0 + bj * HALF; *(f32x4*)op = (f32x4){v[0], v[1], v[2], v[3]}; *(f32x4*)(op + 4) = (f32x4){v[4], v[5], v[6], v[7]}; }
                }
                sq += __shfl_xor(sq, 16); sq += __shfl_xor(sq, 32);
                if (fq == 0) ssout[(size_t)row * 16 + u.pn * 4 + wc] = sq;
            }
        }
    }
};
struct EpiFinalNorm {
    static constexpr bool PERM = false, AFTER_DRAIN = false;
    const bf16_t* H; float* out; const float* gain; float alpha;
    float* xslots;
    unsigned* cnt;
    PG8_LAS unsigned char* xl;
    struct Pre {};
    __device__ __forceinline__ Pre pre(const Unit&, int, int) const { return Pre{}; }
    __device__ __forceinline__ void operator()(f32x4 (&acc)[2][2][4][2], const Unit& u, int wr, int wc, int fr, int fq, const Pre&) const {
        const int tid = threadIdx.x, lane = tid & 63, wid = __builtin_amdgcn_readfirstlane(tid >> 6);
        PG8_LAS float* P = (PG8_LAS float*)xl; PG8_LAS float* S = (PG8_LAS float*)(xl + 4096);
        const int row0 = u.pm * BM + wr * 64 + fr, col0 = u.pn * BM + wc * 32 + 4 * fq;
        typedef unsigned u32x2_t __attribute__((ext_vector_type(2)));
#pragma unroll
        for (int ai = 0; ai < 2; ++ai)
#pragma unroll
            for (int m = 0; m < 4; ++m) {
                const int row = row0 + ai * HALF + m * 16; float sq = 0.f;
#pragma unroll
                for (int bj = 0; bj < 2; ++bj)
#pragma unroll
                    for (int n = 0; n < 2; ++n) {
                        const u32x2_t o = *(const u32x2_t*)(H + (size_t)row * 1024 + col0 + bj * HALF + n * 16);
                        f32x4 v = (f32x4){bf_lo(o.x), bf_hi(o.x), bf_lo(o.y), bf_hi(o.y)} + alpha * acc[ai][bj][m][n];
                        acc[ai][bj][m][n] = v; sq += (v[0] * v[0] + v[1] * v[1]) + (v[2] * v[2] + v[3] * v[3]);
                    }
                sq += __shfl_xor(sq, 16); sq += __shfl_xor(sq, 32);
                if (fq == 0) P[(ai * HALF + wr * 64 + m * 16 + fr) * 4 + wc] = sq;
            }
        asm volatile("s_waitcnt lgkmcnt(0)" ::: "memory"); __builtin_amdgcn_s_barrier(); asm volatile("" ::: "memory");
        if (tid < 256) { const f32x4 p = *(const PG8_LAS f32x4*)(P + tid * 4);
            __hip_atomic_store(xslots + ((size_t)u.pm * BM + tid) * 4 + u.pn, (p[0] + p[1]) + (p[2] + p[3]), __ATOMIC_RELAXED, __HIP_MEMORY_SCOPE_AGENT); }
        asm volatile("s_waitcnt vmcnt(0)" ::: "memory");
        if (tid < 256 && lane == 0) __hip_atomic_fetch_add(cnt + 64 * u.pm, 1u, __ATOMIC_RELAXED, __HIP_MEMORY_SCOPE_AGENT);
        if (wid == 0) {
            unsigned sp = 0;
            while ((unsigned)__builtin_amdgcn_readfirstlane(__hip_atomic_load(cnt + 64 * u.pm, __ATOMIC_RELAXED, __HIP_MEMORY_SCOPE_AGENT)) < 16u) { __builtin_amdgcn_s_sleep(2); if (++sp > (1u << 18)) break; }
            __builtin_amdgcn_fence(__ATOMIC_ACQUIRE, "agent");
        }
        asm volatile("s_waitcnt vmcnt(0) lgkmcnt(0)" ::: "memory"); __builtin_amdgcn_s_barrier(); asm volatile("" ::: "memory");
        if (tid < 256) { const float* sl = xslots + ((size_t)u.pm * BM + tid) * 4;
            const float t = (__hip_atomic_load(sl, __ATOMIC_RELAXED, __HIP_MEMORY_SCOPE_AGENT) + __hip_atomic_load(sl + 1, __ATOMIC_RELAXED, __HIP_MEMORY_SCOPE_AGENT))
                          + (__hip_atomic_load(sl + 2, __ATOMIC_RELAXED, __HIP_MEMORY_SCOPE_AGENT) + __hip_atomic_load(sl + 3, __ATOMIC_RELAXED, __HIP_MEMORY_SCOPE_AGENT));
            S[tid] = __builtin_amdgcn_rsqf(t * (1.0f / 1024.0f) + 1e-6f); }
        asm volatile("s_waitcnt lgkmcnt(0)" ::: "memory"); __builtin_amdgcn_s_barrier(); asm volatile("" ::: "memory");
        f32x4 gv[2][2];
#pragma unroll
        for (int bj = 0; bj < 2; ++bj)
#pragma unroll
            for (int n = 0; n < 2; ++n) gv[bj][n] = *(const f32x4*)(gain + col0 + bj * HALF + n * 16);
#pragma unroll
        for (int ai = 0; ai < 2; ++ai)
#pragma unroll
            for (int m = 0; m < 4; ++m) {
                const int r = ai * HALF + wr * 64 + m * 16 + fr; const float rs = S[r];
                float* op = out + (size_t)(u.pm * BM + r) * 1024 + col0;
#pragma unroll
                for (int bj = 0; bj < 2; ++bj)
#pragma unroll
                    for (int n = 0; n < 2; ++n) __builtin_nontemporal_store(acc[ai][bj][m][n] * rs * gv[bj][n], (f32x4*)(op + bj * HALF + n * 16));
            }
    }
};
struct EpiProjAB {
    static constexpr bool PERM = true, AFTER_DRAIN = false;
    bf16_t* O; RsTab rt; float qscale;
    struct Pre {};
    __device__ __forceinline__ Pre pre(const Unit&, int, int) const { return Pre{}; }
    __device__ __forceinline__ void operator()(const f32x4 (&acc)[2][2][4][2], const Unit& u, int wr, int wc, int fr, int fq, const Pre&) const {
        const int row0 = u.pm * BM + wr * 64 + fr, col0 = u.pn * BM + wc * 32 + 8 * fq;
        const float sc = (u.pn == 6 || u.pn == 7) ? qscale : 1.0f;
#pragma unroll
        for (int ai = 0; ai < 2; ++ai)
#pragma unroll
            for (int m = 0; m < 4; ++m) {
                const int row = row0 + ai * HALF + m * 16; const float rs = rs_lookup(rt, u, ai * HALF + wr * 64 + m * 16 + fr) * sc;
#pragma unroll
                for (int bj = 0; bj < 2; ++bj) {
                    const f32x4 a = acc[ai][bj][m][0] * rs, b = acc[ai][bj][m][1] * rs;
                    u32x4 w; w.x = cvt_pk_bf16(a[0], a[1]); w.y = cvt_pk_bf16(a[2], a[3]); w.z = cvt_pk_bf16(b[0], b[1]); w.w = cvt_pk_bf16(b[2], b[3]);
                    *(u32x4*)(O + (size_t)row * 3072 + col0 + bj * HALF) = w;
                }
            }
    }
};
struct EpiProjC {
    static constexpr bool PERM = true, AFTER_DRAIN = false;
    bf16_t* Qs; float* LF; bf16_t* Iv; bf16_t* Gs; RsTab rt; const float* clb;
    struct Pre {};
    __device__ __forceinline__ Pre pre(const Unit&, int, int) const { return Pre{}; }
    __device__ __forceinline__ void operator()(const f32x4 (&acc)[2][2][4][2], const Unit& u, int wr, int wc, int fr, int fq, const Pre&) const {
        const int kind = u.pn >> 2;
        const int row0 = u.pm * BM + wr * 64 + fr, col0 = (u.pn & 3) * BM + wc * 32 + 8 * fq;
        if (kind == 1) {
            float lb[2][8];
#pragma unroll
            for (int bj = 0; bj < 2; ++bj)
#pragma unroll
                for (int j = 0; j < 8; ++j) { const int c = col0 + bj * HALF + j; lb[bj][j] = sigmoidf_(clb[1024 + c] - clb[c]); }
#pragma unroll
            for (int ai = 0; ai < 2; ++ai)
#pragma unroll
                for (int m = 0; m < 4; ++m) {
                    const int row = row0 + ai * HALF + m * 16; const float rs = rs_lookup(rt, u, ai * HALF + wr * 64 + m * 16 + fr);
#pragma unroll
                    for (int bj = 0; bj < 2; ++bj) {
                        float v[8];
#pragma unroll
                        for (int n = 0; n < 2; ++n)
#pragma unroll
                            for (int i = 0; i < 4; ++i) { const float x = acc[ai][bj][m][n][i] * rs, l = lb[bj][4 * n + i]; v[4 * n + i] = __builtin_amdgcn_logf(l + (1.0f - l) * sigmoidf_(x)); }
                        float* op = LF + (size_t)row * 1024 + col0 + bj * HALF; *(f32x4*)op = (f32x4){v[0], v[1], v[2], v[3]}; *(f32x4*)(op + 4) = (f32x4){v[4], v[5], v[6], v[7]};
                    }
                }
        } else {
            bf16_t* O = Qs + (kind ? ((size_t)(64 + 64 * kind) << 19) : (size_t)0);
            const bool act = kind != 2;
#pragma unroll
            for (int ai = 0; ai < 2; ++ai)
#pragma unroll
                for (int m = 0; m < 4; ++m) {
                    const int row = row0 + ai * HALF + m * 16; const float rs = rs_lookup(rt, u, ai * HALF + wr * 64 + m * 16 + fr);
#pragma unroll
                    for (int bj = 0; bj < 2; ++bj) {
                        float v[8];
#pragma unroll
                        for (int n = 0; n < 2; ++n)
#pragma unroll
                            for (int i = 0; i < 4; ++i) { const float x = acc[ai][bj][m][n][i] * rs; v[4 * n + i] = act ? siluf_(x) : x; }
                        u32x4 w; w.x = cvt_pk_bf16(v[0], v[1]); w.y = cvt_pk_bf16(v[2], v[3]); w.z = cvt_pk_bf16(v[4], v[5]); w.w = cvt_pk_bf16(v[6], v[7]);
                        *(u32x4*)(O + (size_t)row * 1024 + col0 + bj * HALF) = w;
                    }
                }
        }
    }
};
template <class Epi, class Sched, bool ALIGN_EPI = false, bool SP2 = false>
__device__ __forceinline__ void gemm_phase(PG8_LAS unsigned char* lds, const Gemm g, const Sched& S, const Epi& E) {
    const int tid = threadIdx.x, wid = __builtin_amdgcn_readfirstlane(tid >> 6), lane = tid & 63, wr = wid >> 2, wc = wid & 3, fr = lane & 15, fq = lane >> 4;
    const int K = g.K, nt = K / BK;
    unsigned voffA[2], voffB[2];
#pragma unroll
    for (int i = 0; i < 2; ++i) { int R, C; stage_rc(tid * 16 + i * 8192, R, C); const int Rb = Epi::PERM ? ((R & ~31) + perm32(R & 31)) : R;
        voffA[i] = (unsigned)(R * K + C) * 2u; voffB[i] = (unsigned)(Rb * K + C) * 2u; }
    const size_t kstep = (size_t)(BK * 2);
    const size_t hstep = (size_t)HALF * K * 2;
    const size_t tstep = 2 * hstep;
    const unsigned ldsw = (unsigned)wid * 1024u;
    const int aoff = lds_byte(wr * 64 + fr, fq * 8), boff = lds_byte(wc * 32 + fr, fq * 8);
#define PG8_SA(b, h) (((b) * 2 + (h)) * HTB)
#define PG8_SB(b, h) ((4 + (b) * 2 + (h)) * HTB)
#define PG8_STAGE(bufoff, gbase, voff) do { _Pragma("unroll") for (int _i = 0; _i < 2; ++_i) \
        __builtin_amdgcn_global_load_lds((const unsigned*)((const char*)(gbase) + (voff)[_i]), (PG8_LAS unsigned*)(lds + (bufoff) + ldsw + _i * 8192), 16, 0, 0); } while (0)
#define PG8_LDA(dst, b, h) do { _Pragma("unroll") for (int m = 0; m < 4; ++m) _Pragma("unroll") for (int k = 0; k < 2; ++k) dst[m][k] = *(const PG8_LAS bf16x8*)(lds + PG8_SA(b, h) + aoff + m * 2048 + k * 1024); } while (0)
#define PG8_LDB(dst, b, h) do { _Pragma("unroll") for (int n = 0; n < 2; ++n) _Pragma("unroll") for (int k = 0; k < 2; ++k) dst[n][k] = *(const PG8_LAS bf16x8*)(lds + PG8_SB(b, h) + boff + n * 2048 + k * 1024); } while (0)
#define PG8_MMA(ai, bj, At, Bt) do { __builtin_amdgcn_s_setprio(1); _Pragma("unroll") for (int m = 0; m < 4; ++m) _Pragma("unroll") for (int n = 0; n < 2; ++n) _Pragma("unroll") for (int k = 0; k < 2; ++k) \
        acc[ai][bj][m][n] = __builtin_amdgcn_mfma_f32_16x16x32_bf16(Bt[n][k], At[m][k], acc[ai][bj][m][n], 0, 0, 0); __builtin_amdgcn_s_setprio(0); } while (0)
#define PG8_WAIT_V(n) asm volatile("s_waitcnt vmcnt(" #n ")" ::: "memory")
#define PG8_WAIT_L(n) asm volatile("s_waitcnt lgkmcnt(" #n ")" ::: "memory")
#define PG8_BAR __builtin_amdgcn_s_barrier()
#define PG8_SCHED __builtin_amdgcn_sched_barrier(0)
    Unit cur, nxt; int ui = 0;
    if (!S.next(0, cur)) return;
    f32x4 acc[2][2][4][2];
#pragma unroll
    for (int a = 0; a < 2; ++a)
#pragma unroll
        for (int b = 0; b < 2; ++b)
#pragma unroll
            for (int m = 0; m < 4; ++m)
#pragma unroll
                for (int n = 0; n < 2; ++n) acc[a][b][m][n] = (f32x4){0.f, 0.f, 0.f, 0.f};
    bf16x8 At[4][2], B0[2][2], B1[2][2];
    const char* cA = (const char*)g.A + (size_t)cur.pm * tstep; const char* cB = (const char*)g.Bt + (size_t)cur.pn * tstep;
    S.a_ready(cur);
    if constexpr (SP2) {
        PG8_STAGE(PG8_SB(0, 0), cB, voffB); PG8_STAGE(PG8_SB(0, 1), cB + hstep, voffB); PG8_STAGE(PG8_SA(0, 0), cA, voffA); PG8_STAGE(PG8_SA(0, 1), cA + hstep, voffA);
        if (wr == 1) PG8_BAR;
        PG8_WAIT_V(2); PG8_BAR;
        PG8_STAGE(PG8_SB(1, 0), cB + kstep, voffB); PG8_STAGE(PG8_SA(1, 0), cA + kstep, voffA); PG8_STAGE(PG8_SB(1, 1), cB + hstep + kstep, voffB);
        PG8_WAIT_V(6); PG8_BAR;
    } else {
        PG8_STAGE(PG8_SB(0, 0), cB, voffB); PG8_STAGE(PG8_SA(0, 0), cA, voffA); PG8_STAGE(PG8_SB(0, 1), cB + hstep, voffB); PG8_STAGE(PG8_SA(0, 1), cA + hstep, voffA);
        if (wr == 1) PG8_BAR;
        PG8_WAIT_V(4); PG8_BAR;
        PG8_STAGE(PG8_SB(1, 0), cB + kstep, voffB); PG8_STAGE(PG8_SA(1, 0), cA + kstep, voffA); PG8_STAGE(PG8_SB(1, 1), cB + hstep + kstep, voffB);
        PG8_WAIT_V(6); PG8_BAR;
    }
    for (;;) {
        const bool has_next = S.next(ui + 1, nxt);
        const char* nA = has_next ? (const char*)g.A + (size_t)nxt.pm * tstep : cA; const char* nB = has_next ? (const char*)g.Bt + (size_t)nxt.pn * tstep : cB;
        for (int t = 0; t < nt; t += 2) {
            const bool last = (t == nt - 2);
            const char* a1 = cA + (size_t)(t + 1) * kstep;
            const char* a2 = last ? nA : cA + (size_t)(t + 2) * kstep; const char* b2 = last ? nB : cB + (size_t)(t + 2) * kstep;
            const char* a3 = a2 + kstep; const char* b3 = b2 + kstep;
            if (last && has_next) S.a_ready(nxt);
            if constexpr (SP2) {
            PG8_LDB(B0, 0, 0); PG8_LDB(B1, 0, 1); PG8_SCHED; PG8_LDA(At, 0, 0); PG8_STAGE(PG8_SA(1, 1), a1 + hstep, voffA);
            PG8_WAIT_V(8); PG8_WAIT_L(0); PG8_BAR; PG8_MMA(0, 0, At, B0); PG8_MMA(0, 1, At, B1); PG8_BAR; PG8_SCHED;
            PG8_LDA(At, 0, 1); PG8_STAGE(PG8_SB(0, 0), b2, voffB); PG8_STAGE(PG8_SB(0, 1), b2 + hstep, voffB); PG8_STAGE(PG8_SA(0, 0), a2, voffA);
            PG8_WAIT_V(8); PG8_WAIT_L(0); PG8_BAR; PG8_MMA(1, 0, At, B0); PG8_MMA(1, 1, At, B1); PG8_BAR; PG8_SCHED;
            PG8_LDB(B0, 1, 0); PG8_LDB(B1, 1, 1); PG8_SCHED; PG8_LDA(At, 1, 0); PG8_STAGE(PG8_SA(0, 1), a2 + hstep, voffA);
            PG8_WAIT_V(8); PG8_WAIT_L(0); PG8_BAR; PG8_MMA(0, 0, At, B0); PG8_MMA(0, 1, At, B1); PG8_BAR; PG8_SCHED;
            PG8_LDA(At, 1, 1); PG8_STAGE(PG8_SB(1, 0), b3, voffB); PG8_STAGE(PG8_SB(1, 1), b3 + hstep, voffB); PG8_STAGE(PG8_SA(1, 0), a3, voffA);
            PG8_WAIT_V(8); PG8_WAIT_L(0); PG8_BAR; PG8_MMA(1, 0, At, B0); PG8_MMA(1, 1, At, B1); PG8_BAR; PG8_SCHED;
            } else {
            PG8_LDB(B0, 0, 0); PG8_SCHED; PG8_LDA(At, 0, 0); PG8_STAGE(PG8_SA(1, 1), a1 + hstep, voffA);
            PG8_WAIT_L(8); PG8_BAR; PG8_WAIT_L(0); PG8_MMA(0, 0, At, B0); PG8_BAR; PG8_SCHED;
            PG8_LDB(B1, 0, 1); PG8_STAGE(PG8_SB(0, 0), b2, voffB);
            PG8_BAR; PG8_WAIT_L(0); PG8_MMA(0, 1, At, B1); PG8_BAR;
            PG8_LDA(At, 0, 1); PG8_STAGE(PG8_SA(0, 0), a2, voffA);
            PG8_BAR; PG8_WAIT_L(0); PG8_MMA(1, 0, At, B0); PG8_BAR; PG8_SCHED;
            PG8_STAGE(PG8_SB(0, 1), b2 + hstep, voffB);
            PG8_WAIT_V(6); PG8_BAR; PG8_MMA(1, 1, At, B1); PG8_BAR;
            PG8_LDB(B0, 1, 0); PG8_SCHED; PG8_LDA(At, 1, 0); PG8_STAGE(PG8_SA(0, 1), a2 + hstep, voffA);
            PG8_WAIT_L(8); PG8_BAR; PG8_WAIT_L(0); PG8_MMA(0, 0, At, B0); PG8_BAR; PG8_SCHED;
            PG8_LDB(B1, 1, 1); PG8_STAGE(PG8_SB(1, 0), b3, voffB);
            PG8_BAR; PG8_WAIT_L(0); PG8_MMA(0, 1, At, B1); PG8_BAR;
            PG8_LDA(At, 1, 1); PG8_STAGE(PG8_SA(1, 0), a3, voffA);
            PG8_BAR; PG8_WAIT_L(0); PG8_MMA(1, 0, At, B0); PG8_BAR; PG8_SCHED;
            PG8_STAGE(PG8_SB(1, 1), b3 + hstep, voffB);
            PG8_WAIT_V(6); PG8_BAR; PG8_MMA(1, 1, At, B1); PG8_BAR;
            }
        }
        if constexpr (ALIGN_EPI) { if (wr == 0) PG8_BAR; }
        if constexpr (!Epi::AFTER_DRAIN) { E(acc, cur, wr, wc, fr, fq, E.pre(cur, wr, lane)); S.done(cur); }
        if (!has_next) break;
#pragma unroll
        for (int a = 0; a < 2; ++a)
#pragma unroll
            for (int b = 0; b < 2; ++b)
#pragma unroll
                for (int m = 0; m < 4; ++m)
#pragma unroll
                    for (int n = 0; n < 2; ++n) acc[a][b][m][n] = (f32x4){0.f, 0.f, 0.f, 0.f};
        cur = nxt; cA = nA; cB = nB; ++ui;
        if constexpr (ALIGN_EPI) { if (wr == 1) PG8_BAR; }
    }
    PG8_WAIT_V(0);
    if constexpr (!ALIGN_EPI) { if (wr == 0) PG8_BAR; }
    PG8_BAR;
    if constexpr (Epi::AFTER_DRAIN) { E.fused(acc, cur, wr, wc, fr, fq, lds, wid, lane); S.done(cur); }
#undef PG8_SA
#undef PG8_SB
#undef PG8_STAGE
#undef PG8_LDA
#undef PG8_LDB
#undef PG8_MMA
#undef PG8_WAIT_V
#undef PG8_WAIT_L
#undef PG8_BAR
#undef PG8_SCHED
}
}
using pg8::bf16_t; using pg8::bf16x8; using pg8::f32x4; using pg8::u32x4;
typedef float f32x16 __attribute__((ext_vector_type(16)));
typedef short s16x4 __attribute__((ext_vector_type(4)));
typedef unsigned u32x2 __attribute__((ext_vector_type(2)));
#define LAS __attribute__((address_space(3)))
constexpr int NWAVES = 8, NTHREADS = 512;
constexpr int BATCH = 8, SEQ = 4096, D = 1024, FF = 2816, M = BATCH * SEQ;
constexpr float QSCALE = 0.125f * 1.4426950408889634f;
constexpr size_t MiB = 1u << 20;
constexpr size_t WS_GU = 1 * MiB;
constexpr size_t WS_DN = WS_GU + 44 * MiB;
constexpr size_t WS_ABIN = WS_DN + 22 * MiB;
constexpr size_t WS_ABOUT = WS_ABIN + 6 * MiB;
constexpr size_t WS_CIN = WS_ABOUT + 2 * MiB;
constexpr size_t WS_COUT = WS_CIN + 8 * MiB;
constexpr size_t WS_H = WS_COUT + 2 * MiB;
constexpr size_t WS_SS = WS_H + 64 * MiB;
constexpr size_t WS_R = WS_SS + 14 * MiB;
constexpr size_t WS_HID = WS_R, WS_PROJ = WS_R, WS_Y = WS_R + 192 * MiB;
constexpr size_t WS_QS = WS_R, WS_LF = WS_R + 64 * MiB, WS_IV = WS_R + 192 * MiB, WS_GS = WS_R + 256 * MiB;
constexpr size_t WS_END = WS_R + 320 * MiB;
static_assert(WS_END <= 512 * MiB, "workspace map");
constexpr int LDS_BYTES = 147456;

__device__ __forceinline__ unsigned f2bf(float f) { unsigned u = __builtin_bit_cast(unsigned, f); return (u + 0x7fffu + ((u >> 16) & 1u)) >> 16; }
__device__ __forceinline__ unsigned pk2(float lo, float hi) { return pg8::cvt_pk_bf16(lo, hi); }
__device__ __forceinline__ float wave_sum(float v) {
#pragma unroll
    for (int o = 1; o < 64; o <<= 1) v += __shfl_xor(v, o);
    return v;
}
constexpr int P0_SCR = 64 * 65 * 4;
__device__ __forceinline__ void p0_transpose_item(const float* W, int K, int N, const float* gain, bf16_t* WT, int k0, int n0, int orow0, LAS float* scr, int lane) {
    const int lr = lane >> 4, lc = (lane & 15) * 4;
    f32x4 v[16];
#pragma unroll
    for (int j = 0; j < 16; ++j) v[j] = __builtin_nontemporal_load((const f32x4*)(W + (size_t)(k0 + 4 * j + lr) * N + n0 + lc));
    if (gain) {
#pragma unroll
        for (int j = 0; j < 16; ++j) v[j] = v[j] * gain[k0 + 4 * j + lr];
    }
#pragma unroll
    for (int j = 0; j < 16; ++j) { LAS float* d = scr + (4 * j + lr) * 65 + lc; d[0] = v[j][0]; d[1] = v[j][1]; d[2] = v[j][2]; d[3] = v[j][3]; }
    asm volatile("s_waitcnt lgkmcnt(0)" ::: "memory");
    const int c = lane & 7;
#pragma unroll
    for (int j = 0; j < 8; ++j) { const int n = (lane >> 3) + 8 * j; const LAS float* s = scr + (8 * c) * 65 + n;
        u32x4 o; o.x = pk2(s[0 * 65], s[1 * 65]); o.y = pk2(s[2 * 65], s[3 * 65]); o.z = pk2(s[4 * 65], s[5 * 65]); o.w = pk2(s[6 * 65], s[7 * 65]);
        *(u32x4*)(WT + (size_t)(orow0 + n) * K + k0 + 8 * c) = o; }
    asm volatile("s_waitcnt lgkmcnt(0)" ::: "memory");
}
struct Ptrs {
    const float* in[18]; float* out; unsigned char* ws;
};
__device__ __forceinline__ void p0_prologue(const Ptrs& P, LAS unsigned char* lds, int gw, int NGW, int wave, int lane) {
    unsigned char* ws = P.ws;
    const float* x = P.in[0]; bf16_t* H = (bf16_t*)(ws + WS_H); float* ss0 = (float*)(ws + WS_SS);
    for (int m0 = gw * 4; m0 < M; m0 += NGW * 4) {
        f32x4 v[4][4];
#pragma unroll
        for (int r = 0; r < 4; ++r)
#pragma unroll
            for (int j = 0; j < 4; ++j) v[r][j] = __builtin_nontemporal_load((const f32x4*)(x + (size_t)(m0 + r) * D) + lane + 64 * j);
#pragma unroll
        for (int r = 0; r < 4; ++r) {
            float s = 0.f;
#pragma unroll
            for (int j = 0; j < 4; ++j) s += (v[r][j][0] * v[r][j][0] + v[r][j][1] * v[r][j][1]) + (v[r][j][2] * v[r][j][2] + v[r][j][3] * v[r][j][3]);
            s = wave_sum(s);
            u32x2* o8 = (u32x2*)(H + (size_t)(m0 + r) * D) + lane;
#pragma unroll
            for (int j = 0; j < 4; ++j) { u32x2 w; w.x = pk2(v[r][j][0], v[r][j][1]); w.y = pk2(v[r][j][2], v[r][j][3]); o8[64 * j] = w; }
            if (lane < 16) ss0[(size_t)(m0 + r) * 16 + lane] = lane == 0 ? s : 0.f;
        }
    }
    LAS float* scr = (LAS float*)(lds + wave * P0_SCR);
    constexpr int I_FFN = 704;
    constexpr int I_ABIN = 16 * 48, I_ABOUT = 16 * 16, I_CIN = 16 * 64, I_COUT = 16 * 16;
    constexpr int NITEMS = 12 * I_FFN + I_ABIN + I_ABOUT + I_CIN + I_COUT;
    for (int it = gw; it < NITEMS; it += NGW) {
        int r = it;
        if (r < 12 * I_FFN) {
            const int mat = r / I_FFN, item = r % I_FFN, f = mat / 3, type = mat % 3;
            const int layer = f >> 1, post = f & 1;
            if (type < 2) {
                const float* Wg = post ? P.in[7] : P.in[2]; const float* Wu = post ? P.in[8] : P.in[3]; const float* W = (type == 0 ? Wg : Wu) + (size_t)layer * D * FF;
                const float* gain = (post ? P.in[6] : P.in[1]) + layer * D;
                const int nblk = FF / 64, kb = item / nblk, nb = item % nblk, n0 = 64 * nb;
                const int orow0 = (n0 >> 7) * 256 + (n0 & 127) + (type == 1 ? 128 : 0);
                p0_transpose_item(W, D, FF, gain, (bf16_t*)(ws + WS_GU) + (size_t)f * 5632 * 1024, 64 * kb, n0, orow0, scr, lane);
            } else {
                const float* W = (post ? P.in[9] : P.in[4]) + (size_t)layer * FF * D;
                const int nblk = D / 64, kb = item / nblk, nb = item % nblk, n0 = 64 * nb;
                p0_transpose_item(W, FF, D, nullptr, (bf16_t*)(ws + WS_DN) + (size_t)f * 1024 * 2816, 64 * kb, n0, n0, scr, lane);
            }
            continue;
        }
        r -= 12 * I_FFN;
        if (r < I_ABIN) { const int nblk = 48, kb = r / nblk, nb = r % nblk; p0_transpose_item(P.in[10], D, 3072, P.in[5], (bf16_t*)(ws + WS_ABIN), 64 * kb, 64 * nb, 64 * nb, scr, lane); continue; }
        r -= I_ABIN;
        if (r < I_ABOUT) { const int nblk = 16, kb = r / nblk, nb = r % nblk; p0_transpose_item(P.in[12], D, D, nullptr, (bf16_t*)(ws + WS_ABOUT), 64 * kb, 64 * nb, 64 * nb, scr, lane); continue; }
        r -= I_ABOUT;
        if (r < I_CIN) { const int nblk = 64, kb = r / nblk, nb = r % nblk; p0_transpose_item(P.in[13], D, 4096, P.in[5] + D, (bf16_t*)(ws + WS_CIN), 64 * kb, 64 * nb, 64 * nb, scr, lane); continue; }
        r -= I_CIN;
        { const int nblk = 16, kb = r / nblk, nb = r % nblk; p0_transpose_item(P.in[16], D, D, nullptr, (bf16_t*)(ws + WS_COUT), 64 * kb, 64 * nb, 64 * nb, scr, lane); }
    }
}
__device__ __forceinline__ void final_norm(const Ptrs& P, int gw, int NGW, int lane) {
    const float* ss = (const float*)(P.ws + WS_SS) + (size_t)6 * M * 16; const float* gain = P.in[17]; const bf16_t* H = (const bf16_t*)(P.ws + WS_H);
    f32x4 g[4];
#pragma unroll
    for (int j = 0; j < 4; ++j) g[j] = ((const f32x4*)gain)[lane + 64 * j];
    for (int m0 = gw * 4; m0 < M; m0 += NGW * 4) {
        u32x2 w[4][4]; float rs[4];
#pragma unroll
        for (int r = 0; r < 4; ++r) { rs[r] = pg8::row_rstd(ss, m0 + r);
#pragma unroll
            for (int j = 0; j < 4; ++j) w[r][j] = ((const u32x2*)(H + (size_t)(m0 + r) * D))[lane + 64 * j]; }
#pragma unroll
        for (int r = 0; r < 4; ++r) { f32x4* orow = (f32x4*)(P.out + (size_t)(m0 + r) * D) + lane;
#pragma unroll
            for (int j = 0; j < 4; ++j) { const f32x4 v = (f32x4){pg8::bf_lo(w[r][j].x), pg8::bf_hi(w[r][j].x), pg8::bf_lo(w[r][j].y), pg8::bf_hi(w[r][j].y)}; __builtin_nontemporal_store(v * rs[r] * g[j], orow + 64 * j); } }
    }
}
#define XB_TMO      128
#define XB_XCNT(j)  (256  + 64 * (j))
#define XB_XSUB(j)  (1280 + 64 * (j))
#define XB_XGEN(j)  (2304 + 64 * (j))
#define XB_TOP      3328
#define XB_TOPGEN   3392
#define XCD_BAR_WORDS 3456
#define XB_SPIN_CAP (1u << 18)

__device__ __forceinline__ unsigned xb_ld(unsigned* p)              { return __hip_atomic_load(p, __ATOMIC_RELAXED, __HIP_MEMORY_SCOPE_AGENT); }
__device__ __forceinline__ unsigned xb_add(unsigned* p, unsigned v) { return __hip_atomic_fetch_add(p, v, __ATOMIC_RELAXED, __HIP_MEMORY_SCOPE_AGENT); }
__device__ __forceinline__ unsigned xb_xcc_id() { return (unsigned)__builtin_amdgcn_s_getreg((3 << 11) | 20) & 0xFu; }
#define XB_SPIN(cond, bar) do { unsigned _sp = 0; while (cond) { __builtin_amdgcn_s_sleep(1); \
    if ((++_sp & 255u) == 0u) { if (xb_ld(&(bar)[XB_TMO])) break; if (_sp > XB_SPIN_CAP) { atomicAdd(&(bar)[XB_TMO], 1u); break; } } } } while (0)

struct XcdBarrier {
    unsigned* bar; unsigned x;
    volatile LAS unsigned* st;
};

__device__ __forceinline__ XcdBarrier xcd_barrier_post(unsigned* bar, volatile LAS unsigned* st) {
    XcdBarrier b; b.bar = bar; b.x = xb_xcc_id(); b.st = st;
    if (threadIdx.x == 0) (void)xb_add(&bar[XB_XCNT(b.x)], 1u);
    return b;
}
__device__ __forceinline__ void xcd_barrier_complete(unsigned* bar, unsigned x, unsigned& nloc, unsigned& nx) {
    const unsigned G = gridDim.x * gridDim.y * gridDim.z;
    unsigned sum, cnt, mine, sp = 0u;
    for (;;) {
        sum = 0u; cnt = 0u; mine = 0u;
#pragma unroll
        for (unsigned j = 0; j < 16; ++j) { const unsigned c = xb_ld(&bar[XB_XCNT(j)]); sum += c; cnt += (c > 0u) ? 1u : 0u; mine = (j == x) ? c : mine; }
        if (sum == G) break;
        __builtin_amdgcn_s_sleep(1);
        if ((++sp & 255u) == 0u) { if (xb_ld(&bar[XB_TMO])) break; if (sp > XB_SPIN_CAP) { atomicAdd(&bar[XB_TMO], 1u); break; } }
    }
    nloc = mine > 0u ? mine : 1u; nx = cnt > 0u ? cnt : 1u;
}

__device__ __forceinline__ void xcd_barrier(const XcdBarrier& b) {
    asm volatile("s_waitcnt vmcnt(0)" ::: "memory");
    __syncthreads();
    if (threadIdx.x == 0) {
        unsigned* bar = b.bar;
        __builtin_amdgcn_s_waitcnt(0);
        unsigned nloc = b.st[0], nx = b.st[1];
        if (nloc == 0u) { xcd_barrier_complete(bar, b.x, nloc, nx); b.st[0] = nloc; b.st[1] = nx; }
        asm volatile("buffer_wbl2 sc1" ::: "memory");
        const unsigned old = xb_add(&bar[XB_XSUB(b.x)], 1u);
        const unsigned gen = old / nloc;
        if (old + 1u == (gen + 1u) * nloc) {
            __builtin_amdgcn_fence(__ATOMIC_RELEASE, "agent");
            asm volatile("s_waitcnt vmcnt(0)" ::: "memory");
            const unsigned og = xb_add(&bar[XB_TOP], 1u);
            const unsigned tg = og / nx;
            if (og + 1u == (tg + 1u) * nx) xb_add(&bar[XB_TOPGEN], 1u);
            else XB_SPIN(xb_ld(&bar[XB_TOPGEN]) == tg, bar);
            __builtin_amdgcn_fence(__ATOMIC_ACQUIRE, "agent");
            xb_add(&bar[XB_XGEN(b.x)], 1u);
            asm volatile("s_waitcnt vmcnt(0)" ::: "memory");
        } else {
            XB_SPIN(xb_ld(&bar[XB_XGEN(b.x)]) == gen, bar);
            __builtin_amdgcn_fence(__ATOMIC_ACQUIRE, "agent");
            asm volatile("s_waitcnt vmcnt(0)" ::: "memory");
        }
    }
    __syncthreads();
}
__device__ __forceinline__ void unpack8(const u32x4 w, float (&v)[8]) {
    v[0] = pg8::bf_lo(w.x); v[1] = pg8::bf_hi(w.x); v[2] = pg8::bf_lo(w.y); v[3] = pg8::bf_hi(w.y); v[4] = pg8::bf_lo(w.z); v[5] = pg8::bf_hi(w.z); v[6] = pg8::bf_lo(w.w); v[7] = pg8::bf_hi(w.w);
}
__device__ __forceinline__ void conv_item(const bf16_t* PROJ, const float* cw, bf16_t* Y, int item, int lane) {
    const int r0 = item * 16, c0 = lane * 8;
    float w0[8], w1[8], w2[8];
#pragma unroll
    for (int j = 0; j < 8; ++j) { w0[j] = cw[c0 + j]; w1[j] = cw[512 + c0 + j]; w2[j] = cw[1024 + c0 + j]; }
    float um1[8], um2[8];
#pragma unroll
    for (int j = 0; j < 8; ++j) { um1[j] = 0.f; um2[j] = 0.f; }
    if ((r0 & (SEQ - 1)) != 0) {
        float a[8], b[8];
        const bf16_t* p2 = PROJ + (size_t)(r0 - 2) * 3072 + c0; unpack8(*(const u32x4*)(p2 + 512), a); unpack8(*(const u32x4*)(p2 + 1024), b);
#pragma unroll
        for (int j = 0; j < 8; ++j) um2[j] = a[j] * b[j];
        const bf16_t* p1 = PROJ + (size_t)(r0 - 1) * 3072 + c0; unpack8(*(const u32x4*)(p1 + 512), a); unpack8(*(const u32x4*)(p1 + 1024), b);
#pragma unroll
        for (int j = 0; j < 8; ++j) um1[j] = a[j] * b[j];
    }
#pragma unroll 4
    for (int r = 0; r < 16; ++r) {
        const bf16_t* p = PROJ + (size_t)(r0 + r) * 3072 + c0;
        float g[8], a[8], b[8], o[8];
        unpack8(*(const u32x4*)p, g); unpack8(*(const u32x4*)(p + 512), a); unpack8(*(const u32x4*)(p + 1024), b);
#pragma unroll
        for (int j = 0; j < 8; ++j) { const float u = a[j] * b[j]; o[j] = g[j] * (w0[j] * um2[j] + w1[j] * um1[j] + w2[j] * u); um2[j] = um1[j]; um1[j] = u; }
        u32x4 w; w.x = pk2(o[0], o[1]); w.y = pk2(o[2], o[3]); w.z = pk2(o[4], o[5]); w.w = pk2(o[6], o[7]);
        *(u32x4*)(Y + (size_t)(r0 + r) * 1024 + c0) = w;
    }
}
__device__ __forceinline__ s16x4 vtr(const LAS unsigned char* p) { typedef short v4i16_t __attribute__((ext_vector_type(4))); return __builtin_bit_cast(s16x4, __builtin_amdgcn_ds_read_tr16_b64_v4i16((LAS v4i16_t*)p)); }
__device__ __forceinline__ bf16x8 cat8(s16x4 a, s16x4 b) { bf16x8 r; r[0] = a[0]; r[1] = a[1]; r[2] = a[2]; r[3] = a[3]; r[4] = b[0]; r[5] = b[1]; r[6] = b[2]; r[7] = b[3]; return r; }
constexpr int AV_STRIDE = 144;
__device__ __forceinline__ void attn_unit(const bf16_t* PROJ, bf16_t* Y, int b, int h, int qb, LAS unsigned char* vlds, int lane) {
    const int r32 = lane & 31, hi = lane >> 5;
    const size_t rowbase = (size_t)b * SEQ;
    const int t0 = qb * 32;
    bf16x8 qf[4];
    { const bf16_t* qp = PROJ + (rowbase + t0 + r32) * 3072 + 1536 + h * 64 + 8 * hi;
#pragma unroll
      for (int kk = 0; kk < 4; ++kk) qf[kk] = *(const bf16x8*)(qp + 16 * kk); }
    f32x16 o0, o1;
#pragma unroll
    for (int i = 0; i < 16; ++i) { o0[i] = 0.f; o1[i] = 0.f; }
    float carry = 0.f;
    const int g4 = lane >> 4, li = lane & 15;
    const LAS unsigned char* trbase = vlds + (4 * (g4 >> 1) + (li >> 2)) * AV_STRIDE + (16 * (g4 & 1) + 4 * (li & 3)) * 2;
    bf16x8 kf[4]; u32x4 vr[4];
#define AT_LOAD(KF, VR, K0) do { const bf16_t* kp_ = PROJ + (rowbase + (K0) + r32) * 3072 + 2048 + h * 64 + 8 * hi; \
        _Pragma("unroll") for (int kk = 0; kk < 4; ++kk) KF[kk] = *(const bf16x8*)(kp_ + 16 * kk); \
        _Pragma("unroll") for (int j = 0; j < 4; ++j) VR[j] = *(const u32x4*)(PROJ + (rowbase + (K0) + (lane >> 3) + 8 * j) * 3072 + 2560 + h * 64 + 8 * (lane & 7)); } while (0)
    AT_LOAD(kf, vr, t0);
    for (int kt = qb; kt >= 0; --kt) {
#pragma unroll
        for (int j = 0; j < 4; ++j) *(LAS u32x4*)(vlds + ((lane >> 3) + 8 * j) * AV_STRIDE + 16 * (lane & 7)) = vr[j];
        bf16x8 kfn[4]; u32x4 vrn[4];
#pragma unroll
        for (int j = 0; j < 4; ++j) { kfn[j] = kf[j]; vrn[j] = vr[j]; }
        if (kt > 0) AT_LOAD(kfn, vrn, (kt - 1) * 32);
        f32x16 sc;
#pragma unroll
        for (int i = 0; i < 16; ++i) sc[i] = 0.f;
#pragma unroll
        for (int kk = 0; kk < 4; ++kk) sc = __builtin_amdgcn_mfma_f32_32x32x16_bf16(kf[kk], qf[kk], sc, 0, 0, 0);
        const bool diag = (kt == qb);
        float lk[16], lb[16];
#pragma unroll
        for (int r = 0; r < 16; ++r) {
            const float z = sc[r], az = __builtin_fabsf(z);
            const float L = __builtin_amdgcn_logf(1.0f + __builtin_amdgcn_exp2f(-az));
            float lbv = __builtin_fminf(z, 0.f) - L, lkv = lbv - z;
            if (diag) { const int key = (r & 3) + 8 * (r >> 2) + 4 * hi; if (!(key < r32)) { lkv = 0.f; lbv = -1.0e30f; } }
            lk[r] = lkv; lb[r] = lbv;
        }
        float gs[4], pg[4], T[4];
#pragma unroll
        for (int j = 0; j < 4; ++j) { gs[j] = (lk[4 * j] + lk[4 * j + 1]) + (lk[4 * j + 2] + lk[4 * j + 3]); pg[j] = __shfl_xor(gs[j], 32); T[j] = gs[j] + pg[j]; }
        float w[16];
        float suf = carry;
#pragma unroll
        for (int j = 3; j >= 0; --j) {
            float run = suf + (hi == 0 ? pg[j] : 0.f);
#pragma unroll
            for (int i = 3; i >= 0; --i) { w[4 * j + i] = __builtin_amdgcn_exp2f(lb[4 * j + i] + run); run += lk[4 * j + i]; }
            suf += T[j];
        }
        carry = suf;
        u32x4 p0, p1;
        p0.x = pk2(w[0], w[1]); p0.y = pk2(w[2], w[3]); p0.z = pk2(w[4], w[5]); p0.w = pk2(w[6], w[7]);
        p1.x = pk2(w[8], w[9]); p1.y = pk2(w[10], w[11]); p1.z = pk2(w[12], w[13]); p1.w = pk2(w[14], w[15]);
        const bf16x8 pf0 = __builtin_bit_cast(bf16x8, p0), pf1 = __builtin_bit_cast(bf16x8, p1);
        asm volatile("s_waitcnt lgkmcnt(0)" ::: "memory");
        const bf16x8 v00 = cat8(vtr(trbase), vtr(trbase + 8 * AV_STRIDE));
        const bf16x8 v01 = cat8(vtr(trbase + 16 * AV_STRIDE), vtr(trbase + 24 * AV_STRIDE));
        const bf16x8 v10 = cat8(vtr(trbase + 64), vtr(trbase + 8 * AV_STRIDE + 64));
        const bf16x8 v11 = cat8(vtr(trbase + 16 * AV_STRIDE + 64), vtr(trbase + 24 * AV_STRIDE + 64));
        o0 = __builtin_amdgcn_mfma_f32_32x32x16_bf16(v00, pf0, o0, 0, 0, 0);
        o0 = __builtin_amdgcn_mfma_f32_32x32x16_bf16(v01, pf1, o0, 0, 0, 0);
        o1 = __builtin_amdgcn_mfma_f32_32x32x16_bf16(v10, pf0, o1, 0, 0, 0);
        o1 = __builtin_amdgcn_mfma_f32_32x32x16_bf16(v11, pf1, o1, 0, 0, 0);
        if (__builtin_amdgcn_ballot_w64(carry > -127.0f) == 0ull) break;
#pragma unroll
        for (int j = 0; j < 4; ++j) { kf[j] = kfn[j]; vr[j] = vrn[j]; }
    }
#undef AT_LOAD
    bf16_t* yp = Y + (rowbase + t0 + r32) * 1024 + 512 + h * 64 + 4 * hi;
#pragma unroll
    for (int j = 0; j < 4; ++j) {
        u32x2 a; a.x = pk2(o0[4 * j], o0[4 * j + 1]); a.y = pk2(o0[4 * j + 2], o0[4 * j + 3]); *(u32x2*)(yp + 8 * j) = a;
        u32x2 c; c.x = pk2(o1[4 * j], o1[4 * j + 1]); c.y = pk2(o1[4 * j + 2], o1[4 * j + 3]); *(u32x2*)(yp + 32 + 8 * j) = c;
    }
}
__device__ __forceinline__ void mix0_phase(const Ptrs& P, LAS unsigned char* lds, int gw, int NGW, int wave, int lane) {
    const bf16_t* PROJ = (const bf16_t*)(P.ws + WS_PROJ); bf16_t* Y = (bf16_t*)(P.ws + WS_Y);
    LAS unsigned char* vlds = lds + wave * 8192;
#ifndef DBG_NO_ATTN
    for (int it = gw; it < BATCH * 8 * (SEQ / 32); it += NGW) { const int bh = it / (SEQ / 32), qb = it % (SEQ / 32); attn_unit(PROJ, Y, bh >> 3, bh & 7, qb, vlds, lane); }
#else
    for (int m = gw; m < M; m += NGW) { *(u32x4*)(Y + (size_t)m * 1024 + 512 + 8 * lane) = (u32x4){0u, 0u, 0u, 0u}; }
#endif
    for (int it = gw; it < M / 16; it += NGW) conv_item(PROJ, P.in[11], Y, it, lane);
}
constexpr int HS = 272;
constexpr int HL_QT = 0, HL_KT = 64 * HS, HL_KH = 2 * 64 * HS, HL_V = 3 * 64 * HS, HL_V2 = 4 * 64 * HS, HL_OUT = 4 * 64 * HS;
constexpr int HSC = 144;
constexpr int HL_SC = 5 * 64 * HS, HL_SEG = HL_SC + 64 * HSC, HL_DEC = HL_SEG + 8 * 128 * 4, HL_OSQ = HL_DEC + 512, HL_END = HL_OSQ + 64 * 8 * 4;
static_assert(HL_END <= 131072, "hgrn LDS map");
constexpr size_t WS_DTOT = 256 * 1024;
constexpr int HG_NCH = 16;
#define HG_BAR() do { asm volatile("s_waitcnt lgkmcnt(0)" ::: "memory"); __builtin_amdgcn_s_barrier(); asm volatile("" ::: "memory"); } while (0)
#define MFMA16(a, b, c) __builtin_amdgcn_mfma_f32_16x16x32_bf16((a), (b), (c), 0, 0, 0)
typedef float f32x2v __attribute__((ext_vector_type(2)));
template <bool FULL>
__device__ __forceinline__ void hgrn_unit(const Ptrs& P, LAS unsigned char* lds, int bh, int sc, int tid, int wave, int lane) {
    const bf16_t* Qs = (const bf16_t*)(P.ws + WS_QS); const float* LF = (const float*)(P.ws + WS_LF); const bf16_t* Iv = (const bf16_t*)(P.ws + WS_IV); const bf16_t* Gs = (const bf16_t*)(P.ws + WS_GS);
    bf16_t* Ob = (bf16_t*)P.out;
    float* SLOC = (float*)((unsigned char*)P.out + 64 * MiB);
    float* DTOT = (float*)(P.ws + WS_DTOT);
    const int b = bh >> 3, h = bh & 7, hc = h * 128;
    const int fr = lane & 15, fq = lane >> 4;
    const int kp = lane, seg = wave;
    f32x4 S[8];
    if (FULL && sc > 0) {
        const float* sp = SLOC + ((size_t)(bh * 4) << 14) + (16 * wave + fr) * 4;
        const float* dp = DTOT + (bh * 4) * 128 + 4 * fq;
#pragma unroll
        for (int kt = 0; kt < 8; ++kt) S[kt] = *(const f32x4*)(sp + (4 * kt + fq) * 512);
        for (int j = 1; j < sc; ++j) {
#pragma unroll
            for (int kt = 0; kt < 8; ++kt) S[kt] = S[kt] * *(const f32x4*)(dp + j * 128 + 16 * kt) + *(const f32x4*)(sp + ((size_t)j << 14) + (4 * kt + fq) * 512);
        }
    } else {
#pragma unroll
        for (int kt = 0; kt < 8; ++kt) S[kt] = (f32x4){0.f, 0.f, 0.f, 0.f};
    }
    LAS float* segtot = (LAS float*)(lds + HL_SEG); LAS float* dec = (LAS float*)(lds + HL_DEC); LAS float* osq = (LAS float*)(lds + HL_OSQ);
    f32x4 on0, on1;
    if (FULL) { const float* onp = P.in[15] + 8 * (tid & 15); on0 = *(const f32x4*)onp; on1 = *(const f32x4*)(onp + 4); }
    float dprod0 = 1.f, dprod1 = 1.f;
    f32x2v lf2[8]; unsigned q2[8]; u32x4 vch[2], gch[2];
    const size_t Rbase = (size_t)b * SEQ + (size_t)sc * (64 * HG_NCH);
#define HG_LOAD_E(R0_) do { _Pragma("unroll") for (int i = 0; i < 8; ++i) { const size_t off = ((R0_) + 8 * seg + i) * 1024 + hc + 2 * kp; lf2[i] = *(const f32x2v*)(LF + off); if (FULL) q2[i] = *(const unsigned*)(Qs + off); } \
        _Pragma("unroll") for (int j = 0; j < 2; ++j) { const int ch = tid + 512 * j; vch[j] = *(const u32x4*)(Iv + ((R0_) + (ch >> 4)) * 1024 + hc + 8 * (ch & 15)); } } while (0)
#define HG_LOAD_G(R0_) do { _Pragma("unroll") for (int j = 0; j < 2; ++j) { const int ch = tid + 512 * j; gch[j] = *(const u32x4*)(Gs + ((R0_) + (ch >> 4)) * 1024 + hc + 8 * (ch & 15)); } } while (0)
    HG_LOAD_E(Rbase);
    if (FULL) HG_LOAD_G(Rbase);
#pragma unroll 1
    for (int c = 0; c < HG_NCH; ++c) {
        const size_t R0 = Rbase + (size_t)c * 64;
        const int vimg = FULL ? HL_V : ((c & 1) ? HL_V2 : HL_V);
        f32x2v cs[8]; { f32x2v run = (f32x2v){0.f, 0.f};
#pragma unroll
          for (int i = 0; i < 8; ++i) { run += lf2[i]; cs[i] = run; } }
        *(LAS f32x2v*)(segtot + seg * 128 + 2 * kp) = cs[7];
#pragma unroll
        for (int j = 0; j < 2; ++j) { const int ch = tid + 512 * j; *(LAS u32x4*)(lds + vimg + (ch >> 4) * HS + 16 * (ch & 15)) = vch[j]; }
        HG_BAR();
        f32x2v pre = (f32x2v){0.f, 0.f}, tot = (f32x2v){0.f, 0.f};
#pragma unroll
        for (int s2 = 0; s2 < 8; ++s2) { const f32x2v v = *(const LAS f32x2v*)(segtot + s2 * 128 + 2 * kp); tot += v; if (s2 < seg) pre += v; }
        const float dl0 = __builtin_amdgcn_exp2f(tot[0]), dl1 = __builtin_amdgcn_exp2f(tot[1]);
        if (seg == 0) { *(LAS f32x2v*)(dec + 2 * kp) = (f32x2v){dl0, dl1}; dprod0 *= dl0; dprod1 *= dl1; }
#pragma unroll
        for (int i = 0; i < 8; ++i) {
            const float b0 = pre[0] + cs[i][0], b1 = pre[1] + cs[i][1];
            const float k0 = (1.0f - __builtin_amdgcn_exp2f(lf2[i][0])) * __builtin_amdgcn_exp2f(-b0), k1 = (1.0f - __builtin_amdgcn_exp2f(lf2[i][1])) * __builtin_amdgcn_exp2f(-b1);
            const int o = (8 * seg + i) * HS + 4 * kp;
            *(LAS unsigned*)(lds + HL_KH + o) = pk2(k0 * dl0, k1 * dl1);
            if (FULL) {
                *(LAS unsigned*)(lds + HL_KT + o) = pk2(k0, k1);
                *(LAS unsigned*)(lds + HL_QT + o) = pk2(pg8::bf_lo(q2[i]) * __builtin_amdgcn_exp2f(b0), pg8::bf_hi(q2[i]) * __builtin_amdgcn_exp2f(b1));
            }
        }
        if (c < HG_NCH - 1) HG_LOAD_E(R0 + 64);
        HG_BAR();
        f32x4 o[4];
        bf16x8 vf[2];
        if (FULL) {
            { const int tt = wave >> 1;
#pragma unroll
              for (int e = 0; e < 2; ++e) { const int st = 2 * (wave & 1) + e; const int t = 16 * tt + fr, s0 = 16 * st + 4 * fq;
                  u32x2 w = (u32x2){0u, 0u};
                  if (st <= tt) {
                      f32x4 a4 = (f32x4){0.f, 0.f, 0.f, 0.f};
#pragma unroll
                      for (int ks = 0; ks < 4; ++ks) {
                          const bf16x8 af = *(const LAS bf16x8*)(lds + HL_KT + (16 * st + fr) * HS + (32 * ks + 8 * fq) * 2);
                          const bf16x8 bfr = *(const LAS bf16x8*)(lds + HL_QT + (16 * tt + fr) * HS + (32 * ks + 8 * fq) * 2);
                          a4 = MFMA16(af, bfr, a4);
                      }
                      const float v0 = s0 + 0 <= t ? a4[0] : 0.f, v1 = s0 + 1 <= t ? a4[1] : 0.f, v2 = s0 + 2 <= t ? a4[2] : 0.f, v3 = s0 + 3 <= t ? a4[3] : 0.f;
                      w.x = pk2(v0, v1); w.y = pk2(v2, v3);
                  }
                  *(LAS u32x2*)(lds + HL_SC + t * HSC + s0 * 2) = w;
              } }
#pragma unroll
            for (int tt = 0; tt < 4; ++tt) o[tt] = (f32x4){0.f, 0.f, 0.f, 0.f};
#pragma unroll
            for (int ks = 0; ks < 4; ++ks) {
                u32x4 sb; sb.x = pk2(S[2 * ks][0], S[2 * ks][1]); sb.y = pk2(S[2 * ks][2], S[2 * ks][3]); sb.z = pk2(S[2 * ks + 1][0], S[2 * ks + 1][1]); sb.w = pk2(S[2 * ks + 1][2], S[2 * ks + 1][3]);
                const bf16x8 sfr = __builtin_bit_cast(bf16x8, sb);
#pragma unroll
                for (int tt = 0; tt < 4; ++tt) {
                    const LAS unsigned char* ap = lds + HL_QT + (16 * tt + fr) * HS + (32 * ks + 4 * fq) * 2;
                    const s16x4 a0 = *(const LAS s16x4*)ap, a1 = *(const LAS s16x4*)(ap + 32);
                    o[tt] = MFMA16(cat8(a0, a1), sfr, o[tt]);
                }
            }
        }
        { const LAS unsigned char* tb = lds + vimg + (8 * fq + (fr >> 2)) * HS + (16 * wave + 4 * (fr & 3)) * 2;
#pragma unroll
          for (int ss = 0; ss < 2; ++ss) vf[ss] = cat8(vtr(tb + (32 * ss) * HS), vtr(tb + (32 * ss + 4) * HS)); }
        f32x4 Sn[8];
#pragma unroll
        for (int kt = 0; kt < 8; ++kt) {
            const f32x4 d4 = *(const LAS f32x4*)(dec + 16 * kt + 4 * fq);
            f32x4 a4 = S[kt] * d4;
            const LAS unsigned char* tb = lds + HL_KH + (8 * fq + (fr >> 2)) * HS + (16 * kt + 4 * (fr & 3)) * 2;
#pragma unroll
            for (int ss = 0; ss < 2; ++ss) a4 = MFMA16(cat8(vtr(tb + (32 * ss) * HS), vtr(tb + (32 * ss + 4) * HS)), vf[ss], a4);
            Sn[kt] = a4;
        }
#pragma unroll
        for (int kt = 0; kt < 8; ++kt) S[kt] = Sn[kt];
        if (FULL) {
            HG_BAR();
#pragma unroll
            for (int ss = 0; ss < 2; ++ss)
#pragma unroll
                for (int tt = 0; tt < 4; ++tt) {
                    if (ss == 1 && tt < 2) continue;
                    const bf16x8 af = *(const LAS bf16x8*)(lds + HL_SC + (16 * tt + fr) * HSC + (32 * ss + 8 * fq) * 2);
                    o[tt] = MFMA16(af, vf[ss], o[tt]);
                }
#pragma unroll
            for (int tt = 0; tt < 4; ++tt)
#pragma unroll
                for (int r = 0; r < 4; ++r) { const int t = 16 * tt + 4 * fq + r; const float ov = o[tt][r]; float q = ov * ov;
                    *(LAS unsigned short*)(lds + HL_OUT + t * HS + (16 * wave + fr) * 2) = (unsigned short)f2bf(ov);
                    q += __shfl_xor(q, 1); q += __shfl_xor(q, 2); q += __shfl_xor(q, 4); q += __shfl_xor(q, 8);
                    if (fr == 0) osq[t * 8 + wave] = q; }
            HG_BAR();
#pragma unroll
            for (int j = 0; j < 2; ++j) { const int ch = tid + 512 * j, row = ch >> 4, c16 = ch & 15;
                const f32x4 qa = *(const LAS f32x4*)(osq + row * 8), qb = *(const LAS f32x4*)(osq + row * 8 + 4);
                const float rs = 1.0f / sqrtf((((qa[0] + qa[1]) + (qa[2] + qa[3])) + ((qb[0] + qb[1]) + (qb[2] + qb[3]))) * (1.0f / 128.0f) + 1e-6f);
                const u32x4 ow = *(const LAS u32x4*)(lds + HL_OUT + row * HS + 16 * c16);
                float ov[8], gv[8]; unpack8(ow, ov); unpack8(gch[j], gv);
                u32x4 w; w.x = pk2(ov[0] * rs * on0[0] * gv[0], ov[1] * rs * on0[1] * gv[1]); w.y = pk2(ov[2] * rs * on0[2] * gv[2], ov[3] * rs * on0[3] * gv[3]);
                w.z = pk2(ov[4] * rs * on1[0] * gv[4], ov[5] * rs * on1[1] * gv[5]); w.w = pk2(ov[6] * rs * on1[2] * gv[6], ov[7] * rs * on1[3] * gv[7]);
                *(u32x4*)(Ob + (R0 + row) * 1024 + hc + 8 * c16) = w; }
            if (c < HG_NCH - 1) HG_LOAD_G(R0 + 64);
        }
    }
    if (!FULL) {
        float* sp = SLOC + ((size_t)(bh * 4 + sc) << 14) + (16 * wave + fr) * 4;
#pragma unroll
        for (int kt = 0; kt < 8; ++kt) *(f32x4*)(sp + (4 * kt + fq) * 512) = S[kt];
        if (seg == 0) *(f32x2v*)(DTOT + (bh * 4 + sc) * 128 + 2 * kp) = (f32x2v){dprod0, dprod1};
    }
    HG_BAR();
#undef HG_LOAD_E
#undef HG_LOAD_G
}
__device__ __forceinline__ void hgrn_scan(const Ptrs& P, int gw, int NGW, int lane) {
    float* SLOC = (float*)((unsigned char*)P.out + 64 * MiB); const float* DTOT = (const float*)(P.ws + WS_DTOT);
    for (int it = gw; it < 64 * 64; it += NGW) {
        const int bh = it >> 6, e0 = (it & 63) * 256 + lane * 4, k0 = (e0 >> 9) * 4;
        f32x4 v[3], d[3];
#pragma unroll
        for (int s = 0; s < 3; ++s) { v[s] = *(const f32x4*)(SLOC + ((size_t)(bh * 4 + s) << 14) + e0); d[s] = *(const f32x4*)(DTOT + (bh * 4 + s) * 128 + k0); }
        f32x4 run = v[0];
#pragma unroll
        for (int s = 1; s < 3; ++s) { run = run * d[s] + v[s]; *(f32x4*)(SLOC + ((size_t)(bh * 4 + s) << 14) + e0) = run; }
    }
}
#ifndef MK_ONE_LAUNCH
#define MK_ONE_LAUNCH 1
#endif
#ifndef MK_XCD_BAR
#define MK_XCD_BAR 1
#endif
constexpr int N_PHASES = 18;
constexpr int FIN_LDS_OFF = 131072 + 4096;
constexpr int RS_TAB_OFF = 131072 + 1024;
struct Args { Ptrs p; int ph_lo, ph_hi; };
__global__ void __launch_bounds__(NTHREADS, 2) fwd_kernel(Args args) {
    extern __shared__ __attribute__((aligned(16))) unsigned char lds_raw[];
    LAS unsigned char* lds = (LAS unsigned char*)lds_raw;
    const Ptrs& P = args.p;
    const int tid = threadIdx.x, lane = tid & 63, wave = __builtin_amdgcn_readfirstlane(tid >> 6);
    const int G = gridDim.x, bx = blockIdx.x;
    const int vcu = (G % 8 == 0) ? (bx % 8) * (G / 8) + bx / 8 : bx;
    const int gw = vcu * NWAVES + wave, NGW = G * NWAVES;
    unsigned char* ws = P.ws;
    bf16_t* H = (bf16_t*)(ws + WS_H); bf16_t* HID = (bf16_t*)(ws + WS_HID); float* SS = (float*)(ws + WS_SS);
    const int lo = args.ph_lo, hi = args.ph_hi;
#if MK_XCD_BAR
    volatile LAS unsigned* MISC = (volatile LAS unsigned*)(lds + LDS_BYTES - 256);
    if (tid < 32) MISC[tid] = 0u;
#if MK_ONE_LAUNCH
    if (bx == 0) { unsigned* cw = (unsigned*)ws + 4096; for (int i = tid; i < 12288; i += NTHREADS) __hip_atomic_store(cw + i, 0u, __ATOMIC_RELAXED, __HIP_MEMORY_SCOPE_AGENT); }
    __syncthreads();
    XcdBarrier bar; bar.bar = (unsigned*)ws + 4096; bar.x = xb_xcc_id(); bar.st = MISC + 8;
#else
    __syncthreads();
    XcdBarrier bar = xcd_barrier_post((unsigned*)ws + 4096, MISC + 8);
#endif
#endif
#define IN(k) (lo <= (k) && (k) < hi)
#if MK_XCD_BAR
#define SEAM(k) do { if (IN(k) && IN((k) + 1)) { if ((k) == 0) { cg::this_grid().sync(); if (tid == 0) (void)xb_add(&bar.bar[XB_XCNT(bar.x)], 1u); } else xcd_barrier(bar); } } while (0)
#else
#define SEAM(k) do { if (IN(k) && IN((k) + 1)) { cg::this_grid().sync(); } } while (0)
#endif
#define SSB(i) (SS + (size_t)(i) * M * 16)
#define GEMM_GU(f, ssi) do { pg8::Gemm g{H, (const bf16_t*)(ws + WS_GU) + (size_t)(f) * 5632 * 1024, M, 5632, D}; pg8::StaticOrder S; S.init(M, 5632, G, bx); \
        pg8::EpiSwiGLU E{HID, pg8::rs_table_build(lds + RS_TAB_OFF, SSB(ssi), S, tid), FF}; pg8::gemm_phase<pg8::EpiSwiGLU, pg8::StaticOrder, true, true>(lds, g, S, E); } while (0)
#define GEMM_DN(f, sso) do { pg8::Gemm g{HID, (const bf16_t*)(ws + WS_DN) + (size_t)(f) * 1024 * 2816, M, D, FF}; pg8::StaticOrder S; S.init(M, D, G, bx); \
        pg8::EpiResid<false> E{H, SSB(sso), 0.5f, nullptr}; pg8::gemm_phase<pg8::EpiResid<false>, pg8::StaticOrder, true, true>(lds, g, S, E); } while (0)

    if (IN(0)) { p0_prologue(P, lds, gw, NGW, wave, lane); }
#ifdef PROBE_P0
    __syncthreads(); if (IN(0)) { p0_prologue(P, lds, gw, NGW, wave, lane); }
#endif
    SEAM(0);
#ifdef PROBE_EARLYBAR
    xcd_barrier(bar);
#endif
    if (IN(1)) { GEMM_GU(0, 0); }
#ifdef PROBE_LATE_WG
    if (bx == PROBE_LATE_WG) { for (int d_ = 0; d_ < 400; ++d_) __builtin_amdgcn_s_sleep(127); }
#endif
#ifdef PROBE_BAR10
#if PROBE_BAR10 == 2
    asm volatile("s_waitcnt vmcnt(0)" ::: "memory"); __syncthreads();
    if (tid == 0) { __builtin_amdgcn_fence(__ATOMIC_RELEASE, "agent"); asm volatile("s_waitcnt vmcnt(0)" ::: "memory"); __builtin_amdgcn_fence(__ATOMIC_ACQUIRE, "agent"); asm volatile("s_waitcnt vmcnt(0)" ::: "memory"); }
    __syncthreads();
#elif PROBE_BAR10 == 4
    cg::this_grid().sync();
#elif PROBE_BAR10 == 3
    asm volatile("s_waitcnt vmcnt(0)" ::: "memory"); __syncthreads(); __syncthreads();
#else
    for (int i_ = 0; i_ < PROBE_BAR10; ++i_) { xcd_barrier(bar); }
#endif
#endif
#ifdef PROBE_GU2X
    xcd_barrier(bar); if (IN(1)) { GEMM_GU(0, 0); }
#endif
    SEAM(1);
#ifdef PROBE_DN2X
    if (IN(2)) { pg8::Gemm g{HID, (const bf16_t*)(ws + WS_DN), M, D, FF}; pg8::StaticOrder S; S.init(M, D, G, bx);
        pg8::EpiResid<false> E{H, SSB(1), 0.0f, nullptr}; pg8::gemm_phase<pg8::EpiResid<false>, pg8::StaticOrder, true, true>(lds, g, S, E); }
    xcd_barrier(bar);
#endif
    if (IN(2)) { GEMM_DN(0, 1); }
    SEAM(2);
    if (IN(3)) { pg8::Gemm g{H, (const bf16_t*)(ws + WS_ABIN), M, 3072, D}; pg8::StaticOrder S; S.init(M, 3072, G, bx);
        pg8::EpiProjAB E{(bf16_t*)(ws + WS_PROJ), pg8::rs_table_build(lds + RS_TAB_OFF, SSB(1), S, tid), QSCALE}; pg8::gemm_phase<pg8::EpiProjAB, pg8::StaticOrder, true, true>(lds, g, S, E); }
    SEAM(3);
    if (IN(4)) { mix0_phase(P, lds, gw, NGW, wave, lane); }
#ifdef PROBE_P4
    if (IN(4)) { mix0_phase(P, lds, gw, NGW, wave, lane); }
#endif
    SEAM(4);
    if (IN(5)) { pg8::Gemm g{(const bf16_t*)(ws + WS_Y), (const bf16_t*)(ws + WS_ABOUT), M, D, D}; pg8::StaticOrder S; S.init(M, D, G, bx);
        pg8::EpiResid<false> E{H, SSB(2), 1.0f, nullptr}; pg8::gemm_phase<pg8::EpiResid<false>, pg8::StaticOrder, true, true>(lds, g, S, E); }
    SEAM(5);
#ifdef PROBE_BAR_AT5
    xcd_barrier(bar);
#endif
#ifdef PROBE_IDLE
    { const unsigned long long t0_ = __builtin_amdgcn_s_memrealtime(); while (__builtin_amdgcn_s_memrealtime() - t0_ < 100000ull) __builtin_amdgcn_s_sleep(64); }
#endif
    if (IN(6)) { GEMM_GU(1, 2); }
    SEAM(6);
#ifdef PROBE_BAR_AT6
    xcd_barrier(bar);
#endif
    if (IN(7)) { GEMM_DN(1, 3); }
    SEAM(7);
    if (IN(8)) { GEMM_GU(2, 3); }
    SEAM(8);
    if (IN(9)) { GEMM_DN(2, 4); }
    SEAM(9);
    if (IN(10)) { pg8::Gemm g{H, (const bf16_t*)(ws + WS_CIN), M, 4096, D}; pg8::StaticOrder S; S.init(M, 4096, G, bx);
        pg8::EpiProjC E{(bf16_t*)(ws + WS_QS), (float*)(ws + WS_LF), (bf16_t*)(ws + WS_IV), (bf16_t*)(ws + WS_GS), pg8::rs_table_build(lds + RS_TAB_OFF, SSB(4), S, tid), P.in[14]};
        pg8::gemm_phase<pg8::EpiProjC, pg8::StaticOrder, true, true>(lds, g, S, E); }
    SEAM(10);
    if (IN(11)) { const int bh = bx >> 2, sc = bx & 3; if (sc < 3 && bh < 64) hgrn_unit<false>(P, lds, bh, sc, tid, wave, lane); }
    SEAM(11);
    if (IN(13)) { const int bh = bx >> 2, sc = bx & 3; if (bh < 64) hgrn_unit<true>(P, lds, bh, sc, tid, wave, lane); }
    SEAM(13);
    if (IN(14)) { pg8::Gemm g{(const bf16_t*)P.out, (const bf16_t*)(ws + WS_COUT), M, D, D}; pg8::StaticOrder S; S.init(M, D, G, bx);
        pg8::EpiResid<false> E{H, SSB(5), 1.0f, nullptr}; pg8::gemm_phase<pg8::EpiResid<false>, pg8::StaticOrder, true, true>(lds, g, S, E); }
    SEAM(14);
    if (IN(15)) { GEMM_GU(3, 5); }
    SEAM(15);
    if (IN(16)) { pg8::Gemm g{HID, (const bf16_t*)(ws + WS_DN) + (size_t)3 * 1024 * 2816, M, D, FF}; pg8::StaticOrder S; S.init(M, D, G, bx);
        pg8::EpiFinalNorm E{H, P.out, P.in[17], 0.5f, SSB(6), (unsigned*)ws + 8192, lds + FIN_LDS_OFF};
        pg8::gemm_phase<pg8::EpiFinalNorm, pg8::StaticOrder, true, true>(lds, g, S, E); }
    if (IN(18)) {
        for (int m = gw; m < M; m += NGW) { const u32x2* hr = (const u32x2*)(H + (size_t)m * D) + lane; f32x4* orow = (f32x4*)(P.out + (size_t)m * D) + lane;
#pragma unroll
            for (int j = 0; j < 4; ++j) { const u32x2 w = hr[64 * j]; orow[64 * j] = (f32x4){pg8::bf_lo(w.x), pg8::bf_hi(w.x), pg8::bf_lo(w.y), pg8::bf_hi(w.y)}; } }
    }
}

extern "C" void kernel_launch(void* const* d_in, const int* in_sizes, int n_in, void* d_out, int out_size, void* d_ws, size_t ws_size, hipStream_t stream) {
    static int grid = 0;
    if (grid == 0) {
        if (n_in != 18 || in_sizes[0] != M * D || out_size != M * D || ws_size < WS_END) { fprintf(stderr, "kernel_launch: unexpected shapes (n_in %d, in0 %d, out %d, ws %zu)\n", n_in, n_in > 0 ? in_sizes[0] : -1, out_size, ws_size); grid = -1; return; }
        int dev = 0, cus = 0, per_cu = 0;
        hipGetDevice(&dev); hipDeviceGetAttribute(&cus, hipDeviceAttributeMultiprocessorCount, dev);
        if (hipFuncSetAttribute((const void*)fwd_kernel, hipFuncAttributeMaxDynamicSharedMemorySize, LDS_BYTES) != hipSuccess) { fprintf(stderr, "kernel_launch: hipFuncSetAttribute failed\n"); grid = -1; return; }
        if (hipOccupancyMaxActiveBlocksPerMultiprocessor(&per_cu, (const void*)fwd_kernel, NTHREADS, LDS_BYTES) != hipSuccess || per_cu < 1) { fprintf(stderr, "kernel_launch: occupancy query gives %d\n", per_cu); per_cu = 1; }
        (void)hipGetLastError();
        grid = cus;
    }
    if (grid < 0) return;
    Args a{};
    for (int i = 0; i < 18; ++i) a.p.in[i] = (const float*)d_in[i];
    a.p.out = (float*)d_out; a.p.ws = (unsigned char*)d_ws;
#if MK_ONE_LAUNCH
    a.ph_lo = 0; a.ph_hi = N_PHASES;
    void* kargs[] = {&a};
    hipError_t e = hipLaunchCooperativeKernel((const void*)fwd_kernel, dim3(grid), dim3(NTHREADS), kargs, LDS_BYTES, stream);
    if (e != hipSuccess) fprintf(stderr, "kernel_launch: cooperative launch failed: %s (grid %d)\n", hipGetErrorString(e), grid);
#else
#ifdef DBG_STOP
    for (int ph = 0; ph <= DBG_STOP; ++ph) { a.ph_lo = ph; a.ph_hi = ph + 1; hipLaunchKernelGGL(fwd_kernel, dim3(grid), dim3(NTHREADS), LDS_BYTES, stream, a); }
    a.ph_lo = 18; a.ph_hi = 19; hipLaunchKernelGGL(fwd_kernel, dim3(grid), dim3(NTHREADS), LDS_BYTES, stream, a);
#else
    for (int ph = 0; ph < N_PHASES; ++ph) { a.ph_lo = ph; a.ph_hi = ph + 1; hipLaunchKernelGGL(fwd_kernel, dim3(grid), dim3(NTHREADS), LDS_BYTES, stream, a); }
#endif
#endif
}
```

```cpp
#include <hip/hip_runtime.h>
#include <hip/hip_cooperative_groups.h>
#include <cstdio>
#include <cstdint>
namespace cg = cooperative_groups;
#define MK_ONE_LAUNCH 1
namespace pg8 {
#define PG8_LAS __attribute__((address_space(3)))
typedef unsigned short bf16_t;
typedef short bf16x8 __attribute__((ext_vector_type(8)));
typedef float f32x4 __attribute__((ext_vector_type(4)));
typedef unsigned u32x4 __attribute__((ext_vector_type(4)));
constexpr int BM = 256, BK = 64, HALF = 128, HTB = HALF * BK * 2  , STAGE_BYTES = 8 * HTB, NXCD = 8, WGM = 8;

__host__ __device__ __forceinline__ int lds_byte(int r, int c) { const int st = (r >> 4) * 2 + (c >> 5), rr = r & 15, cc = c & 31, ob = rr * 64 + cc * 2; return st * 1024 + (ob ^ (((ob >> 9) & 1) << 5)); }
__host__ __device__ __forceinline__ void stage_rc(int b, int& R, int& C) { const int st = b / 1024, sb = b % 1024, swz = sb ^ (((sb >> 9) & 1) << 5); R = (st >> 1) * 16 + swz / 64; C = (st & 1) * 32 + (swz % 64) / 2; }
__host__ __device__ __forceinline__ int perm32(int rho) { const int n = rho >> 4, i = rho & 15; return 8 * (i >> 2) + 4 * n + (i & 3); }

struct Unit { int pm, pn; };
struct Gemm { const bf16_t* A; const bf16_t* Bt; int M, N, K; };

struct StaticOrder {
    int nM, nN, nwg, G, c;
    __host__ __device__ void init(int M, int N, int G_, int c_) { nM = M / BM; nN = N / BM; nwg = nM * nN; G = G_; c = c_; }
    __host__ __device__ bool next(int i, Unit& u) const {
        const long L = (long)i * G + c; if (L >= nwg) return false;
        int wgid = (int)L; { const int q = nwg / NXCD, r = nwg % NXCD, xcd = wgid % NXCD, off = wgid / NXCD; wgid = (xcd < r ? xcd * (q + 1) : r * (q + 1) + (xcd - r) * q) + off; }
        const int nig = WGM * nN, gid = wgid / nig, fm = gid * WGM, gsz = (nM - fm) < WGM ? (nM - fm) : WGM;
        u.pm = fm + ((wgid % nig) % gsz); u.pn = (wgid % nig) / gsz; return true;
    }
    __device__ __forceinline__ void a_ready(const Unit&) const {}
    __device__ __forceinline__ void done(const Unit&) const {}
};

__device__ __forceinline__ unsigned cvt_pk_bf16(float lo, float hi) { unsigned r; asm volatile("v_cvt_pk_bf16_f32 %0, %1, %2" : "=v"(r) : "v"(lo), "v"(hi)); return r; }
typedef float f32x2 __attribute__((ext_vector_type(2)));
__device__ __forceinline__ float row_rstd(const float* ss, int row) {
    const f32x4* p = (const f32x4*)(ss + (size_t)row * 16);
    const f32x4 a = p[0], b = p[1], c = p[2], d = p[3];
    const float s = ((a[0] + a[1]) + (a[2] + a[3])) + ((b[0] + b[1]) + (b[2] + b[3])) + ((c[0] + c[1]) + (c[2] + c[3])) + ((d[0] + d[1]) + (d[2] + d[3]));
    return __builtin_amdgcn_rsqf(s * (1.0f / 1024.0f) + 1e-6f);
}
struct RsTab { const PG8_LAS float* tab; int pmA, pmB; const float* ss; };
template <class Sched> __device__ __forceinline__ RsTab rs_table_build(PG8_LAS unsigned char* lds_tab, const float* ss, const Sched& S, int tid) {
    RsTab t; t.tab = (const PG8_LAS float*)lds_tab; t.pmA = -1; t.pmB = -1; t.ss = ss;
    Unit u; for (int i = 0; S.next(i, u); ++i) { if (t.pmA < 0) t.pmA = u.pm; else if (u.pm != t.pmA && t.pmB < 0) t.pmB = u.pm; }
    const int pm = tid < 256 ? t.pmA : t.pmB;
    if (pm >= 0) ((PG8_LAS float*)lds_tab)[tid] = row_rstd(ss, pm * BM + (tid & 255));
    __syncthreads();
    return t;
}
__device__ __forceinline__ float rs_lookup(const RsTab& t, const Unit& u, int r  ) {
    if (u.pm == t.pmA) return t.tab[r];
    if (u.pm == t.pmB) return t.tab[256 + r];
    return row_rstd(t.ss, u.pm * BM + r);
}
__device__ __forceinline__ float sigmoidf_(float x) { return __builtin_amdgcn_rcpf(1.0f + __builtin_amdgcn_exp2f(-1.4426950408889634f * x)); }
__device__ __forceinline__ float siluf_(float x) { return x * sigmoidf_(x); }
__device__ __forceinline__ float bf_lo(unsigned w) { return __uint_as_float(w << 16); }
__device__ __forceinline__ float bf_hi(unsigned w) { return __uint_as_float(w & 0xffff0000u); }
__device__ __forceinline__ void st16_wt(void* p, u32x4 v) { asm volatile("global_store_dwordx4 %0, %1, off sc1\n\ts_nop 1" :: "v"(p), "v"(v) : "memory");     }
__device__ __forceinline__ void st16_wt(void* p, f32x4 v) { asm volatile("global_store_dwordx4 %0, %1, off sc1\n\ts_nop 1" :: "v"(p), "v"(v) : "memory");     }

struct EpiSwiGLU {
    static constexpr bool PERM = true, AFTER_DRAIN = false;
    bf16_t* O; RsTab rt; int ldo;
    struct Pre {};
    __device__ __forceinline__ Pre pre(const Unit&, int, int) const { return Pre{}; }
    __device__ __forceinline__ void operator()(const f32x4 (&acc)[2][2][4][2], const Unit& u, int wr, int wc, int fr, int fq, const Pre&) const {
        const int row0 = u.pm * BM + wr * 64 + fr, col0 = u.pn * HALF + wc * 32 + 8 * fq;
#pragma unroll
        for (int ai = 0; ai < 2; ++ai)
#pragma unroll
            for (int m = 0; m < 4; ++m) {
                const int row = row0 + ai * HALF + m * 16; const float rs = rs_lookup(rt, u, ai * HALF + wr * 64 + m * 16 + fr), c1 = -1.4426950408889634f * rs, rs2 = rs * rs;
                float h[8];
#pragma unroll
                for (int n = 0; n < 2; ++n)
#pragma unroll
                    for (int i = 0; i < 4; ++i) { const float g = acc[ai][0][m][n][i], up = acc[ai][1][m][n][i];
                        h[4 * n + i] = (g * up) * (rs2 * __builtin_amdgcn_rcpf(1.0f + __builtin_amdgcn_exp2f(g * c1))); }
                u32x4 w; w.x = cvt_pk_bf16(h[0], h[1]); w.y = cvt_pk_bf16(h[2], h[3]); w.z = cvt_pk_bf16(h[4], h[5]); w.w = cvt_pk_bf16(h[6], h[7]);
                st16_wt(O + (size_t)row * ldo + col0, w);
            }
    }
};
template <bool F32OUT> struct EpiResid {
    static constexpr bool PERM = true, AFTER_DRAIN = false;
    bf16_t* H; float* ssout; float alpha; float* out32;
    struct Pre {};
    __device__ __forceinline__ Pre pre(const Unit&, int, int) const { return Pre{}; }
    __device__ __forceinline__ void operator()(const f32x4 (&acc)[2][2][4][2], const Unit& u, int wr, int wc, int fr, int fq, const Pre&) const {
        const int row0 = u.pm * BM + wr * 64 + fr, col0 = u.pn * BM + wc * 32 + 8 * fq;
#pragma unroll
        for (int ai = 0; ai < 2; ++ai) {
            u32x4 old[4][2];
#pragma unroll
            for (int m = 0; m < 4; ++m)
#pragma unroll
                for (int bj = 0; bj < 2; ++bj) old[m][bj] = *(const u32x4*)(H + (size_t)(row0 + ai * HALF + m * 16) * 1024 + col0 + bj * HALF);
#pragma unroll
            for (int m = 0; m < 4; ++m) {
                const int row = row0 + ai * HALF + m * 16; float sq = 0.f;
#pragma unroll
                for (int bj = 0; bj < 2; ++bj) {
                    bf16_t* hp = H + (size_t)row * 1024 + col0 + bj * HALF;
                    const u32x4 o4 = old[m][bj];
                    float v[8];
                    v[0] = bf_lo(o4.x); v[1] = bf_hi(o4.x); v[2] = bf_lo(o4.y); v[3] = bf_hi(o4.y); v[4] = bf_lo(o4.z); v[5] = bf_hi(o4.z); v[6] = bf_lo(o4.w); v[7] = bf_hi(o4.w);
#pragma unroll
                    for (int n = 0; n < 2; ++n)
#pragma unroll
                        for (int i = 0; i < 4; ++i) { v[4 * n + i] += alpha * acc[ai][bj][m][n][i]; sq += v[4 * n + i] * v[4 * n + i]; }
                    u32x4 w; w.x = cvt_pk_bf16(v[0], v[1]); w.y = cvt_pk_bf16(v[2], v[3]); w.z = cvt_pk_bf16(v[4], v[5]); w.w = cvt_pk_bf16(v[6], v[7]);
                    *(u32x4*)hp = w;
                    if (F32OUT) { float* op = out32 + (size_t)row * 1024 + col0 + bj * HALF; *(f32x4*)op = (f32x4){v[0], v[1], v[2], v[3]}; *(f32x4*)(op + 4) = (f32x4){v[4], v[5], v[6], v[7]}; }
                }
                sq += __shfl_xor(sq, 16); sq += __shfl_xor(sq, 32);
                if (fq == 0) ssout[(size_t)row * 16 + u.pn * 4 + wc] = sq;
            }
        }
    }
};
struct EpiFinalNorm {
    static constexpr bool PERM = false, AFTER_DRAIN = false;
    const bf16_t* H; float* out; const float* gain; float alpha;
    float* xslots;
    unsigned* cnt;
    PG8_LAS unsigned char* xl;
    struct Pre {};
    __device__ __forceinline__ Pre pre(const Unit&, int, int) const { return Pre{}; }
    __device__ __forceinline__ void operator()(f32x4 (&acc)[2][2][4][2], const Unit& u, int wr, int wc, int fr, int fq, const Pre&) const {
        const int tid = threadIdx.x, lane = tid & 63, wid = __builtin_amdgcn_readfirstlane(tid >> 6);
        PG8_LAS float* P = (PG8_LAS float*)xl; PG8_LAS float* S = (PG8_LAS float*)(xl + 4096);
        const int row0 = u.pm * BM + wr * 64 + fr, col0 = u.pn * BM + wc * 32 + 4 * fq;
        typedef unsigned u32x2_t __attribute__((ext_vector_type(2)));
#pragma unroll
        for (int ai = 0; ai < 2; ++ai)
#pragma unroll
            for (int m = 0; m < 4; ++m) {
                const int row = row0 + ai * HALF + m * 16; float sq = 0.f;
#pragma unroll
                for (int bj = 0; bj < 2; ++bj)
#pragma unroll
                    for (int n = 0; n < 2; ++n) {
                        const u32x2_t o = *(const u32x2_t*)(H + (size_t)row * 1024 + col0 + bj * HALF + n * 16);
                        f32x4 v = (f32x4){bf_lo(o.x), bf_hi(o.x), bf_lo(o.y), bf_hi(o.y)} + alpha * acc[ai][bj][m][n];
                        acc[ai][bj][m][n] = v; sq += (v[0] * v[0] + v[1] * v[1]) + (v[2] * v[2] + v[3] * v[3]);
                    }
                sq += __shfl_xor(sq, 16); sq += __shfl_xor(sq, 32);
                if (fq == 0) P[(ai * HALF + wr * 64 + m * 16 + fr) * 4 + wc] = sq;
            }
        asm volatile("s_waitcnt lgkmcnt(0)" ::: "memory"); __builtin_amdgcn_s_barrier(); asm volatile("" ::: "memory");
        if (tid < 256) { const f32x4 p = *(const PG8_LAS f32x4*)(P + tid * 4);
            __hip_atomic_store(xslots + ((size_t)u.pm * BM + tid) * 4 + u.pn, (p[0] + p[1]) + (p[2] + p[3]), __ATOMIC_RELAXED, __HIP_MEMORY_SCOPE_AGENT); }
        asm volatile("s_waitcnt vmcnt(0)" ::: "memory");
        if (tid < 256 && lane == 0) __hip_atomic_fetch_add(cnt + 64 * u.pm, 1u, __ATOMIC_RELAXED, __HIP_MEMORY_SCOPE_AGENT);
        if (wid == 0) {
            unsigned sp = 0;
            while ((unsigned)__builtin_amdgcn_readfirstlane(__hip_atomic_load(cnt + 64 * u.pm, __ATOMIC_RELAXED, __HIP_MEMORY_SCOPE_AGENT)) < 16u) { __builtin_amdgcn_s_sleep(2); if (++sp > (1u << 18)) break; }
            __builtin_amdgcn_fence(__ATOMIC_ACQUIRE, "agent");
        }
        asm volatile("s_waitcnt vmcnt(0) lgkmcnt(0)" ::: "memory"); __builtin_amdgcn_s_barrier(); asm volatile("" ::: "memory");
        if (tid < 256) { const float* sl = xslots + ((size_t)u.pm * BM + tid) * 4;
            const float t = (__hip_atomic_load(sl, __ATOMIC_RELAXED, __HIP_MEMORY_SCOPE_AGENT) + __hip_atomic_load(sl + 1, __ATOMIC_RELAXED, __HIP_MEMORY_SCOPE_AGENT))
                          + (__hip_atomic_load(sl + 2, __ATOMIC_RELAXED, __HIP_MEMORY_SCOPE_AGENT) + __hip_atomic_load(sl + 3, __ATOMIC_RELAXED, __HIP_MEMORY_SCOPE_AGENT));
            S[tid] = __builtin_amdgcn_rsqf(t * (1.0f / 1024.0f) + 1e-6f); }
        asm volatile("s_waitcnt lgkmcnt(0)" ::: "memory"); __builtin_amdgcn_s_barrier(); asm volatile("" ::: "memory");
        f32x4 gv[2][2];
#pragma unroll
        for (int bj = 0; bj < 2; ++bj)
#pragma unroll
            for (int n = 0; n < 2; ++n) gv[bj][n] = *(const f32x4*)(gain + col0 + bj * HALF + n * 16);
#pragma unroll
        for (int ai = 0; ai < 2; ++ai)
#pragma unroll
            for (int m = 0; m < 4; ++m) {
                const int r = ai * HALF + wr * 64 + m * 16 + fr; const float rs = S[r];
                float* op = out + (size_t)(u.pm * BM + r) * 1024 + col0;
#pragma unroll
                for (int bj = 0; bj < 2; ++bj)
#pragma unroll
                    for (int n = 0; n < 2; ++n) __builtin_nontemporal_store(acc[ai][bj][m][n] * rs * gv[bj][n], (f32x4*)(op + bj * HALF + n * 16));
            }
    }
};
struct EpiProjAB {
    static constexpr bool PERM = true, AFTER_DRAIN = false;
    bf16_t* O; RsTab rt; float qscale;
    struct Pre {};
    __device__ __forceinline__ Pre pre(const Unit&, int, int) const { return Pre{}; }
    __device__ __forceinline__ void operator()(const f32x4 (&acc)[2][2][4][2], const Unit& u, int wr, int wc, int fr, int fq, const Pre&) const {
        const int row0 = u.pm * BM + wr * 64 + fr, col0 = u.pn * BM + wc * 32 + 8 * fq;
        const float sc = (u.pn == 6 || u.pn == 7) ? qscale : 1.0f;
#pragma unroll
        for (int ai = 0; ai < 2; ++ai)
#pragma unroll
            for (int m = 0; m < 4; ++m) {
                const int row = row0 + ai * HALF + m * 16; const float rs = rs_lookup(rt, u, ai * HALF + wr * 64 + m * 16 + fr) * sc;
#pragma unroll
                for (int bj = 0; bj < 2; ++bj) {
                    const f32x4 a = acc[ai][bj][m][0] * rs, b = acc[ai][bj][m][1] * rs;
                    u32x4 w; w.x = cvt_pk_bf16(a[0], a[1]); w.y = cvt_pk_bf16(a[2], a[3]); w.z = cvt_pk_bf16(b[0], b[1]); w.w = cvt_pk_bf16(b[2], b[3]);
                    st16_wt(O + (size_t)row * 3072 + col0 + bj * HALF, w);
                }
            }
    }
};
struct EpiProjC {
    static constexpr bool PERM = true, AFTER_DRAIN = false;
    bf16_t* Qs; float* LF; bf16_t* Iv; bf16_t* Gs; RsTab rt; const float* clb;
    struct Pre {};
    __device__ __forceinline__ Pre pre(const Unit&, int, int) const { return Pre{}; }
    __device__ __forceinline__ void operator()(const f32x4 (&acc)[2][2][4][2], const Unit& u, int wr, int wc, int fr, int fq, const Pre&) const {
        const int kind = u.pn >> 2;
        const int row0 = u.pm * BM + wr * 64 + fr, col0 = (u.pn & 3) * BM + wc * 32 + 8 * fq;
        if (kind == 1) {
            float lb[2][8];
#pragma unroll
            for (int bj = 0; bj < 2; ++bj)
#pragma unroll
                for (int j = 0; j < 8; ++j) { const int c = col0 + bj * HALF + j; lb[bj][j] = sigmoidf_(clb[1024 + c] - clb[c]); }
#pragma unroll
            for (int ai = 0; ai < 2; ++ai)
#pragma unroll
                for (int m = 0; m < 4; ++m) {
                    const int row = row0 + ai * HALF + m * 16; const float rs = rs_lookup(rt, u, ai * HALF + wr * 64 + m * 16 + fr);
#pragma unroll
                    for (int bj = 0; bj < 2; ++bj) {
                        float v[8];
#pragma unroll
                        for (int n = 0; n < 2; ++n)
#pragma unroll
                            for (int i = 0; i < 4; ++i) { const float x = acc[ai][bj][m][n][i] * rs, l = lb[bj][4 * n + i]; v[4 * n + i] = __builtin_amdgcn_logf(l + (1.0f - l) * sigmoidf_(x)); }
                        float* op = LF + (size_t)row * 1024 + col0 + bj * HALF; st16_wt(op, (f32x4){v[0], v[1], v[2], v[3]}); st16_wt(op + 4, (f32x4){v[4], v[5], v[6], v[7]});
                    }
                }
        } else {
            bf16_t* O = Qs + (kind ? ((size_t)(64 + 64 * kind) << 19) : (size_t)0);
            const bool act = kind != 2;
#pragma unroll
            for (int ai = 0; ai < 2; ++ai)
#pragma unroll
                for (int m = 0; m < 4; ++m) {
                    const int row = row0 + ai * HALF + m * 16; const float rs = rs_lookup(rt, u, ai * HALF + wr * 64 + m * 16 + fr);
#pragma unroll
                    for (int bj = 0; bj < 2; ++bj) {
                        float v[8];
#pragma unroll
                        for (int n = 0; n < 2; ++n)
#pragma unroll
                            for (int i = 0; i < 4; ++i) { const float x = acc[ai][bj][m][n][i] * rs; v[4 * n + i] = act ? siluf_(x) : x; }
                        u32x4 w; w.x = cvt_pk_bf16(v[0], v[1]); w.y = cvt_pk_bf16(v[2], v[3]); w.z = cvt_pk_bf16(v[4], v[5]); w.w = cvt_pk_bf16(v[6], v[7]);
                        st16_wt(O + (size_t)row * 1024 + col0 + bj * HALF, w);
                    }
                }
        }
    }
};
template <class Epi, class Sched, bool ALIGN_EPI = false, bool SP2 = false>
__device__ __forceinline__ void gemm_phase(PG8_LAS unsigned char* lds, const Gemm g, const Sched& S, const Epi& E) {
    const int tid = threadIdx.x, wid = __builtin_amdgcn_readfirstlane(tid >> 6), lane = tid & 63, wr = wid >> 2, wc = wid & 3, fr = lane & 15, fq = lane >> 4;
    const int K = g.K, nt = K / BK;
    unsigned voffA[2], voffB[2];
#pragma unroll
    for (int i = 0; i < 2; ++i) { int R, C; stage_rc(tid * 16 + i * 8192, R, C); const int Rb = Epi::PERM ? ((R & ~31) + perm32(R & 31)) : R;
        voffA[i] = (unsigned)(R * K + C) * 2u; voffB[i] = (unsigned)(Rb * K + C) * 2u; }
    const size_t kstep = (size_t)(BK * 2);
    const size_t hstep = (size_t)HALF * K * 2;
    const size_t tstep = 2 * hstep;
    const unsigned ldsw = (unsigned)wid * 1024u;
    const int aoff = lds_byte(wr * 64 + fr, fq * 8), boff = lds_byte(wc * 32 + fr, fq * 8);
#define PG8_SA(b, h) (((b) * 2 + (h)) * HTB)
#define PG8_SB(b, h) ((4 + (b) * 2 + (h)) * HTB)
#define PG8_STAGE(bufoff, gbase, voff) do { _Pragma("unroll") for (int _i = 0; _i < 2; ++_i) \
        __builtin_amdgcn_global_load_lds((const unsigned*)((const char*)(gbase) + (voff)[_i]), (PG8_LAS unsigned*)(lds + (bufoff) + ldsw + _i * 8192), 16, 0, 0); } while (0)
#define PG8_LDA(dst, b, h) do { _Pragma("unroll") for (int m = 0; m < 4; ++m) _Pragma("unroll") for (int k = 0; k < 2; ++k) dst[m][k] = *(const PG8_LAS bf16x8*)(lds + PG8_SA(b, h) + aoff + m * 2048 + k * 1024); } while (0)
#define PG8_LDB(dst, b, h) do { _Pragma("unroll") for (int n = 0; n < 2; ++n) _Pragma("unroll") for (int k = 0; k < 2; ++k) dst[n][k] = *(const PG8_LAS bf16x8*)(lds + PG8_SB(b, h) + boff + n * 2048 + k * 1024); } while (0)
#define PG8_MMA(ai, bj, At, Bt) do { __builtin_amdgcn_s_setprio(1); _Pragma("unroll") for (int m = 0; m < 4; ++m) _Pragma("unroll") for (int n = 0; n < 2; ++n) _Pragma("unroll") for (int k = 0; k < 2; ++k) \
        acc[ai][bj][m][n] = __builtin_amdgcn_mfma_f32_16x16x32_bf16(Bt[n][k], At[m][k], acc[ai][bj][m][n], 0, 0, 0); __builtin_amdgcn_s_setprio(0); } while (0)
#define PG8_WAIT_V(n) asm volatile("s_waitcnt vmcnt(" #n ")" ::: "memory")
#define PG8_WAIT_L(n) asm volatile("s_waitcnt lgkmcnt(" #n ")" ::: "memory")
#define PG8_BAR __builtin_amdgcn_s_barrier()
#define PG8_SCHED __builtin_amdgcn_sched_barrier(0)
    Unit cur, nxt; int ui = 0;
    if (!S.next(0, cur)) return;
    f32x4 acc[2][2][4][2];
#pragma unroll
    for (int a = 0; a < 2; ++a)
#pragma unroll
        for (int b = 0; b < 2; ++b)
#pragma unroll
            for (int m = 0; m < 4; ++m)
#pragma unroll
                for (int n = 0; n < 2; ++n) acc[a][b][m][n] = (f32x4){0.f, 0.f, 0.f, 0.f};
    bf16x8 At[4][2], B0[2][2], B1[2][2];
    const char* cA = (const char*)g.A + (size_t)cur.pm * tstep; const char* cB = (const char*)g.Bt + (size_t)cur.pn * tstep;
    S.a_ready(cur);
    if constexpr (SP2) {
        PG8_STAGE(PG8_SB(0, 0), cB, voffB); PG8_STAGE(PG8_SB(0, 1), cB + hstep, voffB); PG8_STAGE(PG8_SA(0, 0), cA, voffA); PG8_STAGE(PG8_SA(0, 1), cA + hstep, voffA);
        if (wr == 1) PG8_BAR;
        PG8_WAIT_V(2); PG8_BAR;
        PG8_STAGE(PG8_SB(1, 0), cB + kstep, voffB); PG8_STAGE(PG8_SA(1, 0), cA + kstep, voffA); PG8_STAGE(PG8_SB(1, 1), cB + hstep + kstep, voffB);
        PG8_WAIT_V(6); PG8_BAR;
    } else {
        PG8_STAGE(PG8_SB(0, 0), cB, voffB); PG8_STAGE(PG8_SA(0, 0), cA, voffA); PG8_STAGE(PG8_SB(0, 1), cB + hstep, voffB); PG8_STAGE(PG8_SA(0, 1), cA + hstep, voffA);
        if (wr == 1) PG8_BAR;
        PG8_WAIT_V(4); PG8_BAR;
        PG8_STAGE(PG8_SB(1, 0), cB + kstep, voffB); PG8_STAGE(PG8_SA(1, 0), cA + kstep, voffA); PG8_STAGE(PG8_SB(1, 1), cB + hstep + kstep, voffB);
        PG8_WAIT_V(6); PG8_BAR;
    }
    for (;;) {
        const bool has_next = S.next(ui + 1, nxt);
        const char* nA = has_next ? (const char*)g.A + (size_t)nxt.pm * tstep : cA; const char* nB = has_next ? (const char*)g.Bt + (size_t)nxt.pn * tstep : cB;
        for (int t = 0; t < nt; t += 2) {
            const bool last = (t == nt - 2);
            const char* a1 = cA + (size_t)(t + 1) * kstep;
            const char* a2 = last ? nA : cA + (size_t)(t + 2) * kstep; const char* b2 = last ? nB : cB + (size_t)(t + 2) * kstep;
            const char* a3 = a2 + kstep; const char* b3 = b2 + kstep;
            if (last && has_next) S.a_ready(nxt);
            if constexpr (SP2) {
            PG8_LDB(B0, 0, 0); PG8_LDB(B1, 0, 1); PG8_SCHED; PG8_LDA(At, 0, 0); PG8_STAGE(PG8_SA(1, 1), a1 + hstep, voffA);
            PG8_WAIT_V(8); PG8_WAIT_L(0); PG8_BAR; PG8_MMA(0, 0, At, B0); PG8_MMA(0, 1, At, B1); PG8_BAR; PG8_SCHED;
            PG8_LDA(At, 0, 1); PG8_STAGE(PG8_SB(0, 0), b2, voffB); PG8_STAGE(PG8_SB(0, 1), b2 + hstep, voffB); PG8_STAGE(PG8_SA(0, 0), a2, voffA);
            PG8_WAIT_V(8); PG8_WAIT_L(0); PG8_BAR; PG8_MMA(1, 0, At, B0); PG8_MMA(1, 1, At, B1); PG8_BAR; PG8_SCHED;
            PG8_LDB(B0, 1, 0); PG8_LDB(B1, 1, 1); PG8_SCHED; PG8_LDA(At, 1, 0); PG8_STAGE(PG8_SA(0, 1), a2 + hstep, voffA);
            PG8_WAIT_V(8); PG8_WAIT_L(0); PG8_BAR; PG8_MMA(0, 0, At, B0); PG8_MMA(0, 1, At, B1); PG8_BAR; PG8_SCHED;
            PG8_LDA(At, 1, 1); PG8_STAGE(PG8_SB(1, 0), b3, voffB); PG8_STAGE(PG8_SB(1, 1), b3 + hstep, voffB); PG8_STAGE(PG8_SA(1, 0), a3, voffA);
            PG8_WAIT_V(8); PG8_WAIT_L(0); PG8_BAR; PG8_MMA(1, 0, At, B0); PG8_MMA(1, 1, At, B1); PG8_BAR; PG8_SCHED;
            } else {
            PG8_LDB(B0, 0, 0); PG8_SCHED; PG8_LDA(At, 0, 0); PG8_STAGE(PG8_SA(1, 1), a1 + hstep, voffA);
            PG8_WAIT_L(8); PG8_BAR; PG8_WAIT_L(0); PG8_MMA(0, 0, At, B0); PG8_BAR; PG8_SCHED;
            PG8_LDB(B1, 0, 1); PG8_STAGE(PG8_SB(0, 0), b2, voffB);
            PG8_BAR; PG8_WAIT_L(0); PG8_MMA(0, 1, At, B1); PG8_BAR;
            PG8_LDA(At, 0, 1); PG8_STAGE(PG8_SA(0, 0), a2, voffA);
            PG8_BAR; PG8_WAIT_L(0); PG8_MMA(1, 0, At, B0); PG8_BAR; PG8_SCHED;
            PG8_STAGE(PG8_SB(0, 1), b2 + hstep, voffB);
            PG8_WAIT_V(6); PG8_BAR; PG8_MMA(1, 1, At, B1); PG8_BAR;
            PG8_LDB(B0, 1, 0); PG8_SCHED; PG8_LDA(At, 1, 0); PG8_STAGE(PG8_SA(0, 1), a2 + hstep, voffA);
            PG8_WAIT_L(8); PG8_BAR; PG8_WAIT_L(0); PG8_MMA(0, 0, At, B0); PG8_BAR; PG8_SCHED;
            PG8_LDB(B1, 1, 1); PG8_STAGE(PG8_SB(1, 0), b3, voffB);
            PG8_BAR; PG8_WAIT_L(0); PG8_MMA(0, 1, At, B1); PG8_BAR;
            PG8_LDA(At, 1, 1); PG8_STAGE(PG8_SA(1, 0), a3, voffA);
            PG8_BAR; PG8_WAIT_L(0); PG8_MMA(1, 0, At, B0); PG8_BAR; PG8_SCHED;
            PG8_STAGE(PG8_SB(1, 1), b3 + hstep, voffB);
            PG8_WAIT_V(6); PG8_BAR; PG8_MMA(1, 1, At, B1); PG8_BAR;
            }
        }
        if constexpr (ALIGN_EPI) { if (wr == 0) PG8_BAR; }
        if constexpr (!Epi::AFTER_DRAIN) { E(acc, cur, wr, wc, fr, fq, E.pre(cur, wr, lane)); S.done(cur); }
        if (!has_next) break;
#pragma unroll
        for (int a = 0; a < 2; ++a)
#pragma unroll
            for (int b = 0; b < 2; ++b)
#pragma unroll
                for (int m = 0; m < 4; ++m)
#pragma unroll
                    for (int n = 0; n < 2; ++n) acc[a][b][m][n] = (f32x4){0.f, 0.f, 0.f, 0.f};
        cur = nxt; cA = nA; cB = nB; ++ui;
        if constexpr (ALIGN_EPI) { if (wr == 1) PG8_BAR; }
    }
    PG8_WAIT_V(0);
    if constexpr (!ALIGN_EPI) { if (wr == 0) PG8_BAR; }
    PG8_BAR;
    if constexpr (Epi::AFTER_DRAIN) { E.fused(acc, cur, wr, wc, fr, fq, lds, wid, lane); S.done(cur); }
#undef PG8_SA
#undef PG8_SB
#undef PG8_STAGE
#undef PG8_LDA
#undef PG8_LDB
#undef PG8_MMA
#undef PG8_WAIT_V
#undef PG8_WAIT_L
#undef PG8_BAR
#undef PG8_SCHED
}
}
using pg8::bf16_t; using pg8::bf16x8; using pg8::f32x4; using pg8::u32x4;
typedef float f32x16 __attribute__((ext_vector_type(16)));
typedef short s16x4 __attribute__((ext_vector_type(4)));
typedef unsigned u32x2 __attribute__((ext_vector_type(2)));
#define LAS __attribute__((address_space(3)))
constexpr int NWAVES = 8, NTHREADS = 512;
constexpr int BATCH = 8, SEQ = 4096, D = 1024, FF = 2816, M = BATCH * SEQ;
constexpr float QSCALE = 0.125f * 1.4426950408889634f;
constexpr size_t MiB = 1u << 20;
constexpr size_t WS_GU = 1 * MiB;
constexpr size_t WS_DN = WS_GU + 44 * MiB;
constexpr size_t WS_ABIN = WS_DN + 22 * MiB;
constexpr size_t WS_ABOUT = WS_ABIN + 6 * MiB;
constexpr size_t WS_CIN = WS_ABOUT + 2 * MiB;
constexpr size_t WS_COUT = WS_CIN + 8 * MiB;
constexpr size_t WS_H = WS_COUT + 2 * MiB;
constexpr size_t WS_SS = WS_H + 64 * MiB;
constexpr size_t WS_R = WS_SS + 14 * MiB;
constexpr size_t WS_HID = WS_R, WS_PROJ = WS_R, WS_Y = WS_R + 192 * MiB;
constexpr size_t WS_QS = WS_R, WS_LF = WS_R + 64 * MiB, WS_IV = WS_R + 192 * MiB, WS_GS = WS_R + 256 * MiB;
constexpr size_t WS_END = WS_R + 320 * MiB;
static_assert(WS_END <= 512 * MiB, "workspace map");
constexpr int LDS_BYTES = 147456;

__device__ __forceinline__ unsigned f2bf(float f) { unsigned u = __builtin_bit_cast(unsigned, f); return (u + 0x7fffu + ((u >> 16) & 1u)) >> 16; }
__device__ __forceinline__ unsigned pk2(float lo, float hi) { return pg8::cvt_pk_bf16(lo, hi); }
__device__ __forceinline__ float wave_sum(float v) {
#pragma unroll
    for (int o = 1; o < 64; o <<= 1) v += __shfl_xor(v, o);
    return v;
}
constexpr int P0_SCR = 64 * 65 * 4;
__device__ __forceinline__ void p0_transpose_item(const float* W, int K, int N, const float* gain, bf16_t* WT, int k0, int n0, int orow0, LAS float* scr, int lane) {
    const int lr = lane >> 4, lc = (lane & 15) * 4;
    f32x4 v[16];
#pragma unroll
    for (int j = 0; j < 16; ++j) v[j] = __builtin_nontemporal_load((const f32x4*)(W + (size_t)(k0 + 4 * j + lr) * N + n0 + lc));
    if (gain) {
#pragma unroll
        for (int j = 0; j < 16; ++j) v[j] = v[j] * gain[k0 + 4 * j + lr];
    }
#pragma unroll
    for (int j = 0; j < 16; ++j) { LAS float* d = scr + (4 * j + lr) * 65 + lc; d[0] = v[j][0]; d[1] = v[j][1]; d[2] = v[j][2]; d[3] = v[j][3]; }
    asm volatile("s_waitcnt lgkmcnt(0)" ::: "memory");
    const int c = lane & 7;
#pragma unroll
    for (int j = 0; j < 8; ++j) { const int n = (lane >> 3) + 8 * j; const LAS float* s = scr + (8 * c) * 65 + n;
        u32x4 o; o.x = pk2(s[0 * 65], s[1 * 65]); o.y = pk2(s[2 * 65], s[3 * 65]); o.z = pk2(s[4 * 65], s[5 * 65]); o.w = pk2(s[6 * 65], s[7 * 65]);
        *(u32x4*)(WT + (size_t)(orow0 + n) * K + k0 + 8 * c) = o; }
    asm volatile("s_waitcnt lgkmcnt(0)" ::: "memory");
}
struct Ptrs {
    const float* in[18]; float* out; unsigned char* ws;
};
__device__ __forceinline__ void p0_prologue(const Ptrs& P, LAS unsigned char* lds, int gw, int NGW, int wave, int lane) {
    unsigned char* ws = P.ws;
    const float* x = P.in[0]; bf16_t* H = (bf16_t*)(ws + WS_H); float* ss0 = (float*)(ws + WS_SS);
    for (int m0 = gw * 4; m0 < M; m0 += NGW * 4) {
        f32x4 v[4][4];
#pragma unroll
        for (int r = 0; r < 4; ++r)
#pragma unroll
            for (int j = 0; j < 4; ++j) v[r][j] = __builtin_nontemporal_load((const f32x4*)(x + (size_t)(m0 + r) * D) + lane + 64 * j);
#pragma unroll
        for (int r = 0; r < 4; ++r) {
            float s = 0.f;
#pragma unroll
            for (int j = 0; j < 4; ++j) s += (v[r][j][0] * v[r][j][0] + v[r][j][1] * v[r][j][1]) + (v[r][j][2] * v[r][j][2] + v[r][j][3] * v[r][j][3]);
            s = wave_sum(s);
            u32x2* o8 = (u32x2*)(H + (size_t)(m0 + r) * D) + lane;
#pragma unroll
            for (int j = 0; j < 4; ++j) { u32x2 w; w.x = pk2(v[r][j][0], v[r][j][1]); w.y = pk2(v[r][j][2], v[r][j][3]); o8[64 * j] = w; }
            if (lane < 16) ss0[(size_t)(m0 + r) * 16 + lane] = lane == 0 ? s : 0.f;
        }
    }
    LAS float* scr = (LAS float*)(lds + wave * P0_SCR);
    constexpr int I_FFN = 704;
    constexpr int I_ABIN = 16 * 48, I_ABOUT = 16 * 16, I_CIN = 16 * 64, I_COUT = 16 * 16;
    constexpr int NITEMS = 12 * I_FFN + I_ABIN + I_ABOUT + I_CIN + I_COUT;
    for (int it = gw; it < NITEMS; it += NGW) {
        int r = it;
        if (r < 12 * I_FFN) {
            const int mat = r / I_FFN, item = r % I_FFN, f = mat / 3, type = mat % 3;
            const int layer = f >> 1, post = f & 1;
            if (type < 2) {
                const float* Wg = post ? P.in[7] : P.in[2]; const float* Wu = post ? P.in[8] : P.in[3]; const float* W = (type == 0 ? Wg : Wu) + (size_t)layer * D * FF;
                const float* gain = (post ? P.in[6] : P.in[1]) + layer * D;
                const int nblk = FF / 64, kb = item / nblk, nb = item % nblk, n0 = 64 * nb;
                const int orow0 = (n0 >> 7) * 256 + (n0 & 127) + (type == 1 ? 128 : 0);
                p0_transpose_item(W, D, FF, gain, (bf16_t*)(ws + WS_GU) + (size_t)f * 5632 * 1024, 64 * kb, n0, orow0, scr, lane);
            } else {
                const float* W = (post ? P.in[9] : P.in[4]) + (size_t)layer * FF * D;
                const int nblk = D / 64, kb = item / nblk, nb = item % nblk, n0 = 64 * nb;
                p0_transpose_item(W, FF, D, nullptr, (bf16_t*)(ws + WS_DN) + (size_t)f * 1024 * 2816, 64 * kb, n0, n0, scr, lane);
            }
            continue;
        }
        r -= 12 * I_FFN;
        if (r < I_ABIN) { const int nblk = 48, kb = r / nblk, nb = r % nblk; p0_transpose_item(P.in[10], D, 3072, P.in[5], (bf16_t*)(ws + WS_ABIN), 64 * kb, 64 * nb, 64 * nb, scr, lane); continue; }
        r -= I_ABIN;
        if (r < I_ABOUT) { const int nblk = 16, kb = r / nblk, nb = r % nblk; p0_transpose_item(P.in[12], D, D, nullptr, (bf16_t*)(ws + WS_ABOUT), 64 * kb, 64 * nb, 64 * nb, scr, lane); continue; }
        r -= I_ABOUT;
        if (r < I_CIN) { const int nblk = 64, kb = r / nblk, nb = r % nblk; p0_transpose_item(P.in[13], D, 4096, P.in[5] + D, (bf16_t*)(ws + WS_CIN), 64 * kb, 64 * nb, 64 * nb, scr, lane); continue; }
        r -= I_CIN;
        { const int nblk = 16, kb = r / nblk, nb = r % nblk; p0_transpose_item(P.in[16], D, D, nullptr, (bf16_t*)(ws + WS_COUT), 64 * kb, 64 * nb, 64 * nb, scr, lane); }
    }
}
__device__ __forceinline__ void final_norm(const Ptrs& P, int gw, int NGW, int lane) {
    const float* ss = (const float*)(P.ws + WS_SS) + (size_t)6 * M * 16; const float* gain = P.in[17]; const bf16_t* H = (const bf16_t*)(P.ws + WS_H);
    f32x4 g[4];
#pragma unroll
    for (int j = 0; j < 4; ++j) g[j] = ((const f32x4*)gain)[lane + 64 * j];
    for (int m0 = gw * 4; m0 < M; m0 += NGW * 4) {
        u32x2 w[4][4]; float rs[4];
#pragma unroll
        for (int r = 0; r < 4; ++r) { rs[r] = pg8::row_rstd(ss, m0 + r);
#pragma unroll
            for (int j = 0; j < 4; ++j) w[r][j] = ((const u32x2*)(H + (size_t)(m0 + r) * D))[lane + 64 * j]; }
#pragma unroll
        for (int r = 0; r < 4; ++r) { f32x4* orow = (f32x4*)(P.out + (size_t)(m0 + r) * D) + lane;
#pragma unroll
            for (int j = 0; j < 4; ++j) { const f32x4 v = (f32x4){pg8::bf_lo(w[r][j].x), pg8::bf_hi(w[r][j].x), pg8::bf_lo(w[r][j].y), pg8::bf_hi(w[r][j].y)}; __builtin_nontemporal_store(v * rs[r] * g[j], orow + 64 * j); } }
    }
}
#define XB_TMO      128
#define XB_XCNT(j)  (256  + 64 * (j))
#define XB_XSUB(j)  (1280 + 64 * (j))
#define XB_XGEN(j)  (2304 + 64 * (j))
#define XB_TOP      3328
#define XB_TOPGEN   3392
#define XCD_BAR_WORDS 3456
#define XB_SPIN_CAP (1u << 18)

__device__ __forceinline__ unsigned xb_ld(unsigned* p)              { return __hip_atomic_load(p, __ATOMIC_RELAXED, __HIP_MEMORY_SCOPE_AGENT); }
__device__ __forceinline__ unsigned xb_add(unsigned* p, unsigned v) { return __hip_atomic_fetch_add(p, v, __ATOMIC_RELAXED, __HIP_MEMORY_SCOPE_AGENT); }
__device__ __forceinline__ unsigned xb_xcc_id() { return (unsigned)__builtin_amdgcn_s_getreg((3 << 11) | 20) & 0xFu; }
#define XB_SPIN(cond, bar) do { unsigned _sp = 0; while (cond) { __builtin_amdgcn_s_sleep(1); \
    if ((++_sp & 255u) == 0u) { if (xb_ld(&(bar)[XB_TMO])) break; if (_sp > XB_SPIN_CAP) { atomicAdd(&(bar)[XB_TMO], 1u); break; } } } } while (0)

struct XcdBarrier {
    unsigned* bar; unsigned x;
    volatile LAS unsigned* st;
};

__device__ __forceinline__ XcdBarrier xcd_barrier_post(unsigned* bar, volatile LAS unsigned* st) {
    XcdBarrier b; b.bar = bar; b.x = xb_xcc_id(); b.st = st;
    if (threadIdx.x == 0) (void)xb_add(&bar[XB_XCNT(b.x)], 1u);
    return b;
}
__device__ __forceinline__ void xcd_barrier_complete(unsigned* bar, unsigned x, unsigned& nloc, unsigned& nx) {
    const unsigned G = gridDim.x * gridDim.y * gridDim.z;
    unsigned sum, cnt, mine, sp = 0u;
    for (;;) {
        sum = 0u; cnt = 0u; mine = 0u;
#pragma unroll
        for (unsigned j = 0; j < 16; ++j) { const unsigned c = xb_ld(&bar[XB_XCNT(j)]); sum += c; cnt += (c > 0u) ? 1u : 0u; mine = (j == x) ? c : mine; }
        if (sum == G) break;
        __builtin_amdgcn_s_sleep(1);
        if ((++sp & 255u) == 0u) { if (xb_ld(&bar[XB_TMO])) break; if (sp > XB_SPIN_CAP) { atomicAdd(&bar[XB_TMO], 1u); break; } }
    }
    nloc = mine > 0u ? mine : 1u; nx = cnt > 0u ? cnt : 1u;
}

__device__ __forceinline__ void xcd_barrier(const XcdBarrier& b) {
    asm volatile("s_waitcnt vmcnt(0)" ::: "memory");
    __syncthreads();
    if (threadIdx.x == 0) {
        unsigned* bar = b.bar;
        __builtin_amdgcn_s_waitcnt(0);
        unsigned nloc = b.st[0], nx = b.st[1];
        if (nloc == 0u) { xcd_barrier_complete(bar, b.x, nloc, nx); b.st[0] = nloc; b.st[1] = nx; }
        const unsigned old = xb_add(&bar[XB_XSUB(b.x)], 1u);
        const unsigned gen = old / nloc;
        if (old + 1u == (gen + 1u) * nloc) {
            __builtin_amdgcn_fence(__ATOMIC_RELEASE, "agent");
            asm volatile("s_waitcnt vmcnt(0)" ::: "memory");
            const unsigned og = xb_add(&bar[XB_TOP], 1u);
            const unsigned tg = og / nx;
            if (og + 1u == (tg + 1u) * nx) xb_add(&bar[XB_TOPGEN], 1u);
            else XB_SPIN(xb_ld(&bar[XB_TOPGEN]) == tg, bar);
            __builtin_amdgcn_fence(__ATOMIC_ACQUIRE, "agent");
            xb_add(&bar[XB_XGEN(b.x)], 1u);
            asm volatile("s_waitcnt vmcnt(0)" ::: "memory");
        } else {
            XB_SPIN(xb_ld(&bar[XB_XGEN(b.x)]) == gen, bar);
            __builtin_amdgcn_fence(__ATOMIC_ACQUIRE, "agent");
            asm volatile("s_waitcnt vmcnt(0)" ::: "memory");
        }
    }
    __syncthreads();
}
__device__ __forceinline__ void unpack8(const u32x4 w, float (&v)[8]) {
    v[0] = pg8::bf_lo(w.x); v[1] = pg8::bf_hi(w.x); v[2] = pg8::bf_lo(w.y); v[3] = pg8::bf_hi(w.y); v[4] = pg8::bf_lo(w.z); v[5] = pg8::bf_hi(w.z); v[6] = pg8::bf_lo(w.w); v[7] = pg8::bf_hi(w.w);
}
__device__ __forceinline__ void conv_item(const bf16_t* PROJ, const float* cw, bf16_t* Y, int item, int lane) {
    const int r0 = item * 16, c0 = lane * 8;
    float w0[8], w1[8], w2[8];
#pragma unroll
    for (int j = 0; j < 8; ++j) { w0[j] = cw[c0 + j]; w1[j] = cw[512 + c0 + j]; w2[j] = cw[1024 + c0 + j]; }
    float um1[8], um2[8];
#pragma unroll
    for (int j = 0; j < 8; ++j) { um1[j] = 0.f; um2[j] = 0.f; }
    if ((r0 & (SEQ - 1)) != 0) {
        float a[8], b[8];
        const bf16_t* p2 = PROJ + (size_t)(r0 - 2) * 3072 + c0; unpack8(*(const u32x4*)(p2 + 512), a); unpack8(*(const u32x4*)(p2 + 1024), b);
#pragma unroll
        for (int j = 0; j < 8; ++j) um2[j] = a[j] * b[j];
        const bf16_t* p1 = PROJ + (size_t)(r0 - 1) * 3072 + c0; unpack8(*(const u32x4*)(p1 + 512), a); unpack8(*(const u32x4*)(p1 + 1024), b);
#pragma unroll
        for (int j = 0; j < 8; ++j) um1[j] = a[j] * b[j];
    }
#pragma unroll 4
    for (int r = 0; r < 16; ++r) {
        const bf16_t* p = PROJ + (size_t)(r0 + r) * 3072 + c0;
        float g[8], a[8], b[8], o[8];
        unpack8(*(const u32x4*)p, g); unpack8(*(const u32x4*)(p + 512), a); unpack8(*(const u32x4*)(p + 1024), b);
#pragma unroll
        for (int j = 0; j < 8; ++j) { const float u = a[j] * b[j]; o[j] = g[j] * (w0[j] * um2[j] + w1[j] * um1[j] + w2[j] * u); um2[j] = um1[j]; um1[j] = u; }
        u32x4 w; w.x = pk2(o[0], o[1]); w.y = pk2(o[2], o[3]); w.z = pk2(o[4], o[5]); w.w = pk2(o[6], o[7]);
        *(u32x4*)(Y + (size_t)(r0 + r) * 1024 + c0) = w;
    }
}
__device__ __forceinline__ s16x4 vtr(const LAS unsigned char* p) { typedef short v4i16_t __attribute__((ext_vector_type(4))); return __builtin_bit_cast(s16x4, __builtin_amdgcn_ds_read_tr16_b64_v4i16((LAS v4i16_t*)p)); }
__device__ __forceinline__ bf16x8 cat8(s16x4 a, s16x4 b) { bf16x8 r; r[0] = a[0]; r[1] = a[1]; r[2] = a[2]; r[3] = a[3]; r[4] = b[0]; r[5] = b[1]; r[6] = b[2]; r[7] = b[3]; return r; }
constexpr int AV_STRIDE = 144;
__device__ __forceinline__ void attn_unit(const bf16_t* PROJ, bf16_t* Y, int b, int h, int qb, LAS unsigned char* vlds, int lane) {
    const int r32 = lane & 31, hi = lane >> 5;
    const size_t rowbase = (size_t)b * SEQ;
    const int t0 = qb * 32;
    bf16x8 qf[4];
    { const bf16_t* qp = PROJ + (rowbase + t0 + r32) * 3072 + 1536 + h * 64 + 8 * hi;
#pragma unroll
      for (int kk = 0; kk < 4; ++kk) qf[kk] = *(const bf16x8*)(qp + 16 * kk); }
    f32x16 o0, o1;
#pragma unroll
    for (int i = 0; i < 16; ++i) { o0[i] = 0.f; o1[i] = 0.f; }
    float carry = 0.f;
    const int g4 = lane >> 4, li = lane & 15;
    const LAS unsigned char* trbase = vlds + (4 * (g4 >> 1) + (li >> 2)) * AV_STRIDE + (16 * (g4 & 1) + 4 * (li & 3)) * 2;
    bf16x8 kf[4]; u32x4 vr[4];
#define AT_LOAD(KF, VR, K0) do { const bf16_t* kp_ = PROJ + (rowbase + (K0) + r32) * 3072 + 2048 + h * 64 + 8 * hi; \
        _Pragma("unroll") for (int kk = 0; kk < 4; ++kk) KF[kk] = *(const bf16x8*)(kp_ + 16 * kk); \
        _Pragma("unroll") for (int j = 0; j < 4; ++j) VR[j] = *(const u32x4*)(PROJ + (rowbase + (K0) + (lane >> 3) + 8 * j) * 3072 + 2560 + h * 64 + 8 * (lane & 7)); } while (0)
    AT_LOAD(kf, vr, t0);
    for (int kt = qb; kt >= 0; --kt) {
#pragma unroll
        for (int j = 0; j < 4; ++j) *(LAS u32x4*)(vlds + ((lane >> 3) + 8 * j) * AV_STRIDE + 16 * (lane & 7)) = vr[j];
        bf16x8 kfn[4]; u32x4 vrn[4];
#pragma unroll
        for (int j = 0; j < 4; ++j) { kfn[j] = kf[j]; vrn[j] = vr[j]; }
        if (kt > 0) AT_LOAD(kfn, vrn, (kt - 1) * 32);
        f32x16 sc;
#pragma unroll
        for (int i = 0; i < 16; ++i) sc[i] = 0.f;
#pragma unroll
        for (int kk = 0; kk < 4; ++kk) sc = __builtin_amdgcn_mfma_f32_32x32x16_bf16(kf[kk], qf[kk], sc, 0, 0, 0);
        const bool diag = (kt == qb);
        float lk[16], lb[16];
#pragma unroll
        for (int r = 0; r < 16; ++r) {
            const float z = sc[r], az = __builtin_fabsf(z);
            const float L = __builtin_amdgcn_logf(1.0f + __builtin_amdgcn_exp2f(-az));
            float lbv = __builtin_fminf(z, 0.f) - L, lkv = lbv - z;
            if (diag) { const int key = (r & 3) + 8 * (r >> 2) + 4 * hi; if (!(key < r32)) { lkv = 0.f; lbv = -1.0e30f; } }
            lk[r] = lkv; lb[r] = lbv;
        }
        float gs[4], pg[4], T[4];
#pragma unroll
        for (int j = 0; j < 4; ++j) { gs[j] = (lk[4 * j] + lk[4 * j + 1]) + (lk[4 * j + 2] + lk[4 * j + 3]); pg[j] = __shfl_xor(gs[j], 32); T[j] = gs[j] + pg[j]; }
        float w[16];
        float suf = carry;
#pragma unroll
        for (int j = 3; j >= 0; --j) {
            float run = suf + (hi == 0 ? pg[j] : 0.f);
#pragma unroll
            for (int i = 3; i >= 0; --i) { w[4 * j + i] = __builtin_amdgcn_exp2f(lb[4 * j + i] + run); run += lk[4 * j + i]; }
            suf += T[j];
        }
        carry = suf;
        u32x4 p0, p1;
        p0.x = pk2(w[0], w[1]); p0.y = pk2(w[2], w[3]); p0.z = pk2(w[4], w[5]); p0.w = pk2(w[6], w[7]);
        p1.x = pk2(w[8], w[9]); p1.y = pk2(w[10], w[11]); p1.z = pk2(w[12], w[13]); p1.w = pk2(w[14], w[15]);
        const bf16x8 pf0 = __builtin_bit_cast(bf16x8, p0), pf1 = __builtin_bit_cast(bf16x8, p1);
        asm volatile("s_waitcnt lgkmcnt(0)" ::: "memory");
        const bf16x8 v00 = cat8(vtr(trbase), vtr(trbase + 8 * AV_STRIDE));
        const bf16x8 v01 = cat8(vtr(trbase + 16 * AV_STRIDE), vtr(trbase + 24 * AV_STRIDE));
        const bf16x8 v10 = cat8(vtr(trbase + 64), vtr(trbase + 8 * AV_STRIDE + 64));
        const bf16x8 v11 = cat8(vtr(trbase + 16 * AV_STRIDE + 64), vtr(trbase + 24 * AV_STRIDE + 64));
        o0 = __builtin_amdgcn_mfma_f32_32x32x16_bf16(v00, pf0, o0, 0, 0, 0);
        o0 = __builtin_amdgcn_mfma_f32_32x32x16_bf16(v01, pf1, o0, 0, 0, 0);
        o1 = __builtin_amdgcn_mfma_f32_32x32x16_bf16(v10, pf0, o1, 0, 0, 0);
        o1 = __builtin_amdgcn_mfma_f32_32x32x16_bf16(v11, pf1, o1, 0, 0, 0);
        if (__builtin_amdgcn_ballot_w64(carry > -127.0f) == 0ull) break;
#pragma unroll
        for (int j = 0; j < 4; ++j) { kf[j] = kfn[j]; vr[j] = vrn[j]; }
    }
#undef AT_LOAD
    bf16_t* yp = Y + (rowbase + t0 + r32) * 1024 + 512 + h * 64 + 4 * hi;
#pragma unroll
    for (int j = 0; j < 4; ++j) {
        u32x2 a; a.x = pk2(o0[4 * j], o0[4 * j + 1]); a.y = pk2(o0[4 * j + 2], o0[4 * j + 3]); *(u32x2*)(yp + 8 * j) = a;
        u32x2 c; c.x = pk2(o1[4 * j], o1[4 * j + 1]); c.y = pk2(o1[4 * j + 2], o1[4 * j + 3]); *(u32x2*)(yp + 32 + 8 * j) = c;
    }
}
__device__ __forceinline__ void mix0_phase(const Ptrs& P, LAS unsigned char* lds, int gw, int NGW, int wave, int lane) {
    const bf16_t* PROJ = (const bf16_t*)(P.ws + WS_PROJ); bf16_t* Y = (bf16_t*)(P.ws + WS_Y);
    LAS unsigned char* vlds = lds + wave * 8192;
#ifndef DBG_NO_ATTN
    for (int it = gw; it < BATCH * 8 * (SEQ / 32); it += NGW) { const int bh = it / (SEQ / 32), qb = it % (SEQ / 32); attn_unit(PROJ, Y, bh >> 3, bh & 7, qb, vlds, lane); }
#else
    for (int m = gw; m < M; m += NGW) { *(u32x4*)(Y + (size_t)m * 1024 + 512 + 8 * lane) = (u32x4){0u, 0u, 0u, 0u}; }
#endif
    for (int it = gw; it < M / 16; it += NGW) conv_item(PROJ, P.in[11], Y, it, lane);
}
constexpr int HS = 272;
constexpr int HL_QT = 0, HL_KT = 64 * HS, HL_KH = 2 * 64 * HS, HL_V = 3 * 64 * HS, HL_V2 = 4 * 64 * HS, HL_OUT = 4 * 64 * HS;
constexpr int HSC = 144;
constexpr int HL_SC = 5 * 64 * HS, HL_SEG = HL_SC + 64 * HSC, HL_DEC = HL_SEG + 8 * 128 * 4, HL_OSQ = HL_DEC + 512, HL_END = HL_OSQ + 64 * 8 * 4;
static_assert(HL_END <= 131072, "hgrn LDS map");
constexpr size_t WS_DTOT = 256 * 1024;
constexpr int HG_NCH = 16;
#define HG_BAR() do { asm volatile("s_waitcnt lgkmcnt(0)" ::: "memory"); __builtin_amdgcn_s_barrier(); asm volatile("" ::: "memory"); } while (0)
#define MFMA16(a, b, c) __builtin_amdgcn_mfma_f32_16x16x32_bf16((a), (b), (c), 0, 0, 0)
typedef float f32x2v __attribute__((ext_vector_type(2)));
template <bool FULL>
__device__ __forceinline__ void hgrn_unit(const Ptrs& P, LAS unsigned char* lds, int bh, int sc, int tid, int wave, int lane) {
    const bf16_t* Qs = (const bf16_t*)(P.ws + WS_QS); const float* LF = (const float*)(P.ws + WS_LF); const bf16_t* Iv = (const bf16_t*)(P.ws + WS_IV); const bf16_t* Gs = (const bf16_t*)(P.ws + WS_GS);
    bf16_t* Ob = (bf16_t*)P.out;
    float* SLOC = (float*)((unsigned char*)P.out + 64 * MiB);
    float* DTOT = (float*)(P.ws + WS_DTOT);
    const int b = bh >> 3, h = bh & 7, hc = h * 128;
    const int fr = lane & 15, fq = lane >> 4;
    const int kp = lane, seg = wave;
    f32x4 S[8];
    if (FULL && sc > 0) {
        const float* sp = SLOC + ((size_t)(bh * 4) << 14) + (16 * wave + fr) * 4;
        const float* dp = DTOT + (bh * 4) * 128 + 4 * fq;
#pragma unroll
        for (int kt = 0; kt < 8; ++kt) S[kt] = *(const f32x4*)(sp + (4 * kt + fq) * 512);
        for (int j = 1; j < sc; ++j) {
#pragma unroll
            for (int kt = 0; kt < 8; ++kt) S[kt] = S[kt] * *(const f32x4*)(dp + j * 128 + 16 * kt) + *(const f32x4*)(sp + ((size_t)j << 14) + (4 * kt + fq) * 512);
        }
    } else {
#pragma unroll
        for (int kt = 0; kt < 8; ++kt) S[kt] = (f32x4){0.f, 0.f, 0.f, 0.f};
    }
    LAS float* segtot = (LAS float*)(lds + HL_SEG); LAS float* dec = (LAS float*)(lds + HL_DEC); LAS float* osq = (LAS float*)(lds + HL_OSQ);
    f32x4 on0, on1;
    if (FULL) { const float* onp = P.in[15] + 8 * (tid & 15); on0 = *(const f32x4*)onp; on1 = *(const f32x4*)(onp + 4); }
    float dprod0 = 1.f, dprod1 = 1.f;
    f32x2v lf2[8]; unsigned q2[8]; u32x4 vch[2], gch[2];
    const size_t Rbase = (size_t)b * SEQ + (size_t)sc * (64 * HG_NCH);
#define HG_LOAD_E(R0_) do { _Pragma("unroll") for (int i = 0; i < 8; ++i) { const size_t off = ((R0_) + 8 * seg + i) * 1024 + hc + 2 * kp; lf2[i] = *(const f32x2v*)(LF + off); if (FULL) q2[i] = *(const unsigned*)(Qs + off); } \
        _Pragma("unroll") for (int j = 0; j < 2; ++j) { const int ch = tid + 512 * j; vch[j] = *(const u32x4*)(Iv + ((R0_) + (ch >> 4)) * 1024 + hc + 8 * (ch & 15)); } } while (0)
#define HG_LOAD_G(R0_) do { _Pragma("unroll") for (int j = 0; j < 2; ++j) { const int ch = tid + 512 * j; gch[j] = *(const u32x4*)(Gs + ((R0_) + (ch >> 4)) * 1024 + hc + 8 * (ch & 15)); } } while (0)
    HG_LOAD_E(Rbase);
    if (FULL) HG_LOAD_G(Rbase);
#pragma unroll 1
    for (int c = 0; c < HG_NCH; ++c) {
        const size_t R0 = Rbase + (size_t)c * 64;
        const int vimg = FULL ? HL_V : ((c & 1) ? HL_V2 : HL_V);
        f32x2v cs[8]; { f32x2v run = (f32x2v){0.f, 0.f};
#pragma unroll
          for (int i = 0; i < 8; ++i) { run += lf2[i]; cs[i] = run; } }
        *(LAS f32x2v*)(segtot + seg * 128 + 2 * kp) = cs[7];
#pragma unroll
        for (int j = 0; j < 2; ++j) { const int ch = tid + 512 * j; *(LAS u32x4*)(lds + vimg + (ch >> 4) * HS + 16 * (ch & 15)) = vch[j]; }
        HG_BAR();
        f32x2v pre = (f32x2v){0.f, 0.f}, tot = (f32x2v){0.f, 0.f};
#pragma unroll
        for (int s2 = 0; s2 < 8; ++s2) { const f32x2v v = *(const LAS f32x2v*)(segtot + s2 * 128 + 2 * kp); tot += v; if (s2 < seg) pre += v; }
        const float dl0 = __builtin_amdgcn_exp2f(tot[0]), dl1 = __builtin_amdgcn_exp2f(tot[1]);
        if (seg == 0) { *(LAS f32x2v*)(dec + 2 * kp) = (f32x2v){dl0, dl1}; dprod0 *= dl0; dprod1 *= dl1; }
#pragma unroll
        for (int i = 0; i < 8; ++i) {
            const float b0 = pre[0] + cs[i][0], b1 = pre[1] + cs[i][1];
            const float k0 = (1.0f - __builtin_amdgcn_exp2f(lf2[i][0])) * __builtin_amdgcn_exp2f(-b0), k1 = (1.0f - __builtin_amdgcn_exp2f(lf2[i][1])) * __builtin_amdgcn_exp2f(-b1);
            const int o = (8 * seg + i) * HS + 4 * kp;
            *(LAS unsigned*)(lds + HL_KH + o) = pk2(k0 * dl0, k1 * dl1);
            if (FULL) {
                *(LAS unsigned*)(lds + HL_KT + o) = pk2(k0, k1);
                *(LAS unsigned*)(lds + HL_QT + o) = pk2(pg8::bf_lo(q2[i]) * __builtin_amdgcn_exp2f(b0), pg8::bf_hi(q2[i]) * __builtin_amdgcn_exp2f(b1));
            }
        }
        if (c < HG_NCH - 1) HG_LOAD_E(R0 + 64);
        HG_BAR();
        f32x4 o[4];
        bf16x8 vf[2];
        if (FULL) {
            { const int tt = wave >> 1;
#pragma unroll
              for (int e = 0; e < 2; ++e) { const int st = 2 * (wave & 1) + e; const int t = 16 * tt + fr, s0 = 16 * st + 4 * fq;
                  u32x2 w = (u32x2){0u, 0u};
                  if (st <= tt) {
                      f32x4 a4 = (f32x4){0.f, 0.f, 0.f, 0.f};
#pragma unroll
                      for (int ks = 0; ks < 4; ++ks) {
                          const bf16x8 af = *(const LAS bf16x8*)(lds + HL_KT + (16 * st + fr) * HS + (32 * ks + 8 * fq) * 2);
                          const bf16x8 bfr = *(const LAS bf16x8*)(lds + HL_QT + (16 * tt + fr) * HS + (32 * ks + 8 * fq) * 2);
                          a4 = MFMA16(af, bfr, a4);
                      }
                      const float v0 = s0 + 0 <= t ? a4[0] : 0.f, v1 = s0 + 1 <= t ? a4[1] : 0.f, v2 = s0 + 2 <= t ? a4[2] : 0.f, v3 = s0 + 3 <= t ? a4[3] : 0.f;
                      w.x = pk2(v0, v1); w.y = pk2(v2, v3);
                  }
                  *(LAS u32x2*)(lds + HL_SC + t * HSC + s0 * 2) = w;
              } }
#pragma unroll
            for (int tt = 0; tt < 4; ++tt) o[tt] = (f32x4){0.f, 0.f, 0.f, 0.f};
#pragma unroll
            for (int ks = 0; ks < 4; ++ks) {
                u32x4 sb; sb.x = pk2(S[2 * ks][0], S[2 * ks][1]); sb.y = pk2(S[2 * ks][2], S[2 * ks][3]); sb.z = pk2(S[2 * ks + 1][0], S[2 * ks + 1][1]); sb.w = pk2(S[2 * ks + 1][2], S[2 * ks + 1][3]);
                const bf16x8 sfr = __builtin_bit_cast(bf16x8, sb);
#pragma unroll
                for (int tt = 0; tt < 4; ++tt) {
                    const LAS unsigned char* ap = lds + HL_QT + (16 * tt + fr) * HS + (32 * ks + 4 * fq) * 2;
                    const s16x4 a0 = *(const LAS s16x4*)ap, a1 = *(const LAS s16x4*)(ap + 32);
                    o[tt] = MFMA16(cat8(a0, a1), sfr, o[tt]);
                }
            }
        }
        { const LAS unsigned char* tb = lds + vimg + (8 * fq + (fr >> 2)) * HS + (16 * wave + 4 * (fr & 3)) * 2;
#pragma unroll
          for (int ss = 0; ss < 2; ++ss) vf[ss] = cat8(vtr(tb + (32 * ss) * HS), vtr(tb + (32 * ss + 4) * HS)); }
        f32x4 Sn[8];
#pragma unroll
        for (int kt = 0; kt < 8; ++kt) {
            const f32x4 d4 = *(const LAS f32x4*)(dec + 16 * kt + 4 * fq);
            f32x4 a4 = S[kt] * d4;
            const LAS unsigned char* tb = lds + HL_KH + (8 * fq + (fr >> 2)) * HS + (16 * kt + 4 * (fr & 3)) * 2;
#pragma unroll
            for (int ss = 0; ss < 2; ++ss) a4 = MFMA16(cat8(vtr(tb + (32 * ss) * HS), vtr(tb + (32 * ss + 4) * HS)), vf[ss], a4);
            Sn[kt] = a4;
        }
#pragma unroll
        for (int kt = 0; kt < 8; ++kt) S[kt] = Sn[kt];
        if (FULL) {
            HG_BAR();
#pragma unroll
            for (int ss = 0; ss < 2; ++ss)
#pragma unroll
                for (int tt = 0; tt < 4; ++tt) {
                    if (ss == 1 && tt < 2) continue;
                    const bf16x8 af = *(const LAS bf16x8*)(lds + HL_SC + (16 * tt + fr) * HSC + (32 * ss + 8 * fq) * 2);
                    o[tt] = MFMA16(af, vf[ss], o[tt]);
                }
#pragma unroll
            for (int tt = 0; tt < 4; ++tt)
#pragma unroll
                for (int r = 0; r < 4; ++r) { const int t = 16 * tt + 4 * fq + r; const float ov = o[tt][r]; float q = ov * ov;
                    *(LAS unsigned short*)(lds + HL_OUT + t * HS + (16 * wave + fr) * 2) = (unsigned short)f2bf(ov);
                    q += __shfl_xor(q, 1); q += __shfl_xor(q, 2); q += __shfl_xor(q, 4); q += __shfl_xor(q, 8);
                    if (fr == 0) osq[t * 8 + wave] = q; }
            HG_BAR();
#pragma unroll
            for (int j = 0; j < 2; ++j) { const int ch = tid + 512 * j, row = ch >> 4, c16 = ch & 15;
                const f32x4 qa = *(const LAS f32x4*)(osq + row * 8), qb = *(const LAS f32x4*)(osq + row * 8 + 4);
                const float rs = 1.0f / sqrtf((((qa[0] + qa[1]) + (qa[2] + qa[3])) + ((qb[0] + qb[1]) + (qb[2] + qb[3]))) * (1.0f / 128.0f) + 1e-6f);
                const u32x4 ow = *(const LAS u32x4*)(lds + HL_OUT + row * HS + 16 * c16);
                float ov[8], gv[8]; unpack8(ow, ov); unpack8(gch[j], gv);
                u32x4 w; w.x = pk2(ov[0] * rs * on0[0] * gv[0], ov[1] * rs * on0[1] * gv[1]); w.y = pk2(ov[2] * rs * on0[2] * gv[2], ov[3] * rs * on0[3] * gv[3]);
                w.z = pk2(ov[4] * rs * on1[0] * gv[4], ov[5] * rs * on1[1] * gv[5]); w.w = pk2(ov[6] * rs * on1[2] * gv[6], ov[7] * rs * on1[3] * gv[7]);
                *(u32x4*)(Ob + (R0 + row) * 1024 + hc + 8 * c16) = w; }
            if (c < HG_NCH - 1) HG_LOAD_G(R0 + 64);
        }
    }
    if (!FULL) {
        float* sp = SLOC + ((size_t)(bh * 4 + sc) << 14) + (16 * wave + fr) * 4;
#pragma unroll
        for (int kt = 0; kt < 8; ++kt) *(f32x4*)(sp + (4 * kt + fq) * 512) = S[kt];
        if (seg == 0) *(f32x2v*)(DTOT + (bh * 4 + sc) * 128 + 2 * kp) = (f32x2v){dprod0, dprod1};
    }
    HG_BAR();
#undef HG_LOAD_E
#undef HG_LOAD_G
}
__device__ __forceinline__ void hgrn_scan(const Ptrs& P, int gw, int NGW, int lane) {
    float* SLOC = (float*)((unsigned char*)P.out + 64 * MiB); const float* DTOT = (const float*)(P.ws + WS_DTOT);
    for (int it = gw; it < 64 * 64; it += NGW) {
        const int bh = it >> 6, e0 = (it & 63) * 256 + lane * 4, k0 = (e0 >> 9) * 4;
        f32x4 v[3], d[3];
#pragma unroll
        for (int s = 0; s < 3; ++s) { v[s] = *(const f32x4*)(SLOC + ((size_t)(bh * 4 + s) << 14) + e0); d[s] = *(const f32x4*)(DTOT + (bh * 4 + s) * 128 + k0); }
        f32x4 run = v[0];
#pragma unroll
        for (int s = 1; s < 3; ++s) { run = run * d[s] + v[s]; *(f32x4*)(SLOC + ((size_t)(bh * 4 + s) << 14) + e0) = run; }
    }
}
#ifndef MK_ONE_LAUNCH
#define MK_ONE_LAUNCH 1
#endif
#ifndef MK_XCD_BAR
#define MK_XCD_BAR 1
#endif
constexpr int N_PHASES = 18;
constexpr int FIN_LDS_OFF = 131072 + 4096;
constexpr int RS_TAB_OFF = 131072 + 1024;
struct Args { Ptrs p; int ph_lo, ph_hi; };
__global__ void __launch_bounds__(NTHREADS, 2) fwd_kernel(Args args) {
    extern __shared__ __attribute__((aligned(16))) unsigned char lds_raw[];
    LAS unsigned char* lds = (LAS unsigned char*)lds_raw;
    const Ptrs& P = args.p;
    const int tid = threadIdx.x, lane = tid & 63, wave = __builtin_amdgcn_readfirstlane(tid >> 6);
    const int G = gridDim.x, bx = blockIdx.x;
    const int vcu = (G % 8 == 0) ? (bx % 8) * (G / 8) + bx / 8 : bx;
    const int gw = vcu * NWAVES + wave, NGW = G * NWAVES;
    unsigned char* ws = P.ws;
    bf16_t* H = (bf16_t*)(ws + WS_H); bf16_t* HID = (bf16_t*)(ws + WS_HID); float* SS = (float*)(ws + WS_SS);
    const int lo = args.ph_lo, hi = args.ph_hi;
#if MK_XCD_BAR
    volatile LAS unsigned* MISC = (volatile LAS unsigned*)(lds + LDS_BYTES - 256);
    if (tid < 32) MISC[tid] = 0u;
#if MK_ONE_LAUNCH
    if (bx == 0) { unsigned* cw = (unsigned*)ws + 4096; for (int i = tid; i < 12288; i += NTHREADS) __hip_atomic_store(cw + i, 0u, __ATOMIC_RELAXED, __HIP_MEMORY_SCOPE_AGENT); }
    __syncthreads();
    XcdBarrier bar; bar.bar = (unsigned*)ws + 4096; bar.x = xb_xcc_id(); bar.st = MISC + 8;
#else
    __syncthreads();
    XcdBarrier bar = xcd_barrier_post((unsigned*)ws + 4096, MISC + 8);
#endif
#endif
#define IN(k) (lo <= (k) && (k) < hi)
#if MK_XCD_BAR
#define SEAM(k) do { if (IN(k) && IN((k) + 1)) { if ((k) == 0) { cg::this_grid().sync(); if (tid == 0) (void)xb_add(&bar.bar[XB_XCNT(bar.x)], 1u); } else xcd_barrier(bar); } } while (0)
#else
#define SEAM(k) do { if (IN(k) && IN((k) + 1)) { cg::this_grid().sync(); } } while (0)
#endif
#define SSB(i) (SS + (size_t)(i) * M * 16)
#define GEMM_GU(f, ssi) do { pg8::Gemm g{H, (const bf16_t*)(ws + WS_GU) + (size_t)(f) * 5632 * 1024, M, 5632, D}; pg8::StaticOrder S; S.init(M, 5632, G, bx); \
        pg8::EpiSwiGLU E{HID, pg8::rs_table_build(lds + RS_TAB_OFF, SSB(ssi), S, tid), FF}; pg8::gemm_phase<pg8::EpiSwiGLU, pg8::StaticOrder, true, true>(lds, g, S, E); } while (0)
#define GEMM_DN(f, sso) do { pg8::Gemm g{HID, (const bf16_t*)(ws + WS_DN) + (size_t)(f) * 1024 * 2816, M, D, FF}; pg8::StaticOrder S; S.init(M, D, G, bx); \
        pg8::EpiResid<false> E{H, SSB(sso), 0.5f, nullptr}; pg8::gemm_phase<pg8::EpiResid<false>, pg8::StaticOrder, true, true>(lds, g, S, E); } while (0)

    if (IN(0)) { p0_prologue(P, lds, gw, NGW, wave, lane); }
#ifdef PROBE_P0
    __syncthreads(); if (IN(0)) { p0_prologue(P, lds, gw, NGW, wave, lane); }
#endif
    SEAM(0);
#ifdef PROBE_EARLYBAR
    xcd_barrier(bar);
#endif
    if (IN(1)) { GEMM_GU(0, 0); }
#ifdef PROBE_LATE_WG
    if (bx == PROBE_LATE_WG) { for (int d_ = 0; d_ < 400; ++d_) __builtin_amdgcn_s_sleep(127); }
#endif
#ifdef PROBE_BAR10
#if PROBE_BAR10 == 2
    asm volatile("s_waitcnt vmcnt(0)" ::: "memory"); __syncthreads();
    if (tid == 0) { __builtin_amdgcn_fence(__ATOMIC_RELEASE, "agent"); asm volatile("s_waitcnt vmcnt(0)" ::: "memory"); __builtin_amdgcn_fence(__ATOMIC_ACQUIRE, "agent"); asm volatile("s_waitcnt vmcnt(0)" ::: "memory"); }
    __syncthreads();
#elif PROBE_BAR10 == 4
    cg::this_grid().sync();
#elif PROBE_BAR10 == 3
    asm volatile("s_waitcnt vmcnt(0)" ::: "memory"); __syncthreads(); __syncthreads();
#else
    for (int i_ = 0; i_ < PROBE_BAR10; ++i_) { xcd_barrier(bar); }
#endif
#endif
#ifdef PROBE_GU2X
    xcd_barrier(bar); if (IN(1)) { GEMM_GU(0, 0); }
#endif
    SEAM(1);
#ifdef PROBE_DN2X
    if (IN(2)) { pg8::Gemm g{HID, (const bf16_t*)(ws + WS_DN), M, D, FF}; pg8::StaticOrder S; S.init(M, D, G, bx);
        pg8::EpiResid<false> E{H, SSB(1), 0.0f, nullptr}; pg8::gemm_phase<pg8::EpiResid<false>, pg8::StaticOrder, true, true>(lds, g, S, E); }
    xcd_barrier(bar);
#endif
    if (IN(2)) { GEMM_DN(0, 1); }
    SEAM(2);
    if (IN(3)) { pg8::Gemm g{H, (const bf16_t*)(ws + WS_ABIN), M, 3072, D}; pg8::StaticOrder S; S.init(M, 3072, G, bx);
        pg8::EpiProjAB E{(bf16_t*)(ws + WS_PROJ), pg8::rs_table_build(lds + RS_TAB_OFF, SSB(1), S, tid), QSCALE}; pg8::gemm_phase<pg8::EpiProjAB, pg8::StaticOrder, true, true>(lds, g, S, E); }
    SEAM(3);
    if (IN(4)) { mix0_phase(P, lds, gw, NGW, wave, lane); }
#ifdef PROBE_P4
    if (IN(4)) { mix0_phase(P, lds, gw, NGW, wave, lane); }
#endif
    SEAM(4);
    if (IN(5)) { pg8::Gemm g{(const bf16_t*)(ws + WS_Y), (const bf16_t*)(ws + WS_ABOUT), M, D, D}; pg8::StaticOrder S; S.init(M, D, G, bx);
        pg8::EpiResid<false> E{H, SSB(2), 1.0f, nullptr}; pg8::gemm_phase<pg8::EpiResid<false>, pg8::StaticOrder, true, true>(lds, g, S, E); }
    SEAM(5);
#ifdef PROBE_BAR_AT5
    xcd_barrier(bar);
#endif
#ifdef PROBE_IDLE
    { const unsigned long long t0_ = __builtin_amdgcn_s_memrealtime(); while (__builtin_amdgcn_s_memrealtime() - t0_ < 100000ull) __builtin_amdgcn_s_sleep(64); }
#endif
    if (IN(6)) { GEMM_GU(1, 2); }
    SEAM(6);
#ifdef PROBE_BAR_AT6
    xcd_barrier(bar);
#endif
    if (IN(7)) { GEMM_DN(1, 3); }
    SEAM(7);
    if (IN(8)) { GEMM_GU(2, 3); }
    SEAM(8);
    if (IN(9)) { GEMM_DN(2, 4); }
    SEAM(9);
    if (IN(10)) { pg8::Gemm g{H, (const bf16_t*)(ws + WS_CIN), M, 4096, D}; pg8::StaticOrder S; S.init(M, 4096, G, bx);
        pg8::EpiProjC E{(bf16_t*)(ws + WS_QS), (float*)(ws + WS_LF), (bf16_t*)(ws + WS_IV), (bf16_t*)(ws + WS_GS), pg8::rs_table_build(lds + RS_TAB_OFF, SSB(4), S, tid), P.in[14]};
        pg8::gemm_phase<pg8::EpiProjC, pg8::StaticOrder, true, true>(lds, g, S, E); }
    SEAM(10);
    if (IN(11)) { const int bh = bx >> 2, sc = bx & 3; if (sc < 3 && bh < 64) hgrn_unit<false>(P, lds, bh, sc, tid, wave, lane); }
    SEAM(11);
    if (IN(13)) { const int bh = bx >> 2, sc = bx & 3; if (bh < 64) hgrn_unit<true>(P, lds, bh, sc, tid, wave, lane); }
    SEAM(13);
    if (IN(14)) { pg8::Gemm g{(const bf16_t*)P.out, (const bf16_t*)(ws + WS_COUT), M, D, D}; pg8::StaticOrder S; S.init(M, D, G, bx);
        pg8::EpiResid<false> E{H, SSB(5), 1.0f, nullptr}; pg8::gemm_phase<pg8::EpiResid<false>, pg8::StaticOrder, true, true>(lds, g, S, E); }
    SEAM(14);
    if (IN(15)) { GEMM_GU(3, 5); }
    SEAM(15);
    if (IN(16)) { pg8::Gemm g{HID, (const bf16_t*)(ws + WS_DN) + (size_t)3 * 1024 * 2816, M, D, FF}; pg8::StaticOrder S; S.init(M, D, G, bx);
        pg8::EpiFinalNorm E{H, P.out, P.in[17], 0.5f, SSB(6), (unsigned*)ws + 8192, lds + FIN_LDS_OFF};
        pg8::gemm_phase<pg8::EpiFinalNorm, pg8::StaticOrder, true, true>(lds, g, S, E); }
    if (IN(18)) {
        for (int m = gw; m < M; m += NGW) { const u32x2* hr = (const u32x2*)(H + (size_t)m * D) + lane; f32x4* orow = (f32x4*)(P.out + (size_t)m * D) + lane;
#pragma unroll
            for (int j = 0; j < 4; ++j) { const u32x2 w = hr[64 * j]; orow[64 * j] = (f32x4){pg8::bf_lo(w.x), pg8::bf_hi(w.x), pg8::bf_lo(w.y), pg8::bf_hi(w.y)}; } }
    }
}

extern "C" void kernel_launch(void* const* d_in, const int* in_sizes, int n_in, void* d_out, int out_size, void* d_ws, size_t ws_size, hipStream_t stream) {
    static int grid = 0;
    if (grid == 0) {
        if (n_in != 18 || in_sizes[0] != M * D || out_size != M * D || ws_size < WS_END) { fprintf(stderr, "kernel_launch: unexpected shapes (n_in %d, in0 %d, out %d, ws %zu)\n", n_in, n_in > 0 ? in_sizes[0] : -1, out_size, ws_size); grid = -1; return; }
        int dev = 0, cus = 0, per_cu = 0;
        hipGetDevice(&dev); hipDeviceGetAttribute(&cus, hipDeviceAttributeMultiprocessorCount, dev);
        if (hipFuncSetAttribute((const void*)fwd_kernel, hipFuncAttributeMaxDynamicSharedMemorySize, LDS_BYTES) != hipSuccess) { fprintf(stderr, "kernel_launch: hipFuncSetAttribute failed\n"); grid = -1; return; }
        if (hipOccupancyMaxActiveBlocksPerMultiprocessor(&per_cu, (const void*)fwd_kernel, NTHREADS, LDS_BYTES) != hipSuccess || per_cu < 1) { fprintf(stderr, "kernel_launch: occupancy query gives %d\n", per_cu); per_cu = 1; }
        (void)hipGetLastError();
        grid = cus;
    }
    if (grid < 0) return;
    Args a{};
    for (int i = 0; i < 18; ++i) a.p.in[i] = (const float*)d_in[i];
    a.p.out = (float*)d_out; a.p.ws = (unsigned char*)d_ws;
#if MK_ONE_LAUNCH
    a.ph_lo = 0; a.ph_hi = N_PHASES;
    void* kargs[] = {&a};
    hipError_t e = hipLaunchCooperativeKernel((const void*)fwd_kernel, dim3(grid), dim3(NTHREADS), kargs, LDS_BYTES, stream);
    if (e != hipSuccess) fprintf(stderr, "kernel_launch: cooperative launch failed: %s (grid %d)\n", hipGetErrorString(e), grid);
#else
#ifdef DBG_STOP
    for (int ph = 0; ph <= DBG_STOP; ++ph) { a.ph_lo = ph; a.ph_hi = ph + 1; hipLaunchKernelGGL(fwd_kernel, dim3(grid), dim3(NTHREADS), LDS_BYTES, stream, a); }
    a.ph_lo = 18; a.ph_hi = 19; hipLaunchKernelGGL(fwd_kernel, dim3(grid), dim3(NTHREADS), LDS_BYTES, stream, a);
#else
    for (int ph = 0; ph < N_PHASES; ++ph) { a.ph_lo = ph; a.ph_hi = ph + 1; hipLaunchKernelGGL(fwd_kernel, dim3(grid), dim3(NTHREADS), LDS_BYTES, stream, a); }
#endif
#endif
}
```

```cpp
#include <hip/hip_runtime.h>
#include <hip/hip_cooperative_groups.h>
#include <cstdio>
#include <cstdint>
namespace cg = cooperative_groups;
#define MK_ONE_LAUNCH 1
namespace pg8 {
#define PG8_LAS __attribute__((address_space(3)))
typedef unsigned short bf16_t;
typedef short bf16x8 __attribute__((ext_vector_type(8)));
typedef float f32x4 __attribute__((ext_vector_type(4)));
typedef unsigned u32x4 __attribute__((ext_vector_type(4)));
constexpr int BM = 256, BK = 64, HALF = 128, HTB = HALF * BK * 2  , STAGE_BYTES = 8 * HTB, NXCD = 8, WGM = 8;

__host__ __device__ __forceinline__ int lds_byte(int r, int c) { const int st = (r >> 4) * 2 + (c >> 5), rr = r & 15, cc = c & 31, ob = rr * 64 + cc * 2; return st * 1024 + (ob ^ (((ob >> 9) & 1) << 5)); }
__host__ __device__ __forceinline__ void stage_rc(int b, int& R, int& C) { const int st = b / 1024, sb = b % 1024, swz = sb ^ (((sb >> 9) & 1) << 5); R = (st >> 1) * 16 + swz / 64; C = (st & 1) * 32 + (swz % 64) / 2; }
__host__ __device__ __forceinline__ int perm32(int rho) { const int n = rho >> 4, i = rho & 15; return 8 * (i >> 2) + 4 * n + (i & 3); }

struct Unit { int pm, pn; };
struct Gemm { const bf16_t* A; const bf16_t* Bt; int M, N, K; };

struct StaticOrder {
    int nM, nN, nwg, G, c;
    __host__ __device__ void init(int M, int N, int G_, int c_) { nM = M / BM; nN = N / BM; nwg = nM * nN; G = G_; c = c_; }
    __host__ __device__ bool next(int i, Unit& u) const {
        const long L = (long)i * G + c; if (L >= nwg) return false;
        int wgid = (int)L; { const int q = nwg / NXCD, r = nwg % NXCD, xcd = wgid % NXCD, off = wgid / NXCD; wgid = (xcd < r ? xcd * (q + 1) : r * (q + 1) + (xcd - r) * q) + off; }
        const int nig = WGM * nN, gid = wgid / nig, fm = gid * WGM, gsz = (nM - fm) < WGM ? (nM - fm) : WGM;
        u.pm = fm + ((wgid % nig) % gsz); u.pn = (wgid % nig) / gsz; return true;
    }
    __device__ __forceinline__ void a_ready(const Unit&) const {}
    __device__ __forceinline__ void done(const Unit&) const {}
};

__device__ __forceinline__ unsigned cvt_pk_bf16(float lo, float hi) { unsigned r; asm volatile("v_cvt_pk_bf16_f32 %0, %1, %2" : "=v"(r) : "v"(lo), "v"(hi)); return r; }
typedef float f32x2 __attribute__((ext_vector_type(2)));
__device__ __forceinline__ float row_rstd(const float* ss, int row) {
    const f32x4* p = (const f32x4*)(ss + (size_t)row * 16);
    const f32x4 a = p[0], b = p[1], c = p[2], d = p[3];
    const float s = ((a[0] + a[1]) + (a[2] + a[3])) + ((b[0] + b[1]) + (b[2] + b[3])) + ((c[0] + c[1]) + (c[2] + c[3])) + ((d[0] + d[1]) + (d[2] + d[3]));
    return __builtin_amdgcn_rsqf(s * (1.0f / 1024.0f) + 1e-6f);
}
struct RsTab { const PG8_LAS float* tab; int pmA, pmB; const float* ss; };
template <class Sched> __device__ __forceinline__ RsTab rs_table_build(PG8_LAS unsigned char* lds_tab, const float* ss, const Sched& S, int tid) {
    RsTab t; t.tab = (const PG8_LAS float*)lds_tab; t.pmA = -1; t.pmB = -1; t.ss = ss;
    Unit u; for (int i = 0; S.next(i, u); ++i) { if (t.pmA < 0) t.pmA = u.pm; else if (u.pm != t.pmA && t.pmB < 0) t.pmB = u.pm; }
    const int pm = tid < 256 ? t.pmA : t.pmB;
    if (pm >= 0) ((PG8_LAS float*)lds_tab)[tid] = row_rstd(ss, pm * BM + (tid & 255));
    __syncthreads();
    return t;
}
__device__ __forceinline__ float rs_lookup(const RsTab& t, const Unit& u, int r  ) {
    if (u.pm == t.pmA) return t.tab[r];
    if (u.pm == t.pmB) return t.tab[256 + r];
    return row_rstd(t.ss, u.pm * BM + r);
}
__device__ __forceinline__ float sigmoidf_(float x) { return __builtin_amdgcn_rcpf(1.0f + __builtin_amdgcn_exp2f(-1.4426950408889634f * x)); }
__device__ __forceinline__ float siluf_(float x) { return x * sigmoidf_(x); }
__device__ __forceinline__ float bf_lo(unsigned w) { return __uint_as_float(w << 16); }
__device__ __forceinline__ float bf_hi(unsigned w) { return __uint_as_float(w & 0xffff0000u); }

struct EpiSwiGLU {
    static constexpr bool PERM = true, AFTER_DRAIN = false;
    bf16_t* O; RsTab rt; int ldo;
    struct Pre {};
    __device__ __forceinline__ Pre pre(const Unit&, int, int) const { return Pre{}; }
    __device__ __forceinline__ void operator()(const f32x4 (&acc)[2][2][4][2], const Unit& u, int wr, int wc, int fr, int fq, const Pre&) const {
        const int row0 = u.pm * BM + wr * 64 + fr, col0 = u.pn * HALF + wc * 32 + 8 * fq;
#pragma unroll
        for (int ai = 0; ai < 2; ++ai)
#pragma unroll
            for (int m = 0; m < 4; ++m) {
                const int row = row0 + ai * HALF + m * 16; const float rs = rs_lookup(rt, u, ai * HALF + wr * 64 + m * 16 + fr), c1 = -1.4426950408889634f * rs, rs2 = rs * rs;
                float h[8];
#pragma unroll
                for (int n = 0; n < 2; ++n)
#pragma unroll
                    for (int i = 0; i < 4; ++i) { const float g = acc[ai][0][m][n][i], up = acc[ai][1][m][n][i];
                        h[4 * n + i] = (g * up) * (rs2 * __builtin_amdgcn_rcpf(1.0f + __builtin_amdgcn_exp2f(g * c1))); }
                u32x4 w; w.x = cvt_pk_bf16(h[0], h[1]); w.y = cvt_pk_bf16(h[2], h[3]); w.z = cvt_pk_bf16(h[4], h[5]); w.w = cvt_pk_bf16(h[6], h[7]);
                *(u32x4*)(O + (size_t)row * ldo + col0) = w;
            }
    }
};
template <bool F32OUT> struct EpiResid {
    static constexpr bool PERM = true, AFTER_DRAIN = false;
    bf16_t* H; float* ssout; float alpha; float* out32;
    struct Pre {};
    __device__ __forceinline__ Pre pre(const Unit&, int, int) const { return Pre{}; }
    __device__ __forceinline__ void operator()(const f32x4 (&acc)[2][2][4][2], const Unit& u, int wr, int wc, int fr, int fq, const Pre&) const {
        const int row0 = u.pm * BM + wr * 64 + fr, col0 = u.pn * BM + wc * 32 + 8 * fq;
#pragma unroll
        for (int ai = 0; ai < 2; ++ai) {
            u32x4 old[4][2];
#pragma unroll
            for (int m = 0; m < 4; ++m)
#pragma unroll
                for (int bj = 0; bj < 2; ++bj) old[m][bj] = *(const u32x4*)(H + (size_t)(row0 + ai * HALF + m * 16) * 1024 + col0 + bj * HALF);
#pragma unroll
            for (int m = 0; m < 4; ++m) {
                const int row = row0 + ai * HALF + m * 16; float sq = 0.f;
#pragma unroll
                for (int bj = 0; bj < 2; ++bj) {
                    bf16_t* hp = H + (size_t)row * 1024 + col0 + bj * HALF;
                    const u32x4 o4 = old[m][bj];
                    float v[8];
                    v[0] = bf_lo(o4.x); v[1] = bf_hi(o4.x); v[2] = bf_lo(o4.y); v[3] = bf_hi(o4.y); v[4] = bf_lo(o4.z); v[5] = bf_hi(o4.z); v[6] = bf_lo(o4.w); v[7] = bf_hi(o4.w);
#pragma unroll
                    for (int n = 0; n < 2; ++n)
#pragma unroll
                        for (int i = 0; i < 4; ++i) { v[4 * n + i] += alpha * acc[ai][bj][m][n][i]; sq += v[4 * n + i] * v[4 * n + i]; }
                    u32x4 w; w.x = cvt_pk_bf16(v[0], v[1]); w.y = cvt_pk_bf16(v[2], v[3]); w.z = cvt_pk_bf16(v[4], v[5]); w.w = cvt_pk_bf16(v[6], v[7]);
                    *(u32x4*)hp = w;
                    if (F32OUT) { float* op = out32 + (size_t)row * 1024 + col0 + bj * HALF; *(f32x4*)op = (f32x4){v[0], v[1], v[2], v[3]}; *(f32x4*)(op + 4) = (f32x4){v[4], v[5], v[6], v[7]}; }
                }
                sq += __shfl_xor(sq, 16); sq += __shfl_xor(sq, 32);
                if (fq == 0) ssout[(size_t)row * 16 + u.pn * 4 + wc] = sq;
            }
        }
    }
};
struct EpiFinalNorm {
    static constexpr bool PERM = false, AFTER_DRAIN = false;
    const bf16_t* H; float* out; const float* gain; float alpha;
    float* xslots;
    unsigned* cnt;
    PG8_LAS unsigned char* xl;
    struct Pre {};
    __device__ __forceinline__ Pre pre(const Unit&, int, int) const { return Pre{}; }
    __device__ __forceinline__ void operator()(f32x4 (&acc)[2][2][4][2], const Unit& u, int wr, int wc, int fr, int fq, const Pre&) const {
        const int tid = threadIdx.x, lane = tid & 63, wid = __builtin_amdgcn_readfirstlane(tid >> 6);
        PG8_LAS float* P = (PG8_LAS float*)xl; PG8_LAS float* S = (PG8_LAS float*)(xl + 4096);
        const int row0 = u.pm * BM + wr * 64 + fr, col0 = u.pn * BM + wc * 32 + 4 * fq;
        typedef unsigned u32x2_t __attribute__((ext_vector_type(2)));
#pragma unroll
        for (int ai = 0; ai < 2; ++ai)
#pragma unroll
            for (int m = 0; m < 4; ++m) {
                const int row = row0 + ai * HALF + m * 16; float sq = 0.f;
#pragma unroll
                for (int bj = 0; bj < 2; ++bj)
#pragma unroll
                    for (int n = 0; n < 2; ++n) {
                        const u32x2_t o = *(const u32x2_t*)(H + (size_t)row * 1024 + col0 + bj * HALF + n * 16);
                        f32x4 v = (f32x4){bf_lo(o.x), bf_hi(o.x), bf_lo(o.y), bf_hi(o.y)} + alpha * acc[ai][bj][m][n];
                        acc[ai][bj][m][n] = v; sq += (v[0] * v[0] + v[1] * v[1]) + (v[2] * v[2] + v[3] * v[3]);
                    }
                sq += __shfl_xor(sq, 16); sq += __shfl_xor(sq, 32);
                if (fq == 0) P[(ai * HALF + wr * 64 + m * 16 + fr) * 4 + wc] = sq;
            }
        asm volatile("s_waitcnt lgkmcnt(0)" ::: "memory"); __builtin_amdgcn_s_barrier(); asm volatile("" ::: "memory");
        if (tid < 256) { const f32x4 p = *(const PG8_LAS f32x4*)(P + tid * 4);
            __hip_atomic_store(xslots + ((size_t)u.pm * BM + tid) * 4 + u.pn, (p[0] + p[1]) + (p[2] + p[3]), __ATOMIC_RELAXED, __HIP_MEMORY_SCOPE_AGENT); }
        asm volatile("s_waitcnt vmcnt(0)" ::: "memory");
        if (tid < 256 && lane == 0) __hip_atomic_fetch_add(cnt + 64 * u.pm, 1u, __ATOMIC_RELAXED, __HIP_MEMORY_SCOPE_AGENT);
        if (wid == 0) {
            unsigned sp = 0;
            while ((unsigned)__builtin_amdgcn_readfirstlane(__hip_atomic_load(cnt + 64 * u.pm, __ATOMIC_RELAXED, __HIP_MEMORY_SCOPE_AGENT)) < 16u) { __builtin_amdgcn_s_sleep(2); if (++sp > (1u << 18)) break; }
            __builtin_amdgcn_fence(__ATOMIC_ACQUIRE, "agent");
        }
        asm volatile("s_waitcnt vmcnt(0) lgkmcnt(0)" ::: "memory"); __builtin_amdgcn_s_barrier(); asm volatile("" ::: "memory");
        if (tid < 256) { const float* sl = xslots + ((size_t)u.pm * BM + tid) * 4;
            const float t = (__hip_atomic_load(sl, __ATOMIC_RELAXED, __HIP_MEMORY_SCOPE_AGENT) + __hip_atomic_load(sl + 1, __ATOMIC_RELAXED, __HIP_MEMORY_SCOPE_AGENT))
                          + (__hip_atomic_load(sl + 2, __ATOMIC_RELAXED, __HIP_MEMORY_SCOPE_AGENT) + __hip_atomic_load(sl + 3, __ATOMIC_RELAXED, __HIP_MEMORY_SCOPE_AGENT));
            S[tid] = __builtin_amdgcn_rsqf(t * (1.0f / 1024.0f) + 1e-6f); }
        asm volatile("s_waitcnt lgkmcnt(0)" ::: "memory"); __builtin_amdgcn_s_barrier(); asm volatile("" ::: "memory");
        f32x4 gv[2][2];
#pragma unroll
        for (int bj = 0; bj < 2; ++bj)
#pragma unroll
            for (int n = 0; n < 2; ++n) gv[bj][n] = *(const f32x4*)(gain + col0 + bj * HALF + n * 16);
#pragma unroll
        for (int ai = 0; ai < 2; ++ai)
#pragma unroll
            for (int m = 0; m < 4; ++m) {
                const int r = ai * HALF + wr * 64 + m * 16 + fr; const float rs = S[r];
                float* op = out + (size_t)(u.pm * BM + r) * 1024 + col0;
#pragma unroll
                for (int bj = 0; bj < 2; ++bj)
#pragma unroll
                    for (int n = 0; n < 2; ++n) __builtin_nontemporal_store(acc[ai][bj][m][n] * rs * gv[bj][n], (f32x4*)(op + bj * HALF + n * 16));
            }
    }
};
struct EpiProjAB {
    static constexpr bool PERM = true, AFTER_DRAIN = false;
    bf16_t* O; RsTab rt; float qscale;
    struct Pre {};
    __device__ __forceinline__ Pre pre(const Unit&, int, int) const { return Pre{}; }
    __device__ __forceinline__ void operator()(const f32x4 (&acc)[2][2][4][2], const Unit& u, int wr, int wc, int fr, int fq, const Pre&) const {
        const int row0 = u.pm * BM + wr * 64 + fr, col0 = u.pn * BM + wc * 32 + 8 * fq;
        const float sc = (u.pn == 6 || u.pn == 7) ? qscale : 1.0f;
#pragma unroll
        for (int ai = 0; ai < 2; ++ai)
#pragma unroll
            for (int m = 0; m < 4; ++m) {
                const int row = row0 + ai * HALF + m * 16; const float rs = rs_lookup(rt, u, ai * HALF + wr * 64 + m * 16 + fr) * sc;
#pragma unroll
                for (int bj = 0; bj < 2; ++bj) {
                    const f32x4 a = acc[ai][bj][m][0] * rs, b = acc[ai][bj][m][1] * rs;
                    u32x4 w; w.x = cvt_pk_bf16(a[0], a[1]); w.y = cvt_pk_bf16(a[2], a[3]); w.z = cvt_pk_bf16(b[0], b[1]); w.w = cvt_pk_bf16(b[2], b[3]);
                    *(u32x4*)(O + (size_t)row * 3072 + col0 + bj * HALF) = w;
                }
            }
    }
};
struct EpiProjC {
    static constexpr bool PERM = true, AFTER_DRAIN = false;
    bf16_t* Qs; float* LF; bf16_t* Iv; bf16_t* Gs; RsTab rt; const float* clb;
    struct Pre {};
    __device__ __forceinline__ Pre pre(const Unit&, int, int) const { return Pre{}; }
    __device__ __forceinline__ void operator()(const f32x4 (&acc)[2][2][4][2], const Unit& u, int wr, int wc, int fr, int fq, const Pre&) const {
        const int kind = u.pn >> 2;
        const int row0 = u.pm * BM + wr * 64 + fr, col0 = (u.pn & 3) * BM + wc * 32 + 8 * fq;
        if (kind == 1) {
            float lb[2][8];
#pragma unroll
            for (int bj = 0; bj < 2; ++bj)
#pragma unroll
                for (int j = 0; j < 8; ++j) { const int c = col0 + bj * HALF + j; lb[bj][j] = sigmoidf_(clb[1024 + c] - clb[c]); }
#pragma unroll
            for (int ai = 0; ai < 2; ++ai)
#pragma unroll
                for (int m = 0; m < 4; ++m) {
                    const int row = row0 + ai * HALF + m * 16; const float rs = rs_lookup(rt, u, ai * HALF + wr * 64 + m * 16 + fr);
#pragma unroll
                    for (int bj = 0; bj < 2; ++bj) {
                        float v[8];
#pragma unroll
                        for (int n = 0; n < 2; ++n)
#pragma unroll
                            for (int i = 0; i < 4; ++i) { const float x = acc[ai][bj][m][n][i] * rs, l = lb[bj][4 * n + i]; v[4 * n + i] = __builtin_amdgcn_logf(l + (1.0f - l) * sigmoidf_(x)); }
                        float* op = LF + (size_t)row * 1024 + col0 + bj * HALF; *(f32x4*)op = (f32x4){v[0], v[1], v[2], v[3]}; *(f32x4*)(op + 4) = (f32x4){v[4], v[5], v[6], v[7]};
                    }
                }
        } else {
            bf16_t* O = Qs + (kind ? ((size_t)(64 + 64 * kind) << 19) : (size_t)0);
            const bool act = kind != 2;
#pragma unroll
            for (int ai = 0; ai < 2; ++ai)
#pragma unroll
                for (int m = 0; m < 4; ++m) {
                    const int row = row0 + ai * HALF + m * 16; const float rs = rs_lookup(rt, u, ai * HALF + wr * 64 + m * 16 + fr);
#pragma unroll
                    for (int bj = 0; bj < 2; ++bj) {
                        float v[8];
#pragma unroll
                        for (int n = 0; n < 2; ++n)
#pragma unroll
                            for (int i = 0; i < 4; ++i) { const float x = acc[ai][bj][m][n][i] * rs; v[4 * n + i] = act ? siluf_(x) : x; }
                        u32x4 w; w.x = cvt_pk_bf16(v[0], v[1]); w.y = cvt_pk_bf16(v[2], v[3]); w.z = cvt_pk_bf16(v[4], v[5]); w.w = cvt_pk_bf16(v[6], v[7]);
                        *(u32x4*)(O + (size_t)row * 1024 + col0 + bj * HALF) = w;
                    }
                }
        }
    }
};
template <class Epi, class Sched, bool ALIGN_EPI = false, bool SP2 = false>
__device__ __forceinline__ void gemm_phase(PG8_LAS unsigned char* lds, const Gemm g, const Sched& S, const Epi& E) {
    const int tid = threadIdx.x, wid = __builtin_amdgcn_readfirstlane(tid >> 6), lane = tid & 63, wr = wid >> 2, wc = wid & 3, fr = lane & 15, fq = lane >> 4;
    const int K = g.K, nt = K / BK;
    unsigned voffA[2], voffB[2];
#pragma unroll
    for (int i = 0; i < 2; ++i) { int R, C; stage_rc(tid * 16 + i * 8192, R, C); const int Rb = Epi::PERM ? ((R & ~31) + perm32(R & 31)) : R;
        voffA[i] = (unsigned)(R * K + C) * 2u; voffB[i] = (unsigned)(Rb * K + C) * 2u; }
    const size_t kstep = (size_t)(BK * 2);
    const size_t hstep = (size_t)HALF * K * 2;
    const size_t tstep = 2 * hstep;
    const unsigned ldsw = (unsigned)wid * 1024u;
    const int aoff = lds_byte(wr * 64 + fr, fq * 8), boff = lds_byte(wc * 32 + fr, fq * 8);
#define PG8_SA(b, h) (((b) * 2 + (h)) * HTB)
#define PG8_SB(b, h) ((4 + (b) * 2 + (h)) * HTB)
#define PG8_STAGE(bufoff, gbase, voff) do { _Pragma("unroll") for (int _i = 0; _i < 2; ++_i) \
        __builtin_amdgcn_global_load_lds((const unsigned*)((const char*)(gbase) + (voff)[_i]), (PG8_LAS unsigned*)(lds + (bufoff) + ldsw + _i * 8192), 16, 0, 0); } while (0)
#define PG8_LDA(dst, b, h) do { _Pragma("unroll") for (int m = 0; m < 4; ++m) _Pragma("unroll") for (int k = 0; k < 2; ++k) dst[m][k] = *(const PG8_LAS bf16x8*)(lds + PG8_SA(b, h) + aoff + m * 2048 + k * 1024); } while (0)
#define PG8_LDB(dst, b, h) do { _Pragma("unroll") for (int n = 0; n < 2; ++n) _Pragma("unroll") for (int k = 0; k < 2; ++k) dst[n][k] = *(const PG8_LAS bf16x8*)(lds + PG8_SB(b, h) + boff + n * 2048 + k * 1024); } while (0)
#define PG8_MMA(ai, bj, At, Bt) do { __builtin_amdgcn_s_setprio(1); _Pragma("unroll") for (int m = 0; m < 4; ++m) _Pragma("unroll") for (int n = 0; n < 2; ++n) _Pragma("unroll") for (int k = 0; k < 2; ++k) \
        acc[ai][bj][m][n] = __builtin_amdgcn_mfma_f32_16x16x32_bf16(Bt[n][k], At[m][k], acc[ai][bj][m][n], 0, 0, 0); __builtin_amdgcn_s_setprio(0); } while (0)
#define PG8_WAIT_V(n) asm volatile("s_waitcnt vmcnt(" #n ")" ::: "memory")
#define PG8_WAIT_L(n) asm volatile("s_waitcnt lgkmcnt(" #n ")" ::: "memory")
#define PG8_BAR __builtin_amdgcn_s_barrier()
#define PG8_SCHED __builtin_amdgcn_sched_barrier(0)
    Unit cur, nxt; int ui = 0;
    if (!S.next(0, cur)) return;
    f32x4 acc[2][2][4][2];
#pragma unroll
    for (int a = 0; a < 2; ++a)
#pragma unroll
        for (int b = 0; b < 2; ++b)
#pragma unroll
            for (int m = 0; m < 4; ++m)
#pragma unroll
                for (int n = 0; n < 2; ++n) acc[a][b][m][n] = (f32x4){0.f, 0.f, 0.f, 0.f};
    bf16x8 At[4][2], B0[2][2], B1[2][2];
    const char* cA = (const char*)g.A + (size_t)cur.pm * tstep; const char* cB = (const char*)g.Bt + (size_t)cur.pn * tstep;
    S.a_ready(cur);
    if constexpr (SP2) {
        PG8_STAGE(PG8_SB(0, 0), cB, voffB); PG8_STAGE(PG8_SB(0, 1), cB + hstep, voffB); PG8_STAGE(PG8_SA(0, 0), cA, voffA); PG8_STAGE(PG8_SA(0, 1), cA + hstep, voffA);
        if (wr == 1) PG8_BAR;
        PG8_WAIT_V(2); PG8_BAR;
        PG8_STAGE(PG8_SB(1, 0), cB + kstep, voffB); PG8_STAGE(PG8_SA(1, 0), cA + kstep, voffA); PG8_STAGE(PG8_SB(1, 1), cB + hstep + kstep, voffB);
        PG8_WAIT_V(6); PG8_BAR;
    } else {
        PG8_STAGE(PG8_SB(0, 0), cB, voffB); PG8_STAGE(PG8_SA(0, 0), cA, voffA); PG8_STAGE(PG8_SB(0, 1), cB + hstep, voffB); PG8_STAGE(PG8_SA(0, 1), cA + hstep, voffA);
        if (wr == 1) PG8_BAR;
        PG8_WAIT_V(4); PG8_BAR;
        PG8_STAGE(PG8_SB(1, 0), cB + kstep, voffB); PG8_STAGE(PG8_SA(1, 0), cA + kstep, voffA); PG8_STAGE(PG8_SB(1, 1), cB + hstep + kstep, voffB);
        PG8_WAIT_V(6); PG8_BAR;
    }
    for (;;) {
        const bool has_next = S.next(ui + 1, nxt);
        const char* nA = has_next ? (const char*)g.A + (size_t)nxt.pm * tstep : cA; const char* nB = has_next ? (const char*)g.Bt + (size_t)nxt.pn * tstep : cB;
        for (int t = 0; t < nt; t += 2) {
            const bool last = (t == nt - 2);
            const char* a1 = cA + (size_t)(t + 1) * kstep;
            const char* a2 = last ? nA : cA + (size_t)(t + 2) * kstep; const char* b2 = last ? nB : cB + (size_t)(t + 2) * kstep;
            const char* a3 = a2 + kstep; const char* b3 = b2 + kstep;
            if (last && has_next) S.a_ready(nxt);
            if constexpr (SP2) {
            PG8_LDB(B0, 0, 0); PG8_LDB(B1, 0, 1); PG8_SCHED; PG8_LDA(At, 0, 0); PG8_STAGE(PG8_SA(1, 1), a1 + hstep, voffA);
            PG8_WAIT_V(8); PG8_WAIT_L(0); PG8_BAR; PG8_MMA(0, 0, At, B0); PG8_MMA(0, 1, At, B1); PG8_BAR; PG8_SCHED;
            PG8_LDA(At, 0, 1); PG8_STAGE(PG8_SB(0, 0), b2, voffB); PG8_STAGE(PG8_SB(0, 1), b2 + hstep, voffB); PG8_STAGE(PG8_SA(0, 0), a2, voffA);
            PG8_WAIT_V(8); PG8_WAIT_L(0); PG8_BAR; PG8_MMA(1, 0, At, B0); PG8_MMA(1, 1, At, B1); PG8_BAR; PG8_SCHED;
            PG8_LDB(B0, 1, 0); PG8_LDB(B1, 1, 1); PG8_SCHED; PG8_LDA(At, 1, 0); PG8_STAGE(PG8_SA(0, 1), a2 + hstep, voffA);
            PG8_WAIT_V(8); PG8_WAIT_L(0); PG8_BAR; PG8_MMA(0, 0, At, B0); PG8_MMA(0, 1, At, B1); PG8_BAR; PG8_SCHED;
            PG8_LDA(At, 1, 1); PG8_STAGE(PG8_SB(1, 0), b3, voffB); PG8_STAGE(PG8_SB(1, 1), b3 + hstep, voffB); PG8_STAGE(PG8_SA(1, 0), a3, voffA);
            PG8_WAIT_V(8); PG8_WAIT_L(0); PG8_BAR; PG8_MMA(1, 0, At, B0); PG8_MMA(1, 1, At, B1); PG8_BAR; PG8_SCHED;
            } else {
            PG8_LDB(B0, 0, 0); PG8_SCHED; PG8_LDA(At, 0, 0); PG8_STAGE(PG8_SA(1, 1), a1 + hstep, voffA);
            PG8_WAIT_L(8); PG8_BAR; PG8_WAIT_L(0); PG8_MMA(0, 0, At, B0); PG8_BAR; PG8_SCHED;
            PG8_LDB(B1, 0, 1); PG8_STAGE(PG8_SB(0, 0), b2, voffB);
            PG8_BAR; PG8_WAIT_L(0); PG8_MMA(0, 1, At, B1); PG8_BAR;
            PG8_LDA(At, 0, 1); PG8_STAGE(PG8_SA(0, 0), a2, voffA);
            PG8_BAR; PG8_WAIT_L(0); PG8_MMA(1, 0, At, B0); PG8_BAR; PG8_SCHED;
            PG8_STAGE(PG8_SB(0, 1), b2 + hstep, voffB);
            PG8_WAIT_V(6); PG8_BAR; PG8_MMA(1, 1, At, B1); PG8_BAR;
            PG8_LDB(B0, 1, 0); PG8_SCHED; PG8_LDA(At, 1, 0); PG8_STAGE(PG8_SA(0, 1), a2 + hstep, voffA);
            PG8_WAIT_L(8); PG8_BAR; PG8_WAIT_L(0); PG8_MMA(0, 0, At, B0); PG8_BAR; PG8_SCHED;
            PG8_LDB(B1, 1, 1); PG8_STAGE(PG8_SB(1, 0), b3, voffB);
            PG8_BAR; PG8_WAIT_L(0); PG8_MMA(0, 1, At, B1); PG8_BAR;
            PG8_LDA(At, 1, 1); PG8_STAGE(PG8_SA(1, 0), a3, voffA);
            PG8_BAR; PG8_WAIT_L(0); PG8_MMA(1, 0, At, B0); PG8_BAR; PG8_SCHED;
            PG8_STAGE(PG8_SB(1, 1), b3 + hstep, voffB);
            PG8_WAIT_V(6); PG8_BAR; PG8_MMA(1, 1, At, B1); PG8_BAR;
            }
        }
        if constexpr (ALIGN_EPI) { if (wr == 0) PG8_BAR; }
        if constexpr (!Epi::AFTER_DRAIN) { E(acc, cur, wr, wc, fr, fq, E.pre(cur, wr, lane)); S.done(cur); }
        if (!has_next) break;
#pragma unroll
        for (int a = 0; a < 2; ++a)
#pragma unroll
            for (int b = 0; b < 2; ++b)
#pragma unroll
                for (int m = 0; m < 4; ++m)
#pragma unroll
                    for (int n = 0; n < 2; ++n) acc[a][b][m][n] = (f32x4){0.f, 0.f, 0.f, 0.f};
        cur = nxt; cA = nA; cB = nB; ++ui;
        if constexpr (ALIGN_EPI) { if (wr == 1) PG8_BAR; }
    }
    PG8_WAIT_V(0);
    if constexpr (!ALIGN_EPI) { if (wr == 0) PG8_BAR; }
    PG8_BAR;
    if constexpr (Epi::AFTER_DRAIN) { E.fused(acc, cur, wr, wc, fr, fq, lds, wid, lane); S.done(cur); }
#undef PG8_SA
#undef PG8_SB
#undef PG8_STAGE
#undef PG8_LDA
#undef PG8_LDB
#undef PG8_MMA
#undef PG8_WAIT_V
#undef PG8_WAIT_L
#undef PG8_BAR
#undef PG8_SCHED
}
}
using pg8::bf16_t; using pg8::bf16x8; using pg8::f32x4; using pg8::u32x4;
typedef float f32x16 __attribute__((ext_vector_type(16)));
typedef short s16x4 __attribute__((ext_vector_type(4)));
typedef unsigned u32x2 __attribute__((ext_vector_type(2)));
#define LAS __attribute__((address_space(3)))
constexpr int NWAVES = 8, NTHREADS = 512;
constexpr int BATCH = 8, SEQ = 4096, D = 1024, FF = 2816, M = BATCH * SEQ;
constexpr float QSCALE = 0.125f * 1.4426950408889634f;
constexpr size_t MiB = 1u << 20;
constexpr size_t WS_GU = 1 * MiB;
constexpr size_t WS_DN = WS_GU + 44 * MiB;
constexpr size_t WS_ABIN = WS_DN + 22 * MiB;
constexpr size_t WS_ABOUT = WS_ABIN + 6 * MiB;
constexpr size_t WS_CIN = WS_ABOUT + 2 * MiB;
constexpr size_t WS_COUT = WS_CIN + 8 * MiB;
constexpr size_t WS_H = WS_COUT + 2 * MiB;
constexpr size_t WS_SS = WS_H + 64 * MiB;
constexpr size_t WS_R = WS_SS + 14 * MiB;
constexpr size_t WS_HID = WS_R, WS_PROJ = WS_R, WS_Y = WS_R + 192 * MiB;
constexpr size_t WS_QS = WS_R, WS_LF = WS_R + 64 * MiB, WS_IV = WS_R + 192 * MiB, WS_GS = WS_R + 256 * MiB;
constexpr size_t WS_END = WS_R + 320 * MiB;
static_assert(WS_END <= 512 * MiB, "workspace map");
constexpr int LDS_BYTES = 147456;

__device__ __forceinline__ unsigned f2bf(float f) { unsigned u = __builtin_bit_cast(unsigned, f); return (u + 0x7fffu + ((u >> 16) & 1u)) >> 16; }
__device__ __forceinline__ unsigned pk2(float lo, float hi) { return pg8::cvt_pk_bf16(lo, hi); }
__device__ __forceinline__ float wave_sum(float v) {
#pragma unroll
    for (int o = 1; o < 64; o <<= 1) v += __shfl_xor(v, o);
    return v;
}
constexpr int P0_SCR = 64 * 65 * 4;
__device__ __forceinline__ void p0_transpose_item(const float* W, int K, int N, const float* gain, bf16_t* WT, int k0, int n0, int orow0, LAS float* scr, int lane) {
    const int lr = lane >> 4, lc = (lane & 15) * 4;
    f32x4 v[16];
#pragma unroll
    for (int j = 0; j < 16; ++j) v[j] = __builtin_nontemporal_load((const f32x4*)(W + (size_t)(k0 + 4 * j + lr) * N + n0 + lc));
    if (gain) {
#pragma unroll
        for (int j = 0; j < 16; ++j) v[j] = v[j] * gain[k0 + 4 * j + lr];
    }
#pragma unroll
    for (int j = 0; j < 16; ++j) { LAS float* d = scr + (4 * j + lr) * 65 + lc; d[0] = v[j][0]; d[1] = v[j][1]; d[2] = v[j][2]; d[3] = v[j][3]; }
    asm volatile("s_waitcnt lgkmcnt(0)" ::: "memory");
    const int c = lane & 7;
#pragma unroll
    for (int j = 0; j < 8; ++j) { const int n = (lane >> 3) + 8 * j; const LAS float* s = scr + (8 * c) * 65 + n;
        u32x4 o; o.x = pk2(s[0 * 65], s[1 * 65]); o.y = pk2(s[2 * 65], s[3 * 65]); o.z = pk2(s[4 * 65], s[5 * 65]); o.w = pk2(s[6 * 65], s[7 * 65]);
        *(u32x4*)(WT + (size_t)(orow0 + n) * K + k0 + 8 * c) = o; }
    asm volatile("s_waitcnt lgkmcnt(0)" ::: "memory");
}
struct Ptrs {
    const float* in[18]; float* out; unsigned char* ws;
};
__device__ __forceinline__ void p0_prologue(const Ptrs& P, LAS unsigned char* lds, int gw, int NGW, int wave, int lane) {
    unsigned char* ws = P.ws;
    const float* x = P.in[0]; bf16_t* H = (bf16_t*)(ws + WS_H); float* ss0 = (float*)(ws + WS_SS);
    for (int m0 = gw * 4; m0 < M; m0 += NGW * 4) {
        f32x4 v[4][4];
#pragma unroll
        for (int r = 0; r < 4; ++r)
#pragma unroll
            for (int j = 0; j < 4; ++j) v[r][j] = __builtin_nontemporal_load((const f32x4*)(x + (size_t)(m0 + r) * D) + lane + 64 * j);
#pragma unroll
        for (int r = 0; r < 4; ++r) {
            float s = 0.f;
#pragma unroll
            for (int j = 0; j < 4; ++j) s += (v[r][j][0] * v[r][j][0] + v[r][j][1] * v[r][j][1]) + (v[r][j][2] * v[r][j][2] + v[r][j][3] * v[r][j][3]);
            s = wave_sum(s);
            u32x2* o8 = (u32x2*)(H + (size_t)(m0 + r) * D) + lane;
#pragma unroll
            for (int j = 0; j < 4; ++j) { u32x2 w; w.x = pk2(v[r][j][0], v[r][j][1]); w.y = pk2(v[r][j][2], v[r][j][3]); o8[64 * j] = w; }
            if (lane < 16) ss0[(size_t)(m0 + r) * 16 + lane] = lane == 0 ? s : 0.f;
        }
    }
    LAS float* scr = (LAS float*)(lds + wave * P0_SCR);
    constexpr int I_FFN = 704;
    constexpr int I_ABIN = 16 * 48, I_ABOUT = 16 * 16, I_CIN = 16 * 64, I_COUT = 16 * 16;
    constexpr int NITEMS = 12 * I_FFN + I_ABIN + I_ABOUT + I_CIN + I_COUT;
    for (int it = gw; it < NITEMS; it += NGW) {
        int r = it;
        if (r < 12 * I_FFN) {
            const int mat = r / I_FFN, item = r % I_FFN, f = mat / 3, type = mat % 3;
            const int layer = f >> 1, post = f & 1;
            if (type < 2) {
                const float* Wg = post ? P.in[7] : P.in[2]; const float* Wu = post ? P.in[8] : P.in[3]; const float* W = (type == 0 ? Wg : Wu) + (size_t)layer * D * FF;
                const float* gain = (post ? P.in[6] : P.in[1]) + layer * D;
                const int nblk = FF / 64, kb = item / nblk, nb = item % nblk, n0 = 64 * nb;
                const int orow0 = (n0 >> 7) * 256 + (n0 & 127) + (type == 1 ? 128 : 0);
                p0_transpose_item(W, D, FF, gain, (bf16_t*)(ws + WS_GU) + (size_t)f * 5632 * 1024, 64 * kb, n0, orow0, scr, lane);
            } else {
                const float* W = (post ? P.in[9] : P.in[4]) + (size_t)layer * FF * D;
                const int nblk = D / 64, kb = item / nblk, nb = item % nblk, n0 = 64 * nb;
                p0_transpose_item(W, FF, D, nullptr, (bf16_t*)(ws + WS_DN) + (size_t)f * 1024 * 2816, 64 * kb, n0, n0, scr, lane);
            }
            continue;
        }
        r -= 12 * I_FFN;
        if (r < I_ABIN) { const int nblk = 48, kb = r / nblk, nb = r % nblk; p0_transpose_item(P.in[10], D, 3072, P.in[5], (bf16_t*)(ws + WS_ABIN), 64 * kb, 64 * nb, 64 * nb, scr, lane); continue; }
        r -= I_ABIN;
        if (r < I_ABOUT) { const int nblk = 16, kb = r / nblk, nb = r % nblk; p0_transpose_item(P.in[12], D, D, nullptr, (bf16_t*)(ws + WS_ABOUT), 64 * kb, 64 * nb, 64 * nb, scr, lane); continue; }
        r -= I_ABOUT;
        if (r < I_CIN) { const int nblk = 64, kb = r / nblk, nb = r % nblk; p0_transpose_item(P.in[13], D, 4096, P.in[5] + D, (bf16_t*)(ws + WS_CIN), 64 * kb, 64 * nb, 64 * nb, scr, lane); continue; }
        r -= I_CIN;
        { const int nblk = 16, kb = r / nblk, nb = r % nblk; p0_transpose_item(P.in[16], D, D, nullptr, (bf16_t*)(ws + WS_COUT), 64 * kb, 64 * nb, 64 * nb, scr, lane); }
    }
}
__device__ __forceinline__ void final_norm(const Ptrs& P, int gw, int NGW, int lane) {
    const float* ss = (const float*)(P.ws + WS_SS) + (size_t)6 * M * 16; const float* gain = P.in[17]; const bf16_t* H = (const bf16_t*)(P.ws + WS_H);
    f32x4 g[4];
#pragma unroll
    for (int j = 0; j < 4; ++j) g[j] = ((const f32x4*)gain)[lane + 64 * j];
    for (int m0 = gw * 4; m0 < M; m0 += NGW * 4) {
        u32x2 w[4][4]; float rs[4];
#pragma unroll
        for (int r = 0; r < 4; ++r) { rs[r] = pg8::row_rstd(ss, m0 + r);
#pragma unroll
            for (int j = 0; j < 4; ++j) w[r][j] = ((const u32x2*)(H + (size_t)(m0 + r) * D))[lane + 64 * j]; }
#pragma unroll
        for (int r = 0; r < 4; ++r) { f32x4* orow = (f32x4*)(P.out + (size_t)(m0 + r) * D) + lane;
#pragma unroll
            for (int j = 0; j < 4; ++j) { const f32x4 v = (f32x4){pg8::bf_lo(w[r][j].x), pg8::bf_hi(w[r][j].x), pg8::bf_lo(w[r][j].y), pg8::bf_hi(w[r][j].y)}; __builtin_nontemporal_store(v * rs[r] * g[j], orow + 64 * j); } }
    }
}
#define XB_TMO      128
#define XB_XCNT(j)  (256  + 64 * (j))
#define XB_XSUB(j)  (1280 + 64 * (j))
#define XB_XGEN(j)  (2304 + 64 * (j))
#define XB_TOP      3328
#define XB_TOPGEN   3392
#define XCD_BAR_WORDS 3456
#define XB_SPIN_CAP (1u << 18)

__device__ __forceinline__ unsigned xb_ld(unsigned* p)              { return __hip_atomic_load(p, __ATOMIC_RELAXED, __HIP_MEMORY_SCOPE_AGENT); }
__device__ __forceinline__ unsigned xb_add(unsigned* p, unsigned v) { return __hip_atomic_fetch_add(p, v, __ATOMIC_RELAXED, __HIP_MEMORY_SCOPE_AGENT); }
__device__ __forceinline__ unsigned xb_xcc_id() { return (unsigned)__builtin_amdgcn_s_getreg((3 << 11) | 20) & 0xFu; }
#define XB_SPIN(cond, bar) do { unsigned _sp = 0; while (cond) { __builtin_amdgcn_s_sleep(1); \
    if ((++_sp & 255u) == 0u) { if (xb_ld(&(bar)[XB_TMO])) break; if (_sp > XB_SPIN_CAP) { atomicAdd(&(bar)[XB_TMO], 1u); break; } } } } while (0)

struct XcdBarrier {
    unsigned* bar; unsigned x;
    volatile LAS unsigned* st;
};

__device__ __forceinline__ XcdBarrier xcd_barrier_post(unsigned* bar, volatile LAS unsigned* st) {
    XcdBarrier b; b.bar = bar; b.x = xb_xcc_id(); b.st = st;
    if (threadIdx.x == 0) (void)xb_add(&bar[XB_XCNT(b.x)], 1u);
    return b;
}
__device__ __forceinline__ void xcd_barrier_complete(unsigned* bar, unsigned x, unsigned& nloc, unsigned& nx) {
    const unsigned G = gridDim.x * gridDim.y * gridDim.z;
    unsigned sum, cnt, mine, sp = 0u;
    for (;;) {
        sum = 0u; cnt = 0u; mine = 0u;
#pragma unroll
        for (unsigned j = 0; j < 16; ++j) { const unsigned c = xb_ld(&bar[XB_XCNT(j)]); sum += c; cnt += (c > 0u) ? 1u : 0u; mine = (j == x) ? c : mine; }
        if (sum == G) break;
        __builtin_amdgcn_s_sleep(1);
        if ((++sp & 255u) == 0u) { if (xb_ld(&bar[XB_TMO])) break; if (sp > XB_SPIN_CAP) { atomicAdd(&bar[XB_TMO], 1u); break; } }
    }
    nloc = mine > 0u ? mine : 1u; nx = cnt > 0u ? cnt : 1u;
}

__device__ __forceinline__ void xcd_barrier(const XcdBarrier& b) {
    asm volatile("s_waitcnt vmcnt(0)" ::: "memory");
    __syncthreads();
    if (threadIdx.x == 0) {
        unsigned* bar = b.bar;
        __builtin_amdgcn_s_waitcnt(0);
        unsigned nloc = b.st[0], nx = b.st[1];
        if (nloc == 0u) { xcd_barrier_complete(bar, b.x, nloc, nx); b.st[0] = nloc; b.st[1] = nx; }
        const unsigned old = xb_add(&bar[XB_XSUB(b.x)], 1u);
        const unsigned gen = old / nloc;
        if (old + 1u == (gen + 1u) * nloc) {
            __builtin_amdgcn_fence(__ATOMIC_RELEASE, "agent");
            asm volatile("s_waitcnt vmcnt(0)" ::: "memory");
            const unsigned og = xb_add(&bar[XB_TOP], 1u);
            const unsigned tg = og / nx;
            if (og + 1u == (tg + 1u) * nx) xb_add(&bar[XB_TOPGEN], 1u);
            else XB_SPIN(xb_ld(&bar[XB_TOPGEN]) == tg, bar);
            __builtin_amdgcn_fence(__ATOMIC_ACQUIRE, "agent");
            xb_add(&bar[XB_XGEN(b.x)], 1u);
            asm volatile("s_waitcnt vmcnt(0)" ::: "memory");
        } else {
            XB_SPIN(xb_ld(&bar[XB_XGEN(b.x)]) == gen, bar);
            __builtin_amdgcn_fence(__ATOMIC_ACQUIRE, "agent");
            asm volatile("s_waitcnt vmcnt(0)" ::: "memory");
        }
    }
    __syncthreads();
}
__device__ __forceinline__ void unpack8(const u32x4 w, float (&v)[8]) {
    v[0] = pg8::bf_lo(w.x); v[1] = pg8::bf_hi(w.x); v[2] = pg8::bf_lo(w.y); v[3] = pg8::bf_hi(w.y); v[4] = pg8::bf_lo(w.z); v[5] = pg8::bf_hi(w.z); v[6] = pg8::bf_lo(w.w); v[7] = pg8::bf_hi(w.w);
}
__device__ __forceinline__ void conv_item(const bf16_t* PROJ, const float* cw, bf16_t* Y, int item, int lane) {
    const int r0 = item * 16, c0 = lane * 8;
    float w0[8], w1[8], w2[8];
#pragma unroll
    for (int j = 0; j < 8; ++j) { w0[j] = cw[c0 + j]; w1[j] = cw[512 + c0 + j]; w2[j] = cw[1024 + c0 + j]; }
    float um1[8], um2[8];
#pragma unroll
    for (int j = 0; j < 8; ++j) { um1[j] = 0.f; um2[j] = 0.f; }
    if ((r0 & (SEQ - 1)) != 0) {
        float a[8], b[8];
        const bf16_t* p2 = PROJ + (size_t)(r0 - 2) * 3072 + c0; unpack8(*(const u32x4*)(p2 + 512), a); unpack8(*(const u32x4*)(p2 + 1024), b);
#pragma unroll
        for (int j = 0; j < 8; ++j) um2[j] = a[j] * b[j];
        const bf16_t* p1 = PROJ + (size_t)(r0 - 1) * 3072 + c0; unpack8(*(const u32x4*)(p1 + 512), a); unpack8(*(const u32x4*)(p1 + 1024), b);
#pragma unroll
        for (int j = 0; j < 8; ++j) um1[j] = a[j] * b[j];
    }
#pragma unroll 4
    for (int r = 0; r < 16; ++r) {
        const bf16_t* p = PROJ + (size_t)(r0 + r) * 3072 + c0;
        float g[8], a[8], b[8], o[8];
        unpack8(*(const u32x4*)p, g); unpack8(*(const u32x4*)(p + 512), a); unpack8(*(const u32x4*)(p + 1024), b);
#pragma unroll
        for (int j = 0; j < 8; ++j) { const float u = a[j] * b[j]; o[j] = g[j] * (w0[j] * um2[j] + w1[j] * um1[j] + w2[j] * u); um2[j] = um1[j]; um1[j] = u; }
        u32x4 w; w.x = pk2(o[0], o[1]); w.y = pk2(o[2], o[3]); w.z = pk2(o[4], o[5]); w.w = pk2(o[6], o[7]);
        *(u32x4*)(Y + (size_t)(r0 + r) * 1024 + c0) = w;
    }
}
__device__ __forceinline__ s16x4 vtr(const LAS unsigned char* p) { typedef short v4i16_t __attribute__((ext_vector_type(4))); return __builtin_bit_cast(s16x4, __builtin_amdgcn_ds_read_tr16_b64_v4i16((LAS v4i16_t*)p)); }
__device__ __forceinline__ bf16x8 cat8(s16x4 a, s16x4 b) { bf16x8 r; r[0] = a[0]; r[1] = a[1]; r[2] = a[2]; r[3] = a[3]; r[4] = b[0]; r[5] = b[1]; r[6] = b[2]; r[7] = b[3]; return r; }
constexpr int AV_STRIDE = 144;
__device__ __forceinline__ void attn_unit(const bf16_t* PROJ, bf16_t* Y, int b, int h, int qb, LAS unsigned char* vlds, int lane) {
    const int r32 = lane & 31, hi = lane >> 5;
    const size_t rowbase = (size_t)b * SEQ;
    const int t0 = qb * 32;
    bf16x8 qf[4];
    { const bf16_t* qp = PROJ + (rowbase + t0 + r32) * 3072 + 1536 + h * 64 + 8 * hi;
#pragma unroll
      for (int kk = 0; kk < 4; ++kk) qf[kk] = *(const bf16x8*)(qp + 16 * kk); }
    f32x16 o0, o1;
#pragma unroll
    for (int i = 0; i < 16; ++i) { o0[i] = 0.f; o1[i] = 0.f; }
    float carry = 0.f;
    const int g4 = lane >> 4, li = lane & 15;
    const LAS unsigned char* trbase = vlds + (4 * (g4 >> 1) + (li >> 2)) * AV_STRIDE + (16 * (g4 & 1) + 4 * (li & 3)) * 2;
    bf16x8 kf[4]; u32x4 vr[4];
#define AT_LOAD(KF, VR, K0) do { const bf16_t* kp_ = PROJ + (rowbase + (K0) + r32) * 3072 + 2048 + h * 64 + 8 * hi; \
        _Pragma("unroll") for (int kk = 0; kk < 4; ++kk) KF[kk] = *(const bf16x8*)(kp_ + 16 * kk); \
        _Pragma("unroll") for (int j = 0; j < 4; ++j) VR[j] = *(const u32x4*)(PROJ + (rowbase + (K0) + (lane >> 3) + 8 * j) * 3072 + 2560 + h * 64 + 8 * (lane & 7)); } while (0)
    AT_LOAD(kf, vr, t0);
    f32x16 sc;
#pragma unroll
    for (int i = 0; i < 16; ++i) sc[i] = 0.f;
#pragma unroll
    for (int kk = 0; kk < 4; ++kk) sc = __builtin_amdgcn_mfma_f32_32x32x16_bf16(kf[kk], qf[kk], sc, 0, 0, 0);
    for (int kt = qb; kt >= 0; --kt) {
#pragma unroll
        for (int j = 0; j < 4; ++j) *(LAS u32x4*)(vlds + ((lane >> 3) + 8 * j) * AV_STRIDE + 16 * (lane & 7)) = vr[j];
        bf16x8 kfn[4]; u32x4 vrn[4];
#pragma unroll
        for (int j = 0; j < 4; ++j) { kfn[j] = kf[j]; vrn[j] = vr[j]; }
        if (kt > 0) AT_LOAD(kfn, vrn, (kt - 1) * 32);
        const bool diag = (kt == qb);
        float lk[16], lb[16];
#pragma unroll
        for (int r = 0; r < 16; ++r) {
            const float z = sc[r], az = __builtin_fabsf(z);
            const float L = __builtin_amdgcn_logf(1.0f + __builtin_amdgcn_exp2f(-az));
            float lbv = __builtin_fminf(z, 0.f) - L, lkv = lbv - z;
            if (diag) { const int key = (r & 3) + 8 * (r >> 2) + 4 * hi; if (!(key < r32)) { lkv = 0.f; lbv = -1.0e30f; } }
            lk[r] = lkv; lb[r] = lbv;
        }
        float gs[4], pg[4], T[4];
#pragma unroll
        for (int j = 0; j < 4; ++j) { gs[j] = (lk[4 * j] + lk[4 * j + 1]) + (lk[4 * j + 2] + lk[4 * j + 3]); pg[j] = __shfl_xor(gs[j], 32); T[j] = gs[j] + pg[j]; }
        float w[16];
        float suf = carry;
#pragma unroll
        for (int j = 3; j >= 0; --j) {
            float run = suf + (hi == 0 ? pg[j] : 0.f);
#pragma unroll
            for (int i = 3; i >= 0; --i) { w[4 * j + i] = __builtin_amdgcn_exp2f(lb[4 * j + i] + run); run += lk[4 * j + i]; }
            suf += T[j];
        }
        carry = suf;
        u32x4 p0, p1;
        p0.x = pk2(w[0], w[1]); p0.y = pk2(w[2], w[3]); p0.z = pk2(w[4], w[5]); p0.w = pk2(w[6], w[7]);
        p1.x = pk2(w[8], w[9]); p1.y = pk2(w[10], w[11]); p1.z = pk2(w[12], w[13]); p1.w = pk2(w[14], w[15]);
        const bf16x8 pf0 = __builtin_bit_cast(bf16x8, p0), pf1 = __builtin_bit_cast(bf16x8, p1);
        f32x16 scn;
#pragma unroll
        for (int i = 0; i < 16; ++i) scn[i] = 0.f;
#pragma unroll
        for (int kk = 0; kk < 4; ++kk) scn = __builtin_amdgcn_mfma_f32_32x32x16_bf16(kfn[kk], qf[kk], scn, 0, 0, 0);
        asm volatile("s_waitcnt lgkmcnt(0)" ::: "memory");
        const bf16x8 v00 = cat8(vtr(trbase), vtr(trbase + 8 * AV_STRIDE));
        const bf16x8 v01 = cat8(vtr(trbase + 16 * AV_STRIDE), vtr(trbase + 24 * AV_STRIDE));
        const bf16x8 v10 = cat8(vtr(trbase + 64), vtr(trbase + 8 * AV_STRIDE + 64));
        const bf16x8 v11 = cat8(vtr(trbase + 16 * AV_STRIDE + 64), vtr(trbase + 24 * AV_STRIDE + 64));
        o0 = __builtin_amdgcn_mfma_f32_32x32x16_bf16(v00, pf0, o0, 0, 0, 0);
        o0 = __builtin_amdgcn_mfma_f32_32x32x16_bf16(v01, pf1, o0, 0, 0, 0);
        o1 = __builtin_amdgcn_mfma_f32_32x32x16_bf16(v10, pf0, o1, 0, 0, 0);
        o1 = __builtin_amdgcn_mfma_f32_32x32x16_bf16(v11, pf1, o1, 0, 0, 0);
        if (__builtin_amdgcn_ballot_w64(carry > -127.0f) == 0ull) break;
#pragma unroll
        for (int j = 0; j < 4; ++j) { kf[j] = kfn[j]; vr[j] = vrn[j]; }
        sc = scn;
    }
#undef AT_LOAD
    bf16_t* yp = Y + (rowbase + t0 + r32) * 1024 + 512 + h * 64 + 4 * hi;
#pragma unroll
    for (int j = 0; j < 4; ++j) {
        u32x2 a; a.x = pk2(o0[4 * j], o0[4 * j + 1]); a.y = pk2(o0[4 * j + 2], o0[4 * j + 3]); *(u32x2*)(yp + 8 * j) = a;
        u32x2 c; c.x = pk2(o1[4 * j], o1[4 * j + 1]); c.y = pk2(o1[4 * j + 2], o1[4 * j + 3]); *(u32x2*)(yp + 32 + 8 * j) = c;
    }
}
__device__ __forceinline__ void mix0_phase(const Ptrs& P, LAS unsigned char* lds, int gw, int NGW, int wave, int lane) {
    const bf16_t* PROJ = (const bf16_t*)(P.ws + WS_PROJ); bf16_t* Y = (bf16_t*)(P.ws + WS_Y);
    LAS unsigned char* vlds = lds + wave * 8192;
#ifndef DBG_NO_ATTN
    for (int it = gw; it < BATCH * 8 * (SEQ / 32); it += NGW) { const int bh = it / (SEQ / 32), qb = it % (SEQ / 32); attn_unit(PROJ, Y, bh >> 3, bh & 7, qb, vlds, lane); }
#else
    for (int m = gw; m < M; m += NGW) { *(u32x4*)(Y + (size_t)m * 1024 + 512 + 8 * lane) = (u32x4){0u, 0u, 0u, 0u}; }
#endif
    for (int it = gw; it < M / 16; it += NGW) conv_item(PROJ, P.in[11], Y, it, lane);
}
constexpr int HS = 272;
constexpr int HL_QT = 0, HL_KT = 64 * HS, HL_KH = 2 * 64 * HS, HL_V = 3 * 64 * HS, HL_V2 = 4 * 64 * HS, HL_OUT = 4 * 64 * HS;
constexpr int HSC = 144;
constexpr int HL_SC = 5 * 64 * HS, HL_SEG = HL_SC + 64 * HSC, HL_DEC = HL_SEG + 8 * 128 * 4, HL_OSQ = HL_DEC + 512, HL_END = HL_OSQ + 64 * 8 * 4;
static_assert(HL_END <= 131072, "hgrn LDS map");
constexpr size_t WS_DTOT = 256 * 1024;
constexpr int HG_NCH = 16;
#define HG_BAR() do { asm volatile("s_waitcnt lgkmcnt(0)" ::: "memory"); __builtin_amdgcn_s_barrier(); asm volatile("" ::: "memory"); } while (0)
#define MFMA16(a, b, c) __builtin_amdgcn_mfma_f32_16x16x32_bf16((a), (b), (c), 0, 0, 0)
typedef float f32x2v __attribute__((ext_vector_type(2)));
template <bool FULL>
__device__ __forceinline__ void hgrn_unit(const Ptrs& P, LAS unsigned char* lds, int bh, int sc, int tid, int wave, int lane) {
    const bf16_t* Qs = (const bf16_t*)(P.ws + WS_QS); const float* LF = (const float*)(P.ws + WS_LF); const bf16_t* Iv = (const bf16_t*)(P.ws + WS_IV); const bf16_t* Gs = (const bf16_t*)(P.ws + WS_GS);
    bf16_t* Ob = (bf16_t*)P.out;
    float* SLOC = (float*)((unsigned char*)P.out + 64 * MiB);
    float* DTOT = (float*)(P.ws + WS_DTOT);
    const int b = bh >> 3, h = bh & 7, hc = h * 128;
    const int fr = lane & 15, fq = lane >> 4;
    const int kp = lane, seg = wave;
    f32x4 S[8];
    if (FULL && sc > 0) {
        const float* sp = SLOC + ((size_t)(bh * 4) << 14) + (16 * wave + fr) * 4;
        const float* dp = DTOT + (bh * 4) * 128 + 4 * fq;
#pragma unroll
        for (int kt = 0; kt < 8; ++kt) S[kt] = *(const f32x4*)(sp + (4 * kt + fq) * 512);
        for (int j = 1; j < sc; ++j) {
#pragma unroll
            for (int kt = 0; kt < 8; ++kt) S[kt] = S[kt] * *(const f32x4*)(dp + j * 128 + 16 * kt) + *(const f32x4*)(sp + ((size_t)j << 14) + (4 * kt + fq) * 512);
        }
    } else {
#pragma unroll
        for (int kt = 0; kt < 8; ++kt) S[kt] = (f32x4){0.f, 0.f, 0.f, 0.f};
    }
    LAS float* segtot = (LAS float*)(lds + HL_SEG); LAS float* dec = (LAS float*)(lds + HL_DEC); LAS float* osq = (LAS float*)(lds + HL_OSQ);
    f32x4 on0, on1;
    if (FULL) { const float* onp = P.in[15] + 8 * (tid & 15); on0 = *(const f32x4*)onp; on1 = *(const f32x4*)(onp + 4); }
    float dprod0 = 1.f, dprod1 = 1.f;
    f32x2v lf2[8]; unsigned q2[8]; u32x4 vch[2], gch[2];
    const size_t Rbase = (size_t)b * SEQ + (size_t)sc * (64 * HG_NCH);
#define HG_LOAD_E(R0_) do { _Pragma("unroll") for (int i = 0; i < 8; ++i) { const size_t off = ((R0_) + 8 * seg + i) * 1024 + hc + 2 * kp; lf2[i] = *(const f32x2v*)(LF + off); if (FULL) q2[i] = *(const unsigned*)(Qs + off); } \
        _Pragma("unroll") for (int j = 0; j < 2; ++j) { const int ch = tid + 512 * j; vch[j] = *(const u32x4*)(Iv + ((R0_) + (ch >> 4)) * 1024 + hc + 8 * (ch & 15)); } } while (0)
#define HG_LOAD_G(R0_) do { _Pragma("unroll") for (int j = 0; j < 2; ++j) { const int ch = tid + 512 * j; gch[j] = *(const u32x4*)(Gs + ((R0_) + (ch >> 4)) * 1024 + hc + 8 * (ch & 15)); } } while (0)
    HG_LOAD_E(Rbase);
    if (FULL) HG_LOAD_G(Rbase);
#pragma unroll 1
    for (int c = 0; c < HG_NCH; ++c) {
        const size_t R0 = Rbase + (size_t)c * 64;
        const int vimg = FULL ? HL_V : ((c & 1) ? HL_V2 : HL_V);
        f32x2v cs[8]; { f32x2v run = (f32x2v){0.f, 0.f};
#pragma unroll
          for (int i = 0; i < 8; ++i) { run += lf2[i]; cs[i] = run; } }
        *(LAS f32x2v*)(segtot + seg * 128 + 2 * kp) = cs[7];
#pragma unroll
        for (int j = 0; j < 2; ++j) { const int ch = tid + 512 * j; *(LAS u32x4*)(lds + vimg + (ch >> 4) * HS + 16 * (ch & 15)) = vch[j]; }
        HG_BAR();
        f32x2v pre = (f32x2v){0.f, 0.f}, tot = (f32x2v){0.f, 0.f};
#pragma unroll
        for (int s2 = 0; s2 < 8; ++s2) { const f32x2v v = *(const LAS f32x2v*)(segtot + s2 * 128 + 2 * kp); tot += v; if (s2 < seg) pre += v; }
        const float dl0 = __builtin_amdgcn_exp2f(tot[0]), dl1 = __builtin_amdgcn_exp2f(tot[1]);
        if (seg == 0) { *(LAS f32x2v*)(dec + 2 * kp) = (f32x2v){dl0, dl1}; dprod0 *= dl0; dprod1 *= dl1; }
#pragma unroll
        for (int i = 0; i < 8; ++i) {
            const float b0 = pre[0] + cs[i][0], b1 = pre[1] + cs[i][1];
            const float k0 = (1.0f - __builtin_amdgcn_exp2f(lf2[i][0])) * __builtin_amdgcn_exp2f(-b0), k1 = (1.0f - __builtin_amdgcn_exp2f(lf2[i][1])) * __builtin_amdgcn_exp2f(-b1);
            const int o = (8 * seg + i) * HS + 4 * kp;
            *(LAS unsigned*)(lds + HL_KH + o) = pk2(k0 * dl0, k1 * dl1);
            if (FULL) {
                *(LAS unsigned*)(lds + HL_KT + o) = pk2(k0, k1);
                *(LAS unsigned*)(lds + HL_QT + o) = pk2(pg8::bf_lo(q2[i]) * __builtin_amdgcn_exp2f(b0), pg8::bf_hi(q2[i]) * __builtin_amdgcn_exp2f(b1));
            }
        }
        if (c < HG_NCH - 1) HG_LOAD_E(R0 + 64);
        HG_BAR();
        f32x4 o[4];
        bf16x8 vf[2];
        if (FULL) {
            { const int tt = wave >> 1;
#pragma unroll
              for (int e = 0; e < 2; ++e) { const int st = 2 * (wave & 1) + e; const int t = 16 * tt + fr, s0 = 16 * st + 4 * fq;
                  u32x2 w = (u32x2){0u, 0u};
                  if (st <= tt) {
                      f32x4 a4 = (f32x4){0.f, 0.f, 0.f, 0.f};
#pragma unroll
                      for (int ks = 0; ks < 4; ++ks) {
                          const bf16x8 af = *(const LAS bf16x8*)(lds + HL_KT + (16 * st + fr) * HS + (32 * ks + 8 * fq) * 2);
                          const bf16x8 bfr = *(const LAS bf16x8*)(lds + HL_QT + (16 * tt + fr) * HS + (32 * ks + 8 * fq) * 2);
                          a4 = MFMA16(af, bfr, a4);
                      }
                      const float v0 = s0 + 0 <= t ? a4[0] : 0.f, v1 = s0 + 1 <= t ? a4[1] : 0.f, v2 = s0 + 2 <= t ? a4[2] : 0.f, v3 = s0 + 3 <= t ? a4[3] : 0.f;
                      w.x = pk2(v0, v1); w.y = pk2(v2, v3);
                  }
                  *(LAS u32x2*)(lds + HL_SC + t * HSC + s0 * 2) = w;
              } }
#pragma unroll
            for (int tt = 0; tt < 4; ++tt) o[tt] = (f32x4){0.f, 0.f, 0.f, 0.f};
#pragma unroll
            for (int ks = 0; ks < 4; ++ks) {
                u32x4 sb; sb.x = pk2(S[2 * ks][0], S[2 * ks][1]); sb.y = pk2(S[2 * ks][2], S[2 * ks][3]); sb.z = pk2(S[2 * ks + 1][0], S[2 * ks + 1][1]); sb.w = pk2(S[2 * ks + 1][2], S[2 * ks + 1][3]);
                const bf16x8 sfr = __builtin_bit_cast(bf16x8, sb);
#pragma unroll
                for (int tt = 0; tt < 4; ++tt) {
                    const LAS unsigned char* ap = lds + HL_QT + (16 * tt + fr) * HS + (32 * ks + 4 * fq) * 2;
                    const s16x4 a0 = *(const LAS s16x4*)ap, a1 = *(const LAS s16x4*)(ap + 32);
                    o[tt] = MFMA16(cat8(a0, a1), sfr, o[tt]);
                }
            }
        }
        { const LAS unsigned char* tb = lds + vimg + (8 * fq + (fr >> 2)) * HS + (16 * wave + 4 * (fr & 3)) * 2;
#pragma unroll
          for (int ss = 0; ss < 2; ++ss) vf[ss] = cat8(vtr(tb + (32 * ss) * HS), vtr(tb + (32 * ss + 4) * HS)); }
        f32x4 Sn[8];
#pragma unroll
        for (int kt = 0; kt < 8; ++kt) {
            const f32x4 d4 = *(const LAS f32x4*)(dec + 16 * kt + 4 * fq);
            f32x4 a4 = S[kt] * d4;
            const LAS unsigned char* tb = lds + HL_KH + (8 * fq + (fr >> 2)) * HS + (16 * kt + 4 * (fr & 3)) * 2;
#pragma unroll
            for (int ss = 0; ss < 2; ++ss) a4 = MFMA16(cat8(vtr(tb + (32 * ss) * HS), vtr(tb + (32 * ss + 4) * HS)), vf[ss], a4);
            Sn[kt] = a4;
        }
#pragma unroll
        for (int kt = 0; kt < 8; ++kt) S[kt] = Sn[kt];
        if (FULL) {
            HG_BAR();
#pragma unroll
            for (int ss = 0; ss < 2; ++ss)
#pragma unroll
                for (int tt = 0; tt < 4; ++tt) {
                    if (ss == 1 && tt < 2) continue;
                    const bf16x8 af = *(const LAS bf16x8*)(lds + HL_SC + (16 * tt + fr) * HSC + (32 * ss + 8 * fq) * 2);
                    o[tt] = MFMA16(af, vf[ss], o[tt]);
                }
#pragma unroll
            for (int tt = 0; tt < 4; ++tt)
#pragma unroll
                for (int r = 0; r < 4; ++r) { const int t = 16 * tt + 4 * fq + r; const float ov = o[tt][r]; float q = ov * ov;
                    *(LAS unsigned short*)(lds + HL_OUT + t * HS + (16 * wave + fr) * 2) = (unsigned short)f2bf(ov);
                    q += __shfl_xor(q, 1); q += __shfl_xor(q, 2); q += __shfl_xor(q, 4); q += __shfl_xor(q, 8);
                    if (fr == 0) osq[t * 8 + wave] = q; }
            HG_BAR();
#pragma unroll
            for (int j = 0; j < 2; ++j) { const int ch = tid + 512 * j, row = ch >> 4, c16 = ch & 15;
                const f32x4 qa = *(const LAS f32x4*)(osq + row * 8), qb = *(const LAS f32x4*)(osq + row * 8 + 4);
                const float rs = 1.0f / sqrtf((((qa[0] + qa[1]) + (qa[2] + qa[3])) + ((qb[0] + qb[1]) + (qb[2] + qb[3]))) * (1.0f / 128.0f) + 1e-6f);
                const u32x4 ow = *(const LAS u32x4*)(lds + HL_OUT + row * HS + 16 * c16);
                float ov[8], gv[8]; unpack8(ow, ov); unpack8(gch[j], gv);
                u32x4 w; w.x = pk2(ov[0] * rs * on0[0] * gv[0], ov[1] * rs * on0[1] * gv[1]); w.y = pk2(ov[2] * rs * on0[2] * gv[2], ov[3] * rs * on0[3] * gv[3]);
                w.z = pk2(ov[4] * rs * on1[0] * gv[4], ov[5] * rs * on1[1] * gv[5]); w.w = pk2(ov[6] * rs * on1[2] * gv[6], ov[7] * rs * on1[3] * gv[7]);
                *(u32x4*)(Ob + (R0 + row) * 1024 + hc + 8 * c16) = w; }
            if (c < HG_NCH - 1) HG_LOAD_G(R0 + 64);
        }
    }
    if (!FULL) {
        float* sp = SLOC + ((size_t)(bh * 4 + sc) << 14) + (16 * wave + fr) * 4;
#pragma unroll
        for (int kt = 0; kt < 8; ++kt) *(f32x4*)(sp + (4 * kt + fq) * 512) = S[kt];
        if (seg == 0) *(f32x2v*)(DTOT + (bh * 4 + sc) * 128 + 2 * kp) = (f32x2v){dprod0, dprod1};
    }
    HG_BAR();
#undef HG_LOAD_E
#undef HG_LOAD_G
}
__device__ __forceinline__ void hgrn_scan(const Ptrs& P, int gw, int NGW, int lane) {
    float* SLOC = (float*)((unsigned char*)P.out + 64 * MiB); const float* DTOT = (const float*)(P.ws + WS_DTOT);
    for (int it = gw; it < 64 * 64; it += NGW) {
        const int bh = it >> 6, e0 = (it & 63) * 256 + lane * 4, k0 = (e0 >> 9) * 4;
        f32x4 v[3], d[3];
#pragma unroll
        for (int s = 0; s < 3; ++s) { v[s] = *(const f32x4*)(SLOC + ((size_t)(bh * 4 + s) << 14) + e0); d[s] = *(const f32x4*)(DTOT + (bh * 4 + s) * 128 + k0); }
        f32x4 run = v[0];
#pragma unroll
        for (int s = 1; s < 3; ++s) { run = run * d[s] + v[s]; *(f32x4*)(SLOC + ((size_t)(bh * 4 + s) << 14) + e0) = run; }
    }
}
#ifndef MK_ONE_LAUNCH
#define MK_ONE_LAUNCH 1
#endif
#ifndef MK_XCD_BAR
#define MK_XCD_BAR 1
#endif
constexpr int N_PHASES = 18;
constexpr int FIN_LDS_OFF = 131072 + 4096;
constexpr int RS_TAB_OFF = 131072 + 1024;
struct Args { Ptrs p; int ph_lo, ph_hi; };
__global__ void __launch_bounds__(NTHREADS, 2) fwd_kernel(Args args) {
    extern __shared__ __attribute__((aligned(16))) unsigned char lds_raw[];
    LAS unsigned char* lds = (LAS unsigned char*)lds_raw;
    const Ptrs& P = args.p;
    const int tid = threadIdx.x, lane = tid & 63, wave = __builtin_amdgcn_readfirstlane(tid >> 6);
    const int G = gridDim.x, bx = blockIdx.x;
    const int vcu = (G % 8 == 0) ? (bx % 8) * (G / 8) + bx / 8 : bx;
    const int gw = vcu * NWAVES + wave, NGW = G * NWAVES;
    unsigned char* ws = P.ws;
    bf16_t* H = (bf16_t*)(ws + WS_H); bf16_t* HID = (bf16_t*)(ws + WS_HID); float* SS = (float*)(ws + WS_SS);
    const int lo = args.ph_lo, hi = args.ph_hi;
#if MK_XCD_BAR
    volatile LAS unsigned* MISC = (volatile LAS unsigned*)(lds + LDS_BYTES - 256);
    if (tid < 32) MISC[tid] = 0u;
#if MK_ONE_LAUNCH
    if (bx == 0) { unsigned* cw = (unsigned*)ws + 4096; for (int i = tid; i < 12288; i += NTHREADS) __hip_atomic_store(cw + i, 0u, __ATOMIC_RELAXED, __HIP_MEMORY_SCOPE_AGENT); }
    __syncthreads();
    XcdBarrier bar; bar.bar = (unsigned*)ws + 4096; bar.x = xb_xcc_id(); bar.st = MISC + 8;
#else
    __syncthreads();
    XcdBarrier bar = xcd_barrier_post((unsigned*)ws + 4096, MISC + 8);
#endif
#endif
#define IN(k) (lo <= (k) && (k) < hi)
#if MK_XCD_BAR
#define SEAM(k) do { if (IN(k) && IN((k) + 1)) { if ((k) == 0) { cg::this_grid().sync(); if (tid == 0) (void)xb_add(&bar.bar[XB_XCNT(bar.x)], 1u); } else xcd_barrier(bar); } } while (0)
#else
#define SEAM(k) do { if (IN(k) && IN((k) + 1)) { cg::this_grid().sync(); } } while (0)
#endif
#define SSB(i) (SS + (size_t)(i) * M * 16)
#define GEMM_GU(f, ssi) do { pg8::Gemm g{H, (const bf16_t*)(ws + WS_GU) + (size_t)(f) * 5632 * 1024, M, 5632, D}; pg8::StaticOrder S; S.init(M, 5632, G, bx); \
        pg8::EpiSwiGLU E{HID, pg8::rs_table_build(lds + RS_TAB_OFF, SSB(ssi), S, tid), FF}; pg8::gemm_phase<pg8::EpiSwiGLU, pg8::StaticOrder, true, true>(lds, g, S, E); } while (0)
#define GEMM_DN(f, sso) do { pg8::Gemm g{HID, (const bf16_t*)(ws + WS_DN) + (size_t)(f) * 1024 * 2816, M, D, FF}; pg8::StaticOrder S; S.init(M, D, G, bx); \
        pg8::EpiResid<false> E{H, SSB(sso), 0.5f, nullptr}; pg8::gemm_phase<pg8::EpiResid<false>, pg8::StaticOrder, true, true>(lds, g, S, E); } while (0)

    if (IN(0)) { p0_prologue(P, lds, gw, NGW, wave, lane); }
#ifdef PROBE_P0
    __syncthreads(); if (IN(0)) { p0_prologue(P, lds, gw, NGW, wave, lane); }
#endif
    SEAM(0);
#ifdef PROBE_EARLYBAR
    xcd_barrier(bar);
#endif
    if (IN(1)) { GEMM_GU(0, 0); }
#ifdef PROBE_LATE_WG
    if (bx == PROBE_LATE_WG) { for (int d_ = 0; d_ < 400; ++d_) __builtin_amdgcn_s_sleep(127); }
#endif
#ifdef PROBE_BAR10
#if PROBE_BAR10 == 2
    asm volatile("s_waitcnt vmcnt(0)" ::: "memory"); __syncthreads();
    if (tid == 0) { __builtin_amdgcn_fence(__ATOMIC_RELEASE, "agent"); asm volatile("s_waitcnt vmcnt(0)" ::: "memory"); __builtin_amdgcn_fence(__ATOMIC_ACQUIRE, "agent"); asm volatile("s_waitcnt vmcnt(0)" ::: "memory"); }
    __syncthreads();
#elif PROBE_BAR10 == 4
    cg::this_grid().sync();
#elif PROBE_BAR10 == 3
    asm volatile("s_waitcnt vmcnt(0)" ::: "memory"); __syncthreads(); __syncthreads();
#else
    for (int i_ = 0; i_ < PROBE_BAR10; ++i_) { xcd_barrier(bar); }
#endif
#endif
#ifdef PROBE_GU2X
    xcd_barrier(bar); if (IN(1)) { GEMM_GU(0, 0); }
#endif
    SEAM(1);
#ifdef PROBE_DN2X
    if (IN(2)) { pg8::Gemm g{HID, (const bf16_t*)(ws + WS_DN), M, D, FF}; pg8::StaticOrder S; S.init(M, D, G, bx);
        pg8::EpiResid<false> E{H, SSB(1), 0.0f, nullptr}; pg8::gemm_phase<pg8::EpiResid<false>, pg8::StaticOrder, true, true>(lds, g, S, E); }
    xcd_barrier(bar);
#endif
    if (IN(2)) { GEMM_DN(0, 1); }
    SEAM(2);
    if (IN(3)) { pg8::Gemm g{H, (const bf16_t*)(ws + WS_ABIN), M, 3072, D}; pg8::StaticOrder S; S.init(M, 3072, G, bx);
        pg8::EpiProjAB E{(bf16_t*)(ws + WS_PROJ), pg8::rs_table_build(lds + RS_TAB_OFF, SSB(1), S, tid), QSCALE}; pg8::gemm_phase<pg8::EpiProjAB, pg8::StaticOrder, true, true>(lds, g, S, E); }
    SEAM(3);
    if (IN(4)) { mix0_phase(P, lds, gw, NGW, wave, lane); }
#ifdef PROBE_P4
    if (IN(4)) { mix0_phase(P, lds, gw, NGW, wave, lane); }
#endif
    SEAM(4);
    if (IN(5)) { pg8::Gemm g{(const bf16_t*)(ws + WS_Y), (const bf16_t*)(ws + WS_ABOUT), M, D, D}; pg8::StaticOrder S; S.init(M, D, G, bx);
        pg8::EpiResid<false> E{H, SSB(2), 1.0f, nullptr}; pg8::gemm_phase<pg8::EpiResid<false>, pg8::StaticOrder, true, true>(lds, g, S, E); }
    SEAM(5);
#ifdef PROBE_BAR_AT5
    xcd_barrier(bar);
#endif
#ifdef PROBE_IDLE
    { const unsigned long long t0_ = __builtin_amdgcn_s_memrealtime(); while (__builtin_amdgcn_s_memrealtime() - t0_ < 100000ull) __builtin_amdgcn_s_sleep(64); }
#endif
    if (IN(6)) { GEMM_GU(1, 2); }
    SEAM(6);
#ifdef PROBE_BAR_AT6
    xcd_barrier(bar);
#endif
    if (IN(7)) { GEMM_DN(1, 3); }
    SEAM(7);
    if (IN(8)) { GEMM_GU(2, 3); }
    SEAM(8);
    if (IN(9)) { GEMM_DN(2, 4); }
    SEAM(9);
    if (IN(10)) { pg8::Gemm g{H, (const bf16_t*)(ws + WS_CIN), M, 4096, D}; pg8::StaticOrder S; S.init(M, 4096, G, bx);
        pg8::EpiProjC E{(bf16_t*)(ws + WS_QS), (float*)(ws + WS_LF), (bf16_t*)(ws + WS_IV), (bf16_t*)(ws + WS_GS), pg8::rs_table_build(lds + RS_TAB_OFF, SSB(4), S, tid), P.in[14]};
        pg8::gemm_phase<pg8::EpiProjC, pg8::StaticOrder, true, true>(lds, g, S, E); }
    SEAM(10);
    if (IN(11)) { const int bh = bx >> 2, sc = bx & 3; if (sc < 3 && bh < 64) hgrn_unit<false>(P, lds, bh, sc, tid, wave, lane); }
    SEAM(11);
    if (IN(13)) { const int bh = bx >> 2, sc = bx & 3; if (bh < 64) hgrn_unit<true>(P, lds, bh, sc, tid, wave, lane); }
    SEAM(13);
    if (IN(14)) { pg8::Gemm g{(const bf16_t*)P.out, (const bf16_t*)(ws + WS_COUT), M, D, D}; pg8::StaticOrder S; S.init(M, D, G, bx);
        pg8::EpiResid<false> E{H, SSB(5), 1.0f, nullptr}; pg8::gemm_phase<pg8::EpiResid<false>, pg8::StaticOrder, true, true>(lds, g, S, E); }
    SEAM(14);
    if (IN(15)) { GEMM_GU(3, 5); }
    SEAM(15);
    if (IN(16)) { pg8::Gemm g{HID, (const bf16_t*)(ws + WS_DN) + (size_t)3 * 1024 * 2816, M, D, FF}; pg8::StaticOrder S; S.init(M, D, G, bx);
        pg8::EpiFinalNorm E{H, P.out, P.in[17], 0.5f, SSB(6), (unsigned*)ws + 8192, lds + FIN_LDS_OFF};
        pg8::gemm_phase<pg8::EpiFinalNorm, pg8::StaticOrder, true, true>(lds, g, S, E); }
    if (IN(18)) {
        for (int m = gw; m < M; m += NGW) { const u32x2* hr = (const u32x2*)(H + (size_t)m * D) + lane; f32x4* orow = (f32x4*)(P.out + (size_t)m * D) + lane;
#pragma unroll
            for (int j = 0; j < 4; ++j) { const u32x2 w = hr[64 * j]; orow[64 * j] = (f32x4){pg8::bf_lo(w.x), pg8::bf_hi(w.x), pg8::bf_lo(w.y), pg8::bf_hi(w.y)}; } }
    }
}

extern "C" void kernel_launch(void* const* d_in, const int* in_sizes, int n_in, void* d_out, int out_size, void* d_ws, size_t ws_size, hipStream_t stream) {
    static int grid = 0;
    if (grid == 0) {
        if (n_in != 18 || in_sizes[0] != M * D || out_size != M * D || ws_size < WS_END) { fprintf(stderr, "kernel_launch: unexpected shapes (n_in %d, in0 %d, out %d, ws %zu)\n", n_in, n_in > 0 ? in_sizes[0] : -1, out_size, ws_size); grid = -1; return; }
        int dev = 0, cus = 0, per_cu = 0;
        hipGetDevice(&dev); hipDeviceGetAttribute(&cus, hipDeviceAttributeMultiprocessorCount, dev);
        if (hipFuncSetAttribute((const void*)fwd_kernel, hipFuncAttributeMaxDynamicSharedMemorySize, LDS_BYTES) != hipSuccess) { fprintf(stderr, "kernel_launch: hipFuncSetAttribute failed\n"); grid = -1; return; }
        if (hipOccupancyMaxActiveBlocksPerMultiprocessor(&per_cu, (const void*)fwd_kernel, NTHREADS, LDS_BYTES) != hipSuccess || per_cu < 1) { fprintf(stderr, "kernel_launch: occupancy query gives %d\n", per_cu); per_cu = 1; }
        (void)hipGetLastError();
        grid = cus;
    }
    if (grid < 0) return;
    Args a{};
    for (int i = 0; i < 18; ++i) a.p.in[i] = (const float*)d_in[i];
    a.p.out = (float*)d_out; a.p.ws = (unsigned char*)d_ws;
#if MK_ONE_LAUNCH
    a.ph_lo = 0; a.ph_hi = N_PHASES;
    void* kargs[] = {&a};
    hipError_t e = hipLaunchCooperativeKernel((const void*)fwd_kernel, dim3(grid), dim3(NTHREADS), kargs, LDS_BYTES, stream);
    if (e != hipSuccess) fprintf(stderr, "kernel_launch: cooperative launch failed: %s (grid %d)\n", hipGetErrorString(e), grid);
#else
#ifdef DBG_STOP
    for (int ph = 0; ph <= DBG_STOP; ++ph) { a.ph_lo = ph; a.ph_hi = ph + 1; hipLaunchKernelGGL(fwd_kernel, dim3(grid), dim3(NTHREADS), LDS_BYTES, stream, a); }
    a.ph_lo = 18; a.ph_hi = 19; hipLaunchKernelGGL(fwd_kernel, dim3(grid), dim3(NTHREADS), LDS_BYTES, stream, a);
#else
    for (int ph = 0; ph < N_PHASES; ++ph) { a.ph_lo = ph; a.ph_hi = ph + 1; hipLaunchKernelGGL(fwd_kernel, dim3(grid), dim3(NTHREADS), LDS_BYTES, stream, a); }
#endif
#endif
}
```

```cpp
#include <hip/hip_runtime.h>
#include <hip/hip_cooperative_groups.h>
#include <cstdio>
#include <cstdint>
namespace cg = cooperative_groups;
#define MK_ONE_LAUNCH 1
namespace pg8 {
#define PG8_LAS __attribute__((address_space(3)))
typedef unsigned short bf16_t;
typedef short bf16x8 __attribute__((ext_vector_type(8)));
typedef float f32x4 __attribute__((ext_vector_type(4)));
typedef unsigned u32x4 __attribute__((ext_vector_type(4)));
constexpr int BM = 256, BK = 64, HALF = 128, HTB = HALF * BK * 2  , STAGE_BYTES = 8 * HTB, NXCD = 8, WGM = 8;

__host__ __device__ __forceinline__ int lds_byte(int r, int c) { const int st = (r >> 4) * 2 + (c >> 5), rr = r & 15, cc = c & 31, ob = rr * 64 + cc * 2; return st * 1024 + (ob ^ (((ob >> 9) & 1) << 5)); }
__host__ __device__ __forceinline__ void stage_rc(int b, int& R, int& C) { const int st = b / 1024, sb = b % 1024, swz = sb ^ (((sb >> 9) & 1) << 5); R = (st >> 1) * 16 + swz / 64; C = (st & 1) * 32 + (swz % 64) / 2; }
__host__ __device__ __forceinline__ int perm32(int rho) { const int n = rho >> 4, i = rho & 15; return 8 * (i >> 2) + 4 * n + (i & 3); }

struct Unit { int pm, pn; };
struct Gemm { const bf16_t* A; const bf16_t* Bt; int M, N, K; };

struct StaticOrder {
    int nM, nN, nwg, G, c;
    __host__ __device__ void init(int M, int N, int G_, int c_) { nM = M / BM; nN = N / BM; nwg = nM * nN; G = G_; c = c_; }
    __host__ __device__ bool next(int i, Unit& u) const {
        const long L = (long)i * G + c; if (L >= nwg) return false;
        int wgid = (int)L; { const int q = nwg / NXCD, r = nwg % NXCD, xcd = wgid % NXCD, off = wgid / NXCD; wgid = (xcd < r ? xcd * (q + 1) : r * (q + 1) + (xcd - r) * q) + off; }
        const int nig = WGM * nN, gid = wgid / nig, fm = gid * WGM, gsz = (nM - fm) < WGM ? (nM - fm) : WGM;
        u.pm = fm + ((wgid % nig) % gsz); u.pn = (wgid % nig) / gsz; return true;
    }
    __device__ __forceinline__ void a_ready(const Unit&) const {}
    __device__ __forceinline__ void done(const Unit&) const {}
};

__device__ __forceinline__ unsigned cvt_pk_bf16(float lo, float hi) { unsigned r; asm volatile("v_cvt_pk_bf16_f32 %0, %1, %2" : "=v"(r) : "v"(lo), "v"(hi)); return r; }
typedef float f32x2 __attribute__((ext_vector_type(2)));
__device__ __forceinline__ float row_rstd(const float* ss, int row) {
    const f32x4* p = (const f32x4*)(ss + (size_t)row * 16);
    const f32x4 a = p[0], b = p[1], c = p[2], d = p[3];
    const float s = ((a[0] + a[1]) + (a[2] + a[3])) + ((b[0] + b[1]) + (b[2] + b[3])) + ((c[0] + c[1]) + (c[2] + c[3])) + ((d[0] + d[1]) + (d[2] + d[3]));
    return __builtin_amdgcn_rsqf(s * (1.0f / 1024.0f) + 1e-6f);
}
struct RsTab { const PG8_LAS float* tab; int pmA, pmB; const float* ss; };
template <class Sched> __device__ __forceinline__ RsTab rs_table_build(PG8_LAS unsigned char* lds_tab, const float* ss, const Sched& S, int tid) {
    RsTab t; t.tab = (const PG8_LAS float*)lds_tab; t.pmA = -1; t.pmB = -1; t.ss = ss;
    Unit u; for (int i = 0; S.next(i, u); ++i) { if (t.pmA < 0) t.pmA = u.pm; else if (u.pm != t.pmA && t.pmB < 0) t.pmB = u.pm; }
    const int pm = tid < 256 ? t.pmA : t.pmB;
    if (pm >= 0) ((PG8_LAS float*)lds_tab)[tid] = row_rstd(ss, pm * BM + (tid & 255));
    __syncthreads();
    return t;
}
__device__ __forceinline__ float rs_lookup(const RsTab& t, const Unit& u, int r  ) {
    if (u.pm == t.pmA) return t.tab[r];
    if (u.pm == t.pmB) return t.tab[256 + r];
    return row_rstd(t.ss, u.pm * BM + r);
}
__device__ __forceinline__ float sigmoidf_(float x) { return __builtin_amdgcn_rcpf(1.0f + __builtin_amdgcn_exp2f(-1.4426950408889634f * x)); }
__device__ __forceinline__ float siluf_(float x) { return x * sigmoidf_(x); }
__device__ __forceinline__ float bf_lo(unsigned w) { return __uint_as_float(w << 16); }
__device__ __forceinline__ float bf_hi(unsigned w) { return __uint_as_float(w & 0xffff0000u); }

struct EpiSwiGLU {
    static constexpr bool PERM = true, AFTER_DRAIN = false;
    bf16_t* O; RsTab rt; int ldo;
    struct Pre {};
    __device__ __forceinline__ Pre pre(const Unit&, int, int) const { return Pre{}; }
    __device__ __forceinline__ void operator()(const f32x4 (&acc)[2][2][4][2], const Unit& u, int wr, int wc, int fr, int fq, const Pre&) const {
        const int row0 = u.pm * BM + wr * 64 + fr, col0 = u.pn * HALF + wc * 32 + 8 * fq;
#pragma unroll
        for (int ai = 0; ai < 2; ++ai)
#pragma unroll
            for (int m = 0; m < 4; ++m) {
                const int row = row0 + ai * HALF + m * 16; const float rs = rs_lookup(rt, u, ai * HALF + wr * 64 + m * 16 + fr), c1 = -1.4426950408889634f * rs, rs2 = rs * rs;
                float h[8];
#pragma unroll
                for (int n = 0; n < 2; ++n)
#pragma unroll
                    for (int i = 0; i < 4; ++i) { const float g = acc[ai][0][m][n][i], up = acc[ai][1][m][n][i];
                        h[4 * n + i] = (g * up) * (rs2 * __builtin_amdgcn_rcpf(1.0f + __builtin_amdgcn_exp2f(g * c1))); }
                u32x4 w; w.x = cvt_pk_bf16(h[0], h[1]); w.y = cvt_pk_bf16(h[2], h[3]); w.z = cvt_pk_bf16(h[4], h[5]); w.w = cvt_pk_bf16(h[6], h[7]);
                *(u32x4*)(O + (size_t)row * ldo + col0) = w;
            }
    }
};
template <bool F32OUT> struct EpiResid {
    static constexpr bool PERM = true, AFTER_DRAIN = false;
    bf16_t* H; float* ssout; float alpha; float* out32;
    struct Pre {};
    __device__ __forceinline__ Pre pre(const Unit&, int, int) const { return Pre{}; }
    __device__ __forceinline__ void operator()(const f32x4 (&acc)[2][2][4][2], const Unit& u, int wr, int wc, int fr, int fq, const Pre&) const {
        const int row0 = u.pm * BM + wr * 64 + fr, col0 = u.pn * BM + wc * 32 + 8 * fq;
#pragma unroll
        for (int ai = 0; ai < 2; ++ai) {
            u32x4 old[4][2];
#pragma unroll
            for (int m = 0; m < 4; ++m)
#pragma unroll
                for (int bj = 0; bj < 2; ++bj) old[m][bj] = *(const u32x4*)(H + (size_t)(row0 + ai * HALF + m * 16) * 1024 + col0 + bj * HALF);
#pragma unroll
            for (int m = 0; m < 4; ++m) {
                const int row = row0 + ai * HALF + m * 16; float sq = 0.f;
#pragma unroll
                for (int bj = 0; bj < 2; ++bj) {
                    bf16_t* hp = H + (size_t)row * 1024 + col0 + bj * HALF;
                    const u32x4 o4 = old[m][bj];
                    float v[8];
                    v[0] = bf_lo(o4.x); v[1] = bf_hi(o4.x); v[2] = bf_lo(o4.y); v[3] = bf_hi(o4.y); v[4] = bf_lo(o4.z); v[5] = bf_hi(o4.z); v[6] = bf_lo(o4.w); v[7] = bf_hi(o4.w);
#pragma unroll
                    for (int n = 0; n < 2; ++n)
#pragma unroll
                        for (int i = 0; i < 4; ++i) { v[4 * n + i] += alpha * acc[ai][bj][m][n][i]; sq += v[4 * n + i] * v[4 * n + i]; }
                    u32x4 w; w.x = cvt_pk_bf16(v[0], v[1]); w.y = cvt_pk_bf16(v[2], v[3]); w.z = cvt_pk_bf16(v[4], v[5]); w.w = cvt_pk_bf16(v[6], v[7]);
                    *(u32x4*)hp = w;
                    if (F32OUT) { float* op = out32 + (size_t)row * 1024 + col0 + bj * HALF; *(f32x4*)op = (f32x4){v[0], v[1], v[2], v[3]}; *(f32x4*)(op + 4) = (f32x4){v[4], v[5], v[6], v[7]}; }
                }
                sq += __shfl_xor(sq, 16); sq += __shfl_xor(sq, 32);
                if (fq == 0) ssout[(size_t)row * 16 + u.pn * 4 + wc] = sq;
            }
        }
    }
};
struct EpiFinalNorm {
    static constexpr bool PERM = false, AFTER_DRAIN = false;
    const bf16_t* H; float* out; const float* gain; float alpha;
    float* xslots;
    unsigned* cnt;
    PG8_LAS unsigned char* xl;
    struct Pre {};
    __device__ __forceinline__ Pre pre(const Unit&, int, int) const { return Pre{}; }
    __device__ __forceinline__ void operator()(f32x4 (&acc)[2][2][4][2], const Unit& u, int wr, int wc, int fr, int fq, const Pre&) const {
        const int tid = threadIdx.x, lane = tid & 63, wid = __builtin_amdgcn_readfirstlane(tid >> 6);
        PG8_LAS float* P = (PG8_LAS float*)xl; PG8_LAS float* S = (PG8_LAS float*)(xl + 4096);
        const int row0 = u.pm * BM + wr * 64 + fr, col0 = u.pn * BM + wc * 32 + 4 * fq;
        typedef unsigned u32x2_t __attribute__((ext_vector_type(2)));
#pragma unroll
        for (int ai = 0; ai < 2; ++ai)
#pragma unroll
            for (int m = 0; m < 4; ++m) {
                const int row = row0 + ai * HALF + m * 16; float sq = 0.f;
#pragma unroll
                for (int bj = 0; bj < 2; ++bj)
#pragma unroll
                    for (int n = 0; n < 2; ++n) {
                        const u32x2_t o = *(const u32x2_t*)(H + (size_t)row * 1024 + col0 + bj * HALF + n * 16);
                        f32x4 v = (f32x4){bf_lo(o.x), bf_hi(o.x), bf_lo(o.y), bf_hi(o.y)} + alpha * acc[ai][bj][m][n];
                        acc[ai][bj][m][n] = v; sq += (v[0] * v[0] + v[1] * v[1]) + (v[2] * v[2] + v[3] * v[3]);
                    }
                sq += __shfl_xor(sq, 16); sq += __shfl_xor(sq, 32);
                if (fq == 0) P[(ai * HALF + wr * 64 + m * 16 + fr) * 4 + wc] = sq;
            }
        asm volatile("s_waitcnt lgkmcnt(0)" ::: "memory"); __builtin_amdgcn_s_barrier(); asm volatile("" ::: "memory");
        if (tid < 256) { const f32x4 p = *(const PG8_LAS f32x4*)(P + tid * 4);
            __hip_atomic_store(xslots + ((size_t)u.pm * BM + tid) * 4 + u.pn, (p[0] + p[1]) + (p[2] + p[3]), __ATOMIC_RELAXED, __HIP_MEMORY_SCOPE_AGENT); }
        asm volatile("s_waitcnt vmcnt(0)" ::: "memory");
        if (tid < 256 && lane == 0) __hip_atomic_fetch_add(cnt + 64 * u.pm, 1u, __ATOMIC_RELAXED, __HIP_MEMORY_SCOPE_AGENT);
        if (wid == 0) {
            unsigned sp = 0;
            while ((unsigned)__builtin_amdgcn_readfirstlane(__hip_atomic_load(cnt + 64 * u.pm, __ATOMIC_RELAXED, __HIP_MEMORY_SCOPE_AGENT)) < 16u) { __builtin_amdgcn_s_sleep(2); if (++sp > (1u << 18)) break; }
            __builtin_amdgcn_fence(__ATOMIC_ACQUIRE, "agent");
        }
        asm volatile("s_waitcnt vmcnt(0) lgkmcnt(0)" ::: "memory"); __builtin_amdgcn_s_barrier(); asm volatile("" ::: "memory");
        if (tid < 256) { const float* sl = xslots + ((size_t)u.pm * BM + tid) * 4;
            const float t = (__hip_atomic_load(sl, __ATOMIC_RELAXED, __HIP_MEMORY_SCOPE_AGENT) + __hip_atomic_load(sl + 1, __ATOMIC_RELAXED, __HIP_MEMORY_SCOPE_AGENT))
                          + (__hip_atomic_load(sl + 2, __ATOMIC_RELAXED, __HIP_MEMORY_SCOPE_AGENT) + __hip_atomic_load(sl + 3, __ATOMIC_RELAXED, __HIP_MEMORY_SCOPE_AGENT));
            S[tid] = __builtin_amdgcn_rsqf(t * (1.0f / 1024.0f) + 1e-6f); }
        asm volatile("s_waitcnt lgkmcnt(0)" ::: "memory"); __builtin_amdgcn_s_barrier(); asm volatile("" ::: "memory");
        f32x4 gv[2][2];
#pragma unroll
        for (int bj = 0; bj < 2; ++bj)
#pragma unroll
            for (int n = 0; n < 2; ++n) gv[bj][n] = *(const f32x4*)(gain + col0 + bj * HALF + n * 16);
#pragma unroll
        for (int ai = 0; ai < 2; ++ai)
#pragma unroll
            for (int m = 0; m < 4; ++m) {
                const int r = ai * HALF + wr * 64 + m * 16 + fr; const float rs = S[r];
                float* op = out + (size_t)(u.pm * BM + r) * 1024 + col0;
#pragma unroll
                for (int bj = 0; bj < 2; ++bj)
#pragma unroll
                    for (int n = 0; n < 2; ++n) __builtin_nontemporal_store(acc[ai][bj][m][n] * rs * gv[bj][n], (f32x4*)(op + bj * HALF + n * 16));
            }
    }
};
struct EpiProjAB {
    static constexpr bool PERM = true, AFTER_DRAIN = false;
    bf16_t* O; RsTab rt; float qscale;
    struct Pre {};
    __device__ __forceinline__ Pre pre(const Unit&, int, int) const { return Pre{}; }
    __device__ __forceinline__ void operator()(const f32x4 (&acc)[2][2][4][2], const Unit& u, int wr, int wc, int fr, int fq, const Pre&) const {
        const int row0 = u.pm * BM + wr * 64 + fr, col0 = u.pn * BM + wc * 32 + 8 * fq;
        const float sc = (u.pn == 6 || u.pn == 7) ? qscale : 1.0f;
#pragma unroll
        for (int ai = 0; ai < 2; ++ai)
#pragma unroll
            for (int m = 0; m < 4; ++m) {
                const int row = row0 + ai * HALF + m * 16; const float rs = rs_lookup(rt, u, ai * HALF + wr * 64 + m * 16 + fr) * sc;
#pragma unroll
                for (int bj = 0; bj < 2; ++bj) {
                    const f32x4 a = acc[ai][bj][m][0] * rs, b = acc[ai][bj][m][1] * rs;
                    u32x4 w; w.x = cvt_pk_bf16(a[0], a[1]); w.y = cvt_pk_bf16(a[2], a[3]); w.z = cvt_pk_bf16(b[0], b[1]); w.w = cvt_pk_bf16(b[2], b[3]);
                    *(u32x4*)(O + (size_t)row * 3072 + col0 + bj * HALF) = w;
                }
            }
    }
};
struct EpiProjC {
    static constexpr bool PERM = true, AFTER_DRAIN = false;
    bf16_t* Qs; float* LF; bf16_t* Iv; bf16_t* Gs; RsTab rt; const float* clb;
    struct Pre {};
    __device__ __forceinline__ Pre pre(const Unit&, int, int) const { return Pre{}; }
    __device__ __forceinline__ void operator()(const f32x4 (&acc)[2][2][4][2], const Unit& u, int wr, int wc, int fr, int fq, const Pre&) const {
        const int kind = u.pn >> 2;
        const int row0 = u.pm * BM + wr * 64 + fr, col0 = (u.pn & 3) * BM + wc * 32 + 8 * fq;
        if (kind == 1) {
            float lb[2][8];
#pragma unroll
            for (int bj = 0; bj < 2; ++bj)
#pragma unroll
                for (int j = 0; j < 8; ++j) { const int c = col0 + bj * HALF + j; lb[bj][j] = sigmoidf_(clb[1024 + c] - clb[c]); }
#pragma unroll
            for (int ai = 0; ai < 2; ++ai)
#pragma unroll
                for (int m = 0; m < 4; ++m) {
                    const int row = row0 + ai * HALF + m * 16; const float rs = rs_lookup(rt, u, ai * HALF + wr * 64 + m * 16 + fr);
#pragma unroll
                    for (int bj = 0; bj < 2; ++bj) {
                        float v[8];
#pragma unroll
                        for (int n = 0; n < 2; ++n)
#pragma unroll
                            for (int i = 0; i < 4; ++i) { const float x = acc[ai][bj][m][n][i] * rs, l = lb[bj][4 * n + i]; v[4 * n + i] = __builtin_amdgcn_logf(l + (1.0f - l) * sigmoidf_(x)); }
                        float* op = LF + (size_t)row * 1024 + col0 + bj * HALF; *(f32x4*)op = (f32x4){v[0], v[1], v[2], v[3]}; *(f32x4*)(op + 4) = (f32x4){v[4], v[5], v[6], v[7]};
                    }
                }
        } else {
            bf16_t* O = Qs + (kind ? ((size_t)(64 + 64 * kind) << 19) : (size_t)0);
            const bool act = kind != 2;
#pragma unroll
            for (int ai = 0; ai < 2; ++ai)
#pragma unroll
                for (int m = 0; m < 4; ++m) {
                    const int row = row0 + ai * HALF + m * 16; const float rs = rs_lookup(rt, u, ai * HALF + wr * 64 + m * 16 + fr);
#pragma unroll
                    for (int bj = 0; bj < 2; ++bj) {
                        float v[8];
#pragma unroll
                        for (int n = 0; n < 2; ++n)
#pragma unroll
                            for (int i = 0; i < 4; ++i) { const float x = acc[ai][bj][m][n][i] * rs; v[4 * n + i] = act ? siluf_(x) : x; }
                        u32x4 w; w.x = cvt_pk_bf16(v[0], v[1]); w.y = cvt_pk_bf16(v[2], v[3]); w.z = cvt_pk_bf16(v[4], v[5]); w.w = cvt_pk_bf16(v[6], v[7]);
                        *(u32x4*)(O + (size_t)row * 1024 + col0 + bj * HALF) = w;
                    }
                }
        }
    }
};
template <class Epi, class Sched, bool ALIGN_EPI = false, bool SP2 = false>
__device__ __forceinline__ void gemm_phase(PG8_LAS unsigned char* lds, const Gemm g, const Sched& S, const Epi& E) {
    const int tid = threadIdx.x, wid = __builtin_amdgcn_readfirstlane(tid >> 6), lane = tid & 63, wr = wid >> 2, wc = wid & 3, fr = lane & 15, fq = lane >> 4;
    const int K = g.K, nt = K / BK;
    unsigned voffA[2], voffB[2];
#pragma unroll
    for (int i = 0; i < 2; ++i) { int R, C; stage_rc(tid * 16 + i * 8192, R, C); const int Rb = Epi::PERM ? ((R & ~31) + perm32(R & 31)) : R;
        voffA[i] = (unsigned)(R * K + C) * 2u; voffB[i] = (unsigned)(Rb * K + C) * 2u; }
    const size_t kstep = (size_t)(BK * 2);
    const size_t hstep = (size_t)HALF * K * 2;
    const size_t tstep = 2 * hstep;
    const unsigned ldsw = (unsigned)wid * 1024u;
    const int aoff = lds_byte(wr * 64 + fr, fq * 8), boff = lds_byte(wc * 32 + fr, fq * 8);
#define PG8_SA(b, h) (((b) * 2 + (h)) * HTB)
#define PG8_SB(b, h) ((4 + (b) * 2 + (h)) * HTB)
#define PG8_STAGE(bufoff, gbase, voff) do { _Pragma("unroll") for (int _i = 0; _i < 2; ++_i) \
        __builtin_amdgcn_global_load_lds((const unsigned*)((const char*)(gbase) + (voff)[_i]), (PG8_LAS unsigned*)(lds + (bufoff) + ldsw + _i * 8192), 16, 0, 0); } while (0)
#define PG8_LDA(dst, b, h) do { _Pragma("unroll") for (int m = 0; m < 4; ++m) _Pragma("unroll") for (int k = 0; k < 2; ++k) dst[m][k] = *(const PG8_LAS bf16x8*)(lds + PG8_SA(b, h) + aoff + m * 2048 + k * 1024); } while (0)
#define PG8_LDB(dst, b, h) do { _Pragma("unroll") for (int n = 0; n < 2; ++n) _Pragma("unroll") for (int k = 0; k < 2; ++k) dst[n][k] = *(const PG8_LAS bf16x8*)(lds + PG8_SB(b, h) + boff + n * 2048 + k * 1024); } while (0)
#define PG8_MMA(ai, bj, At, Bt) do { __builtin_amdgcn_s_setprio(1); _Pragma("unroll") for (int m = 0; m < 4; ++m) _Pragma("unroll") for (int n = 0; n < 2; ++n) _Pragma("unroll") for (int k = 0; k < 2; ++k) \
        acc[ai][bj][m][n] = __builtin_amdgcn_mfma_f32_16x16x32_bf16(Bt[n][k], At[m][k], acc[ai][bj][m][n], 0, 0, 0); __builtin_amdgcn_s_setprio(0); } while (0)
#define PG8_WAIT_V(n) asm volatile("s_waitcnt vmcnt(" #n ")" ::: "memory")
#define PG8_WAIT_L(n) asm volatile("s_waitcnt lgkmcnt(" #n ")" ::: "memory")
#define PG8_BAR __builtin_amdgcn_s_barrier()
#define PG8_SCHED __builtin_amdgcn_sched_barrier(0)
    Unit cur, nxt; int ui = 0;
    if (!S.next(0, cur)) return;
    f32x4 acc[2][2][4][2];
#pragma unroll
    for (int a = 0; a < 2; ++a)
#pragma unroll
        for (int b = 0; b < 2; ++b)
#pragma unroll
            for (int m = 0; m < 4; ++m)
#pragma unroll
                for (int n = 0; n < 2; ++n) acc[a][b][m][n] = (f32x4){0.f, 0.f, 0.f, 0.f};
    bf16x8 At[4][2], B0[2][2], B1[2][2];
    const char* cA = (const char*)g.A + (size_t)cur.pm * tstep; const char* cB = (const char*)g.Bt + (size_t)cur.pn * tstep;
    S.a_ready(cur);
    if constexpr (SP2) {
        PG8_STAGE(PG8_SB(0, 0), cB, voffB); PG8_STAGE(PG8_SB(0, 1), cB + hstep, voffB); PG8_STAGE(PG8_SA(0, 0), cA, voffA); PG8_STAGE(PG8_SA(0, 1), cA + hstep, voffA);
        if (wr == 1) PG8_BAR;
        PG8_WAIT_V(2); PG8_BAR;
        PG8_STAGE(PG8_SB(1, 0), cB + kstep, voffB); PG8_STAGE(PG8_SA(1, 0), cA + kstep, voffA); PG8_STAGE(PG8_SB(1, 1), cB + hstep + kstep, voffB);
        PG8_WAIT_V(6); PG8_BAR;
    } else {
        PG8_STAGE(PG8_SB(0, 0), cB, voffB); PG8_STAGE(PG8_SA(0, 0), cA, voffA); PG8_STAGE(PG8_SB(0, 1), cB + hstep, voffB); PG8_STAGE(PG8_SA(0, 1), cA + hstep, voffA);
        if (wr == 1) PG8_BAR;
        PG8_WAIT_V(4); PG8_BAR;
        PG8_STAGE(PG8_SB(1, 0), cB + kstep, voffB); PG8_STAGE(PG8_SA(1, 0), cA + kstep, voffA); PG8_STAGE(PG8_SB(1, 1), cB + hstep + kstep, voffB);
        PG8_WAIT_V(6); PG8_BAR;
    }
    for (;;) {
        const bool has_next = S.next(ui + 1, nxt);
        const char* nA = has_next ? (const char*)g.A + (size_t)nxt.pm * tstep : cA; const char* nB = has_next ? (const char*)g.Bt + (size_t)nxt.pn * tstep : cB;
        for (int t = 0; t < nt; t += 2) {
            const bool last = (t == nt - 2);
            const char* a1 = cA + (size_t)(t + 1) * kstep;
            const char* a2 = last ? nA : cA + (size_t)(t + 2) * kstep; const char* b2 = last ? nB : cB + (size_t)(t + 2) * kstep;
            const char* a3 = a2 + kstep; const char* b3 = b2 + kstep;
            if (last && has_next) S.a_ready(nxt);
            if constexpr (SP2) {
            PG8_LDB(B0, 0, 0); PG8_LDB(B1, 0, 1); PG8_SCHED; PG8_LDA(At, 0, 0); PG8_STAGE(PG8_SA(1, 1), a1 + hstep, voffA);
            PG8_WAIT_V(8); PG8_WAIT_L(0); PG8_BAR; PG8_MMA(0, 0, At, B0); PG8_MMA(0, 1, At, B1); PG8_BAR; PG8_SCHED;
            PG8_LDA(At, 0, 1); PG8_STAGE(PG8_SB(0, 0), b2, voffB); PG8_STAGE(PG8_SB(0, 1), b2 + hstep, voffB); PG8_STAGE(PG8_SA(0, 0), a2, voffA);
            PG8_WAIT_V(8); PG8_WAIT_L(0); PG8_BAR; PG8_MMA(1, 0, At, B0); PG8_MMA(1, 1, At, B1); PG8_BAR; PG8_SCHED;
            PG8_LDB(B0, 1, 0); PG8_LDB(B1, 1, 1); PG8_SCHED; PG8_LDA(At, 1, 0); PG8_STAGE(PG8_SA(0, 1), a2 + hstep, voffA);
            PG8_WAIT_V(8); PG8_WAIT_L(0); PG8_BAR; PG8_MMA(0, 0, At, B0); PG8_MMA(0, 1, At, B1); PG8_BAR; PG8_SCHED;
            PG8_LDA(At, 1, 1); PG8_STAGE(PG8_SB(1, 0), b3, voffB); PG8_STAGE(PG8_SB(1, 1), b3 + hstep, voffB); PG8_STAGE(PG8_SA(1, 0), a3, voffA);
            PG8_WAIT_V(8); PG8_WAIT_L(0); PG8_BAR; PG8_MMA(1, 0, At, B0); PG8_MMA(1, 1, At, B1); PG8_BAR; PG8_SCHED;
            } else {
            PG8_LDB(B0, 0, 0); PG8_SCHED; PG8_LDA(At, 0, 0); PG8_STAGE(PG8_SA(1, 1), a1 + hstep, voffA);
            PG8_WAIT_L(8); PG8_BAR; PG8_WAIT_L(0); PG8_MMA(0, 0, At, B0); PG8_BAR; PG8_SCHED;
            PG8_LDB(B1, 0, 1); PG8_STAGE(PG8_SB(0, 0), b2, voffB);
            PG8_BAR; PG8_WAIT_L(0); PG8_MMA(0, 1, At, B1); PG8_BAR;
            PG8_LDA(At, 0, 1); PG8_STAGE(PG8_SA(0, 0), a2, voffA);
            PG8_BAR; PG8_WAIT_L(0); PG8_MMA(1, 0, At, B0); PG8_BAR; PG8_SCHED;
            PG8_STAGE(PG8_SB(0, 1), b2 + hstep, voffB);
            PG8_WAIT_V(6); PG8_BAR; PG8_MMA(1, 1, At, B1); PG8_BAR;
            PG8_LDB(B0, 1, 0); PG8_SCHED; PG8_LDA(At, 1, 0); PG8_STAGE(PG8_SA(0, 1), a2 + hstep, voffA);
            PG8_WAIT_L(8); PG8_BAR; PG8_WAIT_L(0); PG8_MMA(0, 0, At, B0); PG8_BAR; PG8_SCHED;
            PG8_LDB(B1, 1, 1); PG8_STAGE(PG8_SB(1, 0), b3, voffB);
            PG8_BAR; PG8_WAIT_L(0); PG8_MMA(0, 1, At, B1); PG8_BAR;
            PG8_LDA(At, 1, 1); PG8_STAGE(PG8_SA(1, 0), a3, voffA);
            PG8_BAR; PG8_WAIT_L(0); PG8_MMA(1, 0, At, B0); PG8_BAR; PG8_SCHED;
            PG8_STAGE(PG8_SB(1, 1), b3 + hstep, voffB);
            PG8_WAIT_V(6); PG8_BAR; PG8_MMA(1, 1, At, B1); PG8_BAR;
            }
        }
        if constexpr (ALIGN_EPI) { if (wr == 0) PG8_BAR; }
        if constexpr (!Epi::AFTER_DRAIN) { E(acc, cur, wr, wc, fr, fq, E.pre(cur, wr, lane)); S.done(cur); }
        if (!has_next) break;
#pragma unroll
        for (int a = 0; a < 2; ++a)
#pragma unroll
            for (int b = 0; b < 2; ++b)
#pragma unroll
                for (int m = 0; m < 4; ++m)
#pragma unroll
                    for (int n = 0; n < 2; ++n) acc[a][b][m][n] = (f32x4){0.f, 0.f, 0.f, 0.f};
        cur = nxt; cA = nA; cB = nB; ++ui;
        if constexpr (ALIGN_EPI) { if (wr == 1) PG8_BAR; }
    }
    PG8_WAIT_V(0);
    if constexpr (!ALIGN_EPI) { if (wr == 0) PG8_BAR; }
    PG8_BAR;
    if constexpr (Epi::AFTER_DRAIN) { E.fused(acc, cur, wr, wc, fr, fq, lds, wid, lane); S.done(cur); }
#undef PG8_SA
#undef PG8_SB
#undef PG8_STAGE
#undef PG8_LDA
#undef PG8_LDB
#undef PG8_MMA
#undef PG8_WAIT_V
#undef PG8_WAIT_L
#undef PG8_BAR
#undef PG8_SCHED
}
}
using pg8::bf16_t; using pg8::bf16x8; using pg8::f32x4; using pg8::u32x4;
typedef float f32x16 __attribute__((ext_vector_type(16)));
typedef short s16x4 __attribute__((ext_vector_type(4)));
typedef unsigned u32x2 __attribute__((ext_vector_type(2)));
#define LAS __attribute__((address_space(3)))
constexpr int NWAVES = 8, NTHREADS = 512;
constexpr int BATCH = 8, SEQ = 4096, D = 1024, FF = 2816, M = BATCH * SEQ;
constexpr float QSCALE = 0.125f * 1.4426950408889634f;
constexpr size_t MiB = 1u << 20;
constexpr size_t WS_GU = 1 * MiB;
constexpr size_t WS_DN = WS_GU + 44 * MiB;
constexpr size_t WS_ABIN = WS_DN + 22 * MiB;
constexpr size_t WS_ABOUT = WS_ABIN + 6 * MiB;
constexpr size_t WS_CIN = WS_ABOUT + 2 * MiB;
constexpr size_t WS_COUT = WS_CIN + 8 * MiB;
constexpr size_t WS_H = WS_COUT + 2 * MiB;
constexpr size_t WS_SS = WS_H + 64 * MiB;
constexpr size_t WS_R = WS_SS + 14 * MiB;
constexpr size_t WS_HID = WS_R, WS_PROJ = WS_R, WS_Y = WS_R + 192 * MiB;
constexpr size_t WS_QS = WS_R, WS_LF = WS_R + 64 * MiB, WS_IV = WS_R + 192 * MiB, WS_GS = WS_R + 256 * MiB;
constexpr size_t WS_END = WS_R + 320 * MiB;
static_assert(WS_END <= 512 * MiB, "workspace map");
constexpr int LDS_BYTES = 147456;

__device__ __forceinline__ unsigned f2bf(float f) { unsigned u = __builtin_bit_cast(unsigned, f); return (u + 0x7fffu + ((u >> 16) & 1u)) >> 16; }
__device__ __forceinline__ unsigned pk2(float lo, float hi) { return pg8::cvt_pk_bf16(lo, hi); }
__device__ __forceinline__ float wave_sum(float v) {
#pragma unroll
    for (int o = 1; o < 64; o <<= 1) v += __shfl_xor(v, o);
    return v;
}
constexpr int P0_SCR = 64 * 65 * 4;
__device__ __forceinline__ void p0_transpose_item(const float* W, int K, int N, const float* gain, bf16_t* WT, int k0, int n0, int orow0, LAS float* scr, int lane) {
    const int lr = lane >> 4, lc = (lane & 15) * 4;
    f32x4 v[16];
#pragma unroll
    for (int j = 0; j < 16; ++j) v[j] = __builtin_nontemporal_load((const f32x4*)(W + (size_t)(k0 + 4 * j + lr) * N + n0 + lc));
    if (gain) {
#pragma unroll
        for (int j = 0; j < 16; ++j) v[j] = v[j] * gain[k0 + 4 * j + lr];
    }
#pragma unroll
    for (int j = 0; j < 16; ++j) { LAS float* d = scr + (4 * j + lr) * 65 + lc; d[0] = v[j][0]; d[1] = v[j][1]; d[2] = v[j][2]; d[3] = v[j][3]; }
    asm volatile("s_waitcnt lgkmcnt(0)" ::: "memory");
    const int c = lane & 7;
#pragma unroll
    for (int j = 0; j < 8; ++j) { const int n = (lane >> 3) + 8 * j; const LAS float* s = scr + (8 * c) * 65 + n;
        u32x4 o; o.x = pk2(s[0 * 65], s[1 * 65]); o.y = pk2(s[2 * 65], s[3 * 65]); o.z = pk2(s[4 * 65], s[5 * 65]); o.w = pk2(s[6 * 65], s[7 * 65]);
        *(u32x4*)(WT + (size_t)(orow0 + n) * K + k0 + 8 * c) = o; }
    asm volatile("s_waitcnt lgkmcnt(0)" ::: "memory");
}
struct Ptrs {
    const float* in[18]; float* out; unsigned char* ws;
};
__device__ __forceinline__ void p0_prologue(const Ptrs& P, LAS unsigned char* lds, int gw, int NGW, int wave, int lane) {
    unsigned char* ws = P.ws;
    const float* x = P.in[0]; bf16_t* H = (bf16_t*)(ws + WS_H); float* ss0 = (float*)(ws + WS_SS);
    for (int m0 = gw * 4; m0 < M; m0 += NGW * 4) {
        f32x4 v[4][4];
#pragma unroll
        for (int r = 0; r < 4; ++r)
#pragma unroll
            for (int j = 0; j < 4; ++j) v[r][j] = __builtin_nontemporal_load((const f32x4*)(x + (size_t)(m0 + r) * D) + lane + 64 * j);
#pragma unroll
        for (int r = 0; r < 4; ++r) {
            float s = 0.f;
#pragma unroll
            for (int j = 0; j < 4; ++j) s += (v[r][j][0] * v[r][j][0] + v[r][j][1] * v[r][j][1]) + (v[r][j][2] * v[r][j][2] + v[r][j][3] * v[r][j][3]);
            s = wave_sum(s);
            u32x2* o8 = (u32x2*)(H + (size_t)(m0 + r) * D) + lane;
#pragma unroll
            for (int j = 0; j < 4; ++j) { u32x2 w; w.x = pk2(v[r][j][0], v[r][j][1]); w.y = pk2(v[r][j][2], v[r][j][3]); o8[64 * j] = w; }
            if (lane < 16) ss0[(size_t)(m0 + r) * 16 + lane] = lane == 0 ? s : 0.f;
        }
    }
    LAS float* scr = (LAS float*)(lds + wave * P0_SCR);
    constexpr int I_FFN = 704;
    constexpr int I_ABIN = 16 * 48, I_ABOUT = 16 * 16, I_CIN = 16 * 64, I_COUT = 16 * 16;
    constexpr int NITEMS = 12 * I_FFN + I_ABIN + I_ABOUT + I_CIN + I_COUT;
    for (int it = gw; it < NITEMS; it += NGW) {
        int r = it;
        if (r < 12 * I_FFN) {
            const int mat = r / I_FFN, item = r % I_FFN, f = mat / 3, type = mat % 3;
            const int layer = f >> 1, post = f & 1;
            if (type < 2) {
                const float* Wg = post ? P.in[7] : P.in[2]; const float* Wu = post ? P.in[8] : P.in[3]; const float* W = (type == 0 ? Wg : Wu) + (size_t)layer * D * FF;
                const float* gain = (post ? P.in[6] : P.in[1]) + layer * D;
                const int nblk = FF / 64, kb = item / nblk, nb = item % nblk, n0 = 64 * nb;
                const int orow0 = (n0 >> 7) * 256 + (n0 & 127) + (type == 1 ? 128 : 0);
                p0_transpose_item(W, D, FF, gain, (bf16_t*)(ws + WS_GU) + (size_t)f * 5632 * 1024, 64 * kb, n0, orow0, scr, lane);
            } else {
                const float* W = (post ? P.in[9] : P.in[4]) + (size_t)layer * FF * D;
                const int nblk = D / 64, kb = item / nblk, nb = item % nblk, n0 = 64 * nb;
                p0_transpose_item(W, FF, D, nullptr, (bf16_t*)(ws + WS_DN) + (size_t)f * 1024 * 2816, 64 * kb, n0, n0, scr, lane);
            }
            continue;
        }
        r -= 12 * I_FFN;
        if (r < I_ABIN) { const int nblk = 48, kb = r / nblk, nb = r % nblk; p0_transpose_item(P.in[10], D, 3072, P.in[5], (bf16_t*)(ws + WS_ABIN), 64 * kb, 64 * nb, 64 * nb, scr, lane); continue; }
        r -= I_ABIN;
        if (r < I_ABOUT) { const int nblk = 16, kb = r / nblk, nb = r % nblk; p0_transpose_item(P.in[12], D, D, nullptr, (bf16_t*)(ws + WS_ABOUT), 64 * kb, 64 * nb, 64 * nb, scr, lane); continue; }
        r -= I_ABOUT;
        if (r < I_CIN) { const int nblk = 64, kb = r / nblk, nb = r % nblk; p0_transpose_item(P.in[13], D, 4096, P.in[5] + D, (bf16_t*)(ws + WS_CIN), 64 * kb, 64 * nb, 64 * nb, scr, lane); continue; }
        r -= I_CIN;
        { const int nblk = 16, kb = r / nblk, nb = r % nblk; p0_transpose_item(P.in[16], D, D, nullptr, (bf16_t*)(ws + WS_COUT), 64 * kb, 64 * nb, 64 * nb, scr, lane); }
    }
}
__device__ __forceinline__ void final_norm(const Ptrs& P, int gw, int NGW, int lane) {
    const float* ss = (const float*)(P.ws + WS_SS) + (size_t)6 * M * 16; const float* gain = P.in[17]; const bf16_t* H = (const bf16_t*)(P.ws + WS_H);
    f32x4 g[4];
#pragma unroll
    for (int j = 0; j < 4; ++j) g[j] = ((const f32x4*)gain)[lane + 64 * j];
    for (int m0 = gw * 4; m0 < M; m0 += NGW * 4) {
        u32x2 w[4][4]; float rs[4];
#pragma unroll
        for (int r = 0; r < 4; ++r) { rs[r] = pg8::row_rstd(ss, m0 + r);
#pragma unroll
            for (int j = 0; j < 4; ++j) w[r][j] = ((const u32x2*)(H + (size_t)(m0 + r) * D))[lane + 64 * j]; }
#pragma unroll
        for (int r = 0; r < 4; ++r) { f32x4* orow = (f32x4*)(P.out + (size_t)(m0 + r) * D) + lane;
#pragma unroll
            for (int j = 0; j < 4; ++j) { const f32x4 v = (f32x4){pg8::bf_lo(w[r][j].x), pg8::bf_hi(w[r][j].x), pg8::bf_lo(w[r][j].y), pg8::bf_hi(w[r][j].y)}; __builtin_nontemporal_store(v * rs[r] * g[j], orow + 64 * j); } }
    }
}
#define XB_TMO      128
#define XB_XCNT(j)  (256  + 64 * (j))
#define XB_XSUB(j)  (1280 + 64 * (j))
#define XB_XGEN(j)  (2304 + 64 * (j))
#define XB_TOP      3328
#define XB_TOPGEN   3392
#define XCD_BAR_WORDS 3456
#define XB_SPIN_CAP (1u << 18)

__device__ __forceinline__ unsigned xb_ld(unsigned* p)              { return __hip_atomic_load(p, __ATOMIC_RELAXED, __HIP_MEMORY_SCOPE_AGENT); }
__device__ __forceinline__ unsigned xb_add(unsigned* p, unsigned v) { return __hip_atomic_fetch_add(p, v, __ATOMIC_RELAXED, __HIP_MEMORY_SCOPE_AGENT); }
__device__ __forceinline__ unsigned xb_xcc_id() { return (unsigned)__builtin_amdgcn_s_getreg((3 << 11) | 20) & 0xFu; }
#define XB_SPIN(cond, bar) do { unsigned _sp = 0; while (cond) { __builtin_amdgcn_s_sleep(1); \
    if ((++_sp & 255u) == 0u) { if (xb_ld(&(bar)[XB_TMO])) break; if (_sp > XB_SPIN_CAP) { atomicAdd(&(bar)[XB_TMO], 1u); break; } } } } while (0)

struct XcdBarrier {
    unsigned* bar; unsigned x;
    volatile LAS unsigned* st;
};

__device__ __forceinline__ XcdBarrier xcd_barrier_post(unsigned* bar, volatile LAS unsigned* st) {
    XcdBarrier b; b.bar = bar; b.x = xb_xcc_id(); b.st = st;
    if (threadIdx.x == 0) (void)xb_add(&bar[XB_XCNT(b.x)], 1u);
    return b;
}
__device__ __forceinline__ void xcd_barrier_complete(unsigned* bar, unsigned x, unsigned& nloc, unsigned& nx) {
    const unsigned G = gridDim.x * gridDim.y * gridDim.z;
    unsigned sum, cnt, mine, sp = 0u;
    for (;;) {
        sum = 0u; cnt = 0u; mine = 0u;
#pragma unroll
        for (unsigned j = 0; j < 16; ++j) { const unsigned c = xb_ld(&bar[XB_XCNT(j)]); sum += c; cnt += (c > 0u) ? 1u : 0u; mine = (j == x) ? c : mine; }
        if (sum == G) break;
        __builtin_amdgcn_s_sleep(1);
        if ((++sp & 255u) == 0u) { if (xb_ld(&bar[XB_TMO])) break; if (sp > XB_SPIN_CAP) { atomicAdd(&bar[XB_TMO], 1u); break; } }
    }
    nloc = mine > 0u ? mine : 1u; nx = cnt > 0u ? cnt : 1u;
}

__device__ __forceinline__ void xcd_barrier(const XcdBarrier& b) {
    asm volatile("s_waitcnt vmcnt(0)" ::: "memory");
    __syncthreads();
    if (threadIdx.x == 0) {
        unsigned* bar = b.bar;
        __builtin_amdgcn_s_waitcnt(0);
        unsigned nloc = b.st[0], nx = b.st[1];
        if (nloc == 0u) { xcd_barrier_complete(bar, b.x, nloc, nx); b.st[0] = nloc; b.st[1] = nx; }
        const unsigned old = xb_add(&bar[XB_XSUB(b.x)], 1u);
        const unsigned gen = old / nloc;
        if (old + 1u == (gen + 1u) * nloc) {
            __builtin_amdgcn_fence(__ATOMIC_RELEASE, "agent");
            asm volatile("s_waitcnt vmcnt(0)" ::: "memory");
            const unsigned og = xb_add(&bar[XB_TOP], 1u);
            const unsigned tg = og / nx;
            if (og + 1u == (tg + 1u) * nx) xb_add(&bar[XB_TOPGEN], 1u);
            else XB_SPIN(xb_ld(&bar[XB_TOPGEN]) == tg, bar);
            __builtin_amdgcn_fence(__ATOMIC_ACQUIRE, "agent");
            xb_add(&bar[XB_XGEN(b.x)], 1u);
            asm volatile("s_waitcnt vmcnt(0)" ::: "memory");
        } else {
            XB_SPIN(xb_ld(&bar[XB_XGEN(b.x)]) == gen, bar);
            __builtin_amdgcn_fence(__ATOMIC_ACQUIRE, "agent");
            asm volatile("s_waitcnt vmcnt(0)" ::: "memory");
        }
    }
    __syncthreads();
}
__device__ __forceinline__ void unpack8(const u32x4 w, float (&v)[8]) {
    v[0] = pg8::bf_lo(w.x); v[1] = pg8::bf_hi(w.x); v[2] = pg8::bf_lo(w.y); v[3] = pg8::bf_hi(w.y); v[4] = pg8::bf_lo(w.z); v[5] = pg8::bf_hi(w.z); v[6] = pg8::bf_lo(w.w); v[7] = pg8::bf_hi(w.w);
}
__device__ __forceinline__ void conv_item(const bf16_t* PROJ, const float* cw, bf16_t* Y, int item, int lane) {
    const int r0 = item * 16, c0 = lane * 8;
    float w0[8], w1[8], w2[8];
#pragma unroll
    for (int j = 0; j < 8; ++j) { w0[j] = cw[c0 + j]; w1[j] = cw[512 + c0 + j]; w2[j] = cw[1024 + c0 + j]; }
    float um1[8], um2[8];
#pragma unroll
    for (int j = 0; j < 8; ++j) { um1[j] = 0.f; um2[j] = 0.f; }
    if ((r0 & (SEQ - 1)) != 0) {
        float a[8], b[8];
        const bf16_t* p2 = PROJ + (size_t)(r0 - 2) * 3072 + c0; unpack8(*(const u32x4*)(p2 + 512), a); unpack8(*(const u32x4*)(p2 + 1024), b);
#pragma unroll
        for (int j = 0; j < 8; ++j) um2[j] = a[j] * b[j];
        const bf16_t* p1 = PROJ + (size_t)(r0 - 1) * 3072 + c0; unpack8(*(const u32x4*)(p1 + 512), a); unpack8(*(const u32x4*)(p1 + 1024), b);
#pragma unroll
        for (int j = 0; j < 8; ++j) um1[j] = a[j] * b[j];
    }
#pragma unroll 4
    for (int r = 0; r < 16; ++r) {
        const bf16_t* p = PROJ + (size_t)(r0 + r) * 3072 + c0;
        float g[8], a[8], b[8], o[8];
        unpack8(*(const u32x4*)p, g); unpack8(*(const u32x4*)(p + 512), a); unpack8(*(const u32x4*)(p + 1024), b);
#pragma unroll
        for (int j = 0; j < 8; ++j) { const float u = a[j] * b[j]; o[j] = g[j] * (w0[j] * um2[j] + w1[j] * um1[j] + w2[j] * u); um2[j] = um1[j]; um1[j] = u; }
        u32x4 w; w.x = pk2(o[0], o[1]); w.y = pk2(o[2], o[3]); w.z = pk2(o[4], o[5]); w.w = pk2(o[6], o[7]);
        *(u32x4*)(Y + (size_t)(r0 + r) * 1024 + c0) = w;
    }
}
__device__ __forceinline__ s16x4 vtr(const LAS unsigned char* p) { typedef short v4i16_t __attribute__((ext_vector_type(4))); return __builtin_bit_cast(s16x4, __builtin_amdgcn_ds_read_tr16_b64_v4i16((LAS v4i16_t*)p)); }
__device__ __forceinline__ bf16x8 cat8(s16x4 a, s16x4 b) { bf16x8 r; r[0] = a[0]; r[1] = a[1]; r[2] = a[2]; r[3] = a[3]; r[4] = b[0]; r[5] = b[1]; r[6] = b[2]; r[7] = b[3]; return r; }
constexpr int AV_STRIDE = 144;
__device__ __forceinline__ void attn_unit(const bf16_t* PROJ, bf16_t* Y, int b, int h, int qb, LAS unsigned char* vlds, int lane) {
    const int r32 = lane & 31, hi = lane >> 5;
    const size_t rowbase = (size_t)b * SEQ;
    const int t0 = qb * 32;
    bf16x8 qf[4];
    { const bf16_t* qp = PROJ + (rowbase + t0 + r32) * 3072 + 1536 + h * 64 + 8 * hi;
#pragma unroll
      for (int kk = 0; kk < 4; ++kk) qf[kk] = *(const bf16x8*)(qp + 16 * kk); }
    f32x16 o0, o1;
#pragma unroll
    for (int i = 0; i < 16; ++i) { o0[i] = 0.f; o1[i] = 0.f; }
    float carry = 0.f;
    const int g4 = lane >> 4, li = lane & 15;
    const LAS unsigned char* trbase = vlds + (4 * (g4 >> 1) + (li >> 2)) * AV_STRIDE + (16 * (g4 & 1) + 4 * (li & 3)) * 2;
    bf16x8 kf[4]; u32x4 vr[4];
#define AT_LOAD(KF, VR, K0) do { const bf16_t* kp_ = PROJ + (rowbase + (K0) + r32) * 3072 + 2048 + h * 64 + 8 * hi; \
        _Pragma("unroll") for (int kk = 0; kk < 4; ++kk) KF[kk] = *(const bf16x8*)(kp_ + 16 * kk); \
        _Pragma("unroll") for (int j = 0; j < 4; ++j) VR[j] = *(const u32x4*)(PROJ + (rowbase + (K0) + (lane >> 3) + 8 * j) * 3072 + 2560 + h * 64 + 8 * (lane & 7)); } while (0)
    AT_LOAD(kf, vr, t0);
    for (int kt = qb; kt >= 0; --kt) {
#pragma unroll
        for (int j = 0; j < 4; ++j) *(LAS u32x4*)(vlds + ((lane >> 3) + 8 * j) * AV_STRIDE + 16 * (lane & 7)) = vr[j];
        bf16x8 kfn[4]; u32x4 vrn[4];
#pragma unroll
        for (int j = 0; j < 4; ++j) { kfn[j] = kf[j]; vrn[j] = vr[j]; }
        if (kt > 0) AT_LOAD(kfn, vrn, (kt - 1) * 32);
        f32x16 sc;
#pragma unroll
        for (int i = 0; i < 16; ++i) sc[i] = 0.f;
#pragma unroll
        for (int kk = 0; kk < 4; ++kk) sc = __builtin_amdgcn_mfma_f32_32x32x16_bf16(kf[kk], qf[kk], sc, 0, 0, 0);
        const bool diag = (kt == qb);
        float lk[16], lb[16];
#pragma unroll
        for (int r = 0; r < 16; ++r) {
            const float z = sc[r], az = __builtin_fabsf(z);
            const float L = __builtin_amdgcn_logf(1.0f + __builtin_amdgcn_exp2f(-az));
            float lbv = __builtin_fminf(z, 0.f) - L, lkv = lbv - z;
            if (diag) { const int key = (r & 3) + 8 * (r >> 2) + 4 * hi; if (!(key < r32)) { lkv = 0.f; lbv = -1.0e30f; } }
            lk[r] = lkv; lb[r] = lbv;
        }
        float gs[4], pg[4], T[4];
#pragma unroll
        for (int j = 0; j < 4; ++j) { gs[j] = (lk[4 * j] + lk[4 * j + 1]) + (lk[4 * j + 2] + lk[4 * j + 3]); pg[j] = __shfl_xor(gs[j], 32); T[j] = gs[j] + pg[j]; }
        float w[16];
        float suf = carry;
#pragma unroll
        for (int j = 3; j >= 0; --j) {
            float run = suf + (hi == 0 ? pg[j] : 0.f);
#pragma unroll
            for (int i = 3; i >= 0; --i) { w[4 * j + i] = __builtin_amdgcn_exp2f(lb[4 * j + i] + run); run += lk[4 * j + i]; }
            suf += T[j];
        }
        carry = suf;
        u32x4 p0, p1;
        p0.x = pk2(w[0], w[1]); p0.y = pk2(w[2], w[3]); p0.z = pk2(w[4], w[5]); p0.w = pk2(w[6], w[7]);
        p1.x = pk2(w[8], w[9]); p1.y = pk2(w[10], w[11]); p1.z = pk2(w[12], w[13]); p1.w = pk2(w[14], w[15]);
        const bf16x8 pf0 = __builtin_bit_cast(bf16x8, p0), pf1 = __builtin_bit_cast(bf16x8, p1);
        asm volatile("s_waitcnt lgkmcnt(0)" ::: "memory");
        const bf16x8 v00 = cat8(vtr(trbase), vtr(trbase + 8 * AV_STRIDE));
        const bf16x8 v01 = cat8(vtr(trbase + 16 * AV_STRIDE), vtr(trbase + 24 * AV_STRIDE));
        const bf16x8 v10 = cat8(vtr(trbase + 64), vtr(trbase + 8 * AV_STRIDE + 64));
        const bf16x8 v11 = cat8(vtr(trbase + 16 * AV_STRIDE + 64), vtr(trbase + 24 * AV_STRIDE + 64));
        o0 = __builtin_amdgcn_mfma_f32_32x32x16_bf16(v00, pf0, o0, 0, 0, 0);
        o0 = __builtin_amdgcn_mfma_f32_32x32x16_bf16(v01, pf1, o0, 0, 0, 0);
        o1 = __builtin_amdgcn_mfma_f32_32x32x16_bf16(v10, pf0, o1, 0, 0, 0);
        o1 = __builtin_amdgcn_mfma_f32_32x32x16_bf16(v11, pf1, o1, 0, 0, 0);
        if (__builtin_amdgcn_ballot_w64(carry > -160.0f) == 0ull) break;
#pragma unroll
        for (int j = 0; j < 4; ++j) { kf[j] = kfn[j]; vr[j] = vrn[j]; }
    }
#undef AT_LOAD
    bf16_t* yp = Y + (rowbase + t0 + r32) * 1024 + 512 + h * 64 + 4 * hi;
#pragma unroll
    for (int j = 0; j < 4; ++j) {
        u32x2 a; a.x = pk2(o0[4 * j], o0[4 * j + 1]); a.y = pk2(o0[4 * j + 2], o0[4 * j + 3]); *(u32x2*)(yp + 8 * j) = a;
        u32x2 c; c.x = pk2(o1[4 * j], o1[4 * j + 1]); c.y = pk2(o1[4 * j + 2], o1[4 * j + 3]); *(u32x2*)(yp + 32 + 8 * j) = c;
    }
}
__device__ __forceinline__ void mix0_phase(const Ptrs& P, LAS unsigned char* lds, int gw, int NGW, int wave, int lane) {
    const bf16_t* PROJ = (const bf16_t*)(P.ws + WS_PROJ); bf16_t* Y = (bf16_t*)(P.ws + WS_Y);
    LAS unsigned char* vlds = lds + wave * 8192;
#ifndef DBG_NO_ATTN
    for (int it = gw; it < BATCH * 8 * (SEQ / 32); it += NGW) { const int bh = it / (SEQ / 32), qb = it % (SEQ / 32); attn_unit(PROJ, Y, bh >> 3, bh & 7, qb, vlds, lane); }
#else
    for (int m = gw; m < M; m += NGW) { *(u32x4*)(Y + (size_t)m * 1024 + 512 + 8 * lane) = (u32x4){0u, 0u, 0u, 0u}; }
#endif
    for (int it = gw; it < M / 16; it += NGW) conv_item(PROJ, P.in[11], Y, it, lane);
}
constexpr int HS = 272;
constexpr int HL_QT = 0, HL_KT = 64 * HS, HL_KH = 2 * 64 * HS, HL_V = 3 * 64 * HS, HL_V2 = 4 * 64 * HS, HL_OUT = 4 * 64 * HS;
constexpr int HSC = 144;
constexpr int HL_SC = 5 * 64 * HS, HL_SEG = HL_SC + 64 * HSC, HL_DEC = HL_SEG + 8 * 128 * 4, HL_OSQ = HL_DEC + 512, HL_END = HL_OSQ + 64 * 8 * 4;
static_assert(HL_END <= 131072, "hgrn LDS map");
constexpr size_t WS_DTOT = 256 * 1024;
constexpr int HG_NCH = 16;
#define HG_BAR() do { asm volatile("s_waitcnt lgkmcnt(0)" ::: "memory"); __builtin_amdgcn_s_barrier(); asm volatile("" ::: "memory"); } while (0)
#define MFMA16(a, b, c) __builtin_amdgcn_mfma_f32_16x16x32_bf16((a), (b), (c), 0, 0, 0)
typedef float f32x2v __attribute__((ext_vector_type(2)));
template <bool FULL>
__device__ __forceinline__ void hgrn_unit(const Ptrs& P, LAS unsigned char* lds, int bh, int sc, int tid, int wave, int lane) {
    const bf16_t* Qs = (const bf16_t*)(P.ws + WS_QS); const float* LF = (const float*)(P.ws + WS_LF); const bf16_t* Iv = (const bf16_t*)(P.ws + WS_IV); const bf16_t* Gs = (const bf16_t*)(P.ws + WS_GS);
    bf16_t* Ob = (bf16_t*)P.out;
    float* SLOC = (float*)((unsigned char*)P.out + 64 * MiB);
    float* DTOT = (float*)(P.ws + WS_DTOT);
    const int b = bh >> 3, h = bh & 7, hc = h * 128;
    const int fr = lane & 15, fq = lane >> 4;
    const int kp = lane, seg = wave;
    f32x4 S[8];
    if (FULL && sc > 0) {
        const float* sp = SLOC + ((size_t)(bh * 4) << 14) + (16 * wave + fr) * 4;
        const float* dp = DTOT + (bh * 4) * 128 + 4 * fq;
#pragma unroll
        for (int kt = 0; kt < 8; ++kt) S[kt] = *(const f32x4*)(sp + (4 * kt + fq) * 512);
        for (int j = 1; j < sc; ++j) {
#pragma unroll
            for (int kt = 0; kt < 8; ++kt) S[kt] = S[kt] * *(const f32x4*)(dp + j * 128 + 16 * kt) + *(const f32x4*)(sp + ((size_t)j << 14) + (4 * kt + fq) * 512);
        }
    } else {
#pragma unroll
        for (int kt = 0; kt < 8; ++kt) S[kt] = (f32x4){0.f, 0.f, 0.f, 0.f};
    }
    LAS float* segtot = (LAS float*)(lds + HL_SEG); LAS float* dec = (LAS float*)(lds + HL_DEC); LAS float* osq = (LAS float*)(lds + HL_OSQ);
    f32x4 on0, on1;
    if (FULL) { const float* onp = P.in[15] + 8 * (tid & 15); on0 = *(const f32x4*)onp; on1 = *(const f32x4*)(onp + 4); }
    float dprod0 = 1.f, dprod1 = 1.f;
    f32x2v lf2[8]; unsigned q2[8]; u32x4 vch[2], gch[2];
    const size_t Rbase = (size_t)b * SEQ + (size_t)sc * (64 * HG_NCH);
#define HG_LOAD_E(R0_) do { _Pragma("unroll") for (int i = 0; i < 8; ++i) { const size_t off = ((R0_) + 8 * seg + i) * 1024 + hc + 2 * kp; lf2[i] = *(const f32x2v*)(LF + off); if (FULL) q2[i] = *(const unsigned*)(Qs + off); } \
        _Pragma("unroll") for (int j = 0; j < 2; ++j) { const int ch = tid + 512 * j; vch[j] = *(const u32x4*)(Iv + ((R0_) + (ch >> 4)) * 1024 + hc + 8 * (ch & 15)); } } while (0)
#define HG_LOAD_G(R0_) do { _Pragma("unroll") for (int j = 0; j < 2; ++j) { const int ch = tid + 512 * j; gch[j] = *(const u32x4*)(Gs + ((R0_) + (ch >> 4)) * 1024 + hc + 8 * (ch & 15)); } } while (0)
    HG_LOAD_E(Rbase);
    if (FULL) HG_LOAD_G(Rbase);
#pragma unroll 1
    for (int c = 0; c < HG_NCH; ++c) {
        const size_t R0 = Rbase + (size_t)c * 64;
        const int vimg = FULL ? HL_V : ((c & 1) ? HL_V2 : HL_V);
        f32x2v cs[8]; { f32x2v run = (f32x2v){0.f, 0.f};
#pragma unroll
          for (int i = 0; i < 8; ++i) { run += lf2[i]; cs[i] = run; } }
        *(LAS f32x2v*)(segtot + seg * 128 + 2 * kp) = cs[7];
#pragma unroll
        for (int j = 0; j < 2; ++j) { const int ch = tid + 512 * j; *(LAS u32x4*)(lds + vimg + (ch >> 4) * HS + 16 * (ch & 15)) = vch[j]; }
        HG_BAR();
        f32x2v pre = (f32x2v){0.f, 0.f}, tot = (f32x2v){0.f, 0.f};
#pragma unroll
        for (int s2 = 0; s2 < 8; ++s2) { const f32x2v v = *(const LAS f32x2v*)(segtot + s2 * 128 + 2 * kp); tot += v; if (s2 < seg) pre += v; }
        const float dl0 = __builtin_amdgcn_exp2f(tot[0]), dl1 = __builtin_amdgcn_exp2f(tot[1]);
        if (seg == 0) { *(LAS f32x2v*)(dec + 2 * kp) = (f32x2v){dl0, dl1}; dprod0 *= dl0; dprod1 *= dl1; }
#pragma unroll
        for (int i = 0; i < 8; ++i) {
            const float b0 = pre[0] + cs[i][0], b1 = pre[1] + cs[i][1];
            const float k0 = (1.0f - __builtin_amdgcn_exp2f(lf2[i][0])) * __builtin_amdgcn_exp2f(-b0), k1 = (1.0f - __builtin_amdgcn_exp2f(lf2[i][1])) * __builtin_amdgcn_exp2f(-b1);
            const int o = (8 * seg + i) * HS + 4 * kp;
            *(LAS unsigned*)(lds + HL_KH + o) = pk2(k0 * dl0, k1 * dl1);
            if (FULL) {
                *(LAS unsigned*)(lds + HL_KT + o) = pk2(k0, k1);
                *(LAS unsigned*)(lds + HL_QT + o) = pk2(pg8::bf_lo(q2[i]) * __builtin_amdgcn_exp2f(b0), pg8::bf_hi(q2[i]) * __builtin_amdgcn_exp2f(b1));
            }
        }
        if (c < HG_NCH - 1) HG_LOAD_E(R0 + 64);
        HG_BAR();
        f32x4 o[4];
        bf16x8 vf[2];
        if (FULL) {
            { const int tt = wave >> 1;
#pragma unroll
              for (int e = 0; e < 2; ++e) { const int st = 2 * (wave & 1) + e; const int t = 16 * tt + fr, s0 = 16 * st + 4 * fq;
                  u32x2 w = (u32x2){0u, 0u};
                  if (st <= tt) {
                      f32x4 a4 = (f32x4){0.f, 0.f, 0.f, 0.f};
#pragma unroll
                      for (int ks = 0; ks < 4; ++ks) {
                          const bf16x8 af = *(const LAS bf16x8*)(lds + HL_KT + (16 * st + fr) * HS + (32 * ks + 8 * fq) * 2);
                          const bf16x8 bfr = *(const LAS bf16x8*)(lds + HL_QT + (16 * tt + fr) * HS + (32 * ks + 8 * fq) * 2);
                          a4 = MFMA16(af, bfr, a4);
                      }
                      const float v0 = s0 + 0 <= t ? a4[0] : 0.f, v1 = s0 + 1 <= t ? a4[1] : 0.f, v2 = s0 + 2 <= t ? a4[2] : 0.f, v3 = s0 + 3 <= t ? a4[3] : 0.f;
                      w.x = pk2(v0, v1); w.y = pk2(v2, v3);
                  }
                  *(LAS u32x2*)(lds + HL_SC + t * HSC + s0 * 2) = w;
              } }
#pragma unroll
            for (int tt = 0; tt < 4; ++tt) o[tt] = (f32x4){0.f, 0.f, 0.f, 0.f};
#pragma unroll
            for (int ks = 0; ks < 4; ++ks) {
                u32x4 sb; sb.x = pk2(S[2 * ks][0], S[2 * ks][1]); sb.y = pk2(S[2 * ks][2], S[2 * ks][3]); sb.z = pk2(S[2 * ks + 1][0], S[2 * ks + 1][1]); sb.w = pk2(S[2 * ks + 1][2], S[2 * ks + 1][3]);
                const bf16x8 sfr = __builtin_bit_cast(bf16x8, sb);
#pragma unroll
                for (int tt = 0; tt < 4; ++tt) {
                    const LAS unsigned char* ap = lds + HL_QT + (16 * tt + fr) * HS + (32 * ks + 4 * fq) * 2;
                    const s16x4 a0 = *(const LAS s16x4*)ap, a1 = *(const LAS s16x4*)(ap + 32);
                    o[tt] = MFMA16(cat8(a0, a1), sfr, o[tt]);
                }
            }
        }
        { const LAS unsigned char* tb = lds + vimg + (8 * fq + (fr >> 2)) * HS + (16 * wave + 4 * (fr & 3)) * 2;
#pragma unroll
          for (int ss = 0; ss < 2; ++ss) vf[ss] = cat8(vtr(tb + (32 * ss) * HS), vtr(tb + (32 * ss + 4) * HS)); }
        f32x4 Sn[8];
#pragma unroll
        for (int kt = 0; kt < 8; ++kt) {
            const f32x4 d4 = *(const LAS f32x4*)(dec + 16 * kt + 4 * fq);
            f32x4 a4 = S[kt] * d4;
            const LAS unsigned char* tb = lds + HL_KH + (8 * fq + (fr >> 2)) * HS + (16 * kt + 4 * (fr & 3)) * 2;
#pragma unroll
            for (int ss = 0; ss < 2; ++ss) a4 = MFMA16(cat8(vtr(tb + (32 * ss) * HS), vtr(tb + (32 * ss + 4) * HS)), vf[ss], a4);
            Sn[kt] = a4;
        }
#pragma unroll
        for (int kt = 0; kt < 8; ++kt) S[kt] = Sn[kt];
        if (FULL) {
            HG_BAR();
#pragma unroll
            for (int ss = 0; ss < 2; ++ss)
#pragma unroll
                for (int tt = 0; tt < 4; ++tt) {
                    if (ss == 1 && tt < 2) continue;
                    const bf16x8 af = *(const LAS bf16x8*)(lds + HL_SC + (16 * tt + fr) * HSC + (32 * ss + 8 * fq) * 2);
                    o[tt] = MFMA16(af, vf[ss], o[tt]);
                }
#pragma unroll
            for (int tt = 0; tt < 4; ++tt)
#pragma unroll
                for (int r = 0; r < 4; ++r) { const int t = 16 * tt + 4 * fq + r; const float ov = o[tt][r]; float q = ov * ov;
                    *(LAS unsigned short*)(lds + HL_OUT + t * HS + (16 * wave + fr) * 2) = (unsigned short)f2bf(ov);
                    q += __shfl_xor(q, 1); q += __shfl_xor(q, 2); q += __shfl_xor(q, 4); q += __shfl_xor(q, 8);
                    if (fr == 0) osq[t * 8 + wave] = q; }
            HG_BAR();
#pragma unroll
            for (int j = 0; j < 2; ++j) { const int ch = tid + 512 * j, row = ch >> 4, c16 = ch & 15;
                const f32x4 qa = *(const LAS f32x4*)(osq + row * 8), qb = *(const LAS f32x4*)(osq + row * 8 + 4);
                const float rs = 1.0f / sqrtf((((qa[0] + qa[1]) + (qa[2] + qa[3])) + ((qb[0] + qb[1]) + (qb[2] + qb[3]))) * (1.0f / 128.0f) + 1e-6f);
                const u32x4 ow = *(const LAS u32x4*)(lds + HL_OUT + row * HS + 16 * c16);
                float ov[8], gv[8]; unpack8(ow, ov); unpack8(gch[j], gv);
                u32x4 w; w.x = pk2(ov[0] * rs * on0[0] * gv[0], ov[1] * rs * on0[1] * gv[1]); w.y = pk2(ov[2] * rs * on0[2] * gv[2], ov[3] * rs * on0[3] * gv[3]);
                w.z = pk2(ov[4] * rs * on1[0] * gv[4], ov[5] * rs * on1[1] * gv[5]); w.w = pk2(ov[6] * rs * on1[2] * gv[6], ov[7] * rs * on1[3] * gv[7]);
                *(u32x4*)(Ob + (R0 + row) * 1024 + hc + 8 * c16) = w; }
            if (c < HG_NCH - 1) HG_LOAD_G(R0 + 64);
        }
    }
    if (!FULL) {
        float* sp = SLOC + ((size_t)(bh * 4 + sc) << 14) + (16 * wave + fr) * 4;
#pragma unroll
        for (int kt = 0; kt < 8; ++kt) *(f32x4*)(sp + (4 * kt + fq) * 512) = S[kt];
        if (seg == 0) *(f32x2v*)(DTOT + (bh * 4 + sc) * 128 + 2 * kp) = (f32x2v){dprod0, dprod1};
    }
    HG_BAR();
#undef HG_LOAD_E
#undef HG_LOAD_G
}
__device__ __forceinline__ void hgrn_scan(const Ptrs& P, int gw, int NGW, int lane) {
    float* SLOC = (float*)((unsigned char*)P.out + 64 * MiB); const float* DTOT = (const float*)(P.ws + WS_DTOT);
    for (int it = gw; it < 64 * 64; it += NGW) {
        const int bh = it >> 6, e0 = (it & 63) * 256 + lane * 4, k0 = (e0 >> 9) * 4;
        f32x4 v[3], d[3];
#pragma unroll
        for (int s = 0; s < 3; ++s) { v[s] = *(const f32x4*)(SLOC + ((size_t)(bh * 4 + s) << 14) + e0); d[s] = *(const f32x4*)(DTOT + (bh * 4 + s) * 128 + k0); }
        f32x4 run = v[0];
#pragma unroll
        for (int s = 1; s < 3; ++s) { run = run * d[s] + v[s]; *(f32x4*)(SLOC + ((size_t)(bh * 4 + s) << 14) + e0) = run; }
    }
}
#ifndef MK_ONE_LAUNCH
#define MK_ONE_LAUNCH 1
#endif
#ifndef MK_XCD_BAR
#define MK_XCD_BAR 1
#endif
constexpr int N_PHASES = 18;
constexpr int FIN_LDS_OFF = 131072 + 4096;
constexpr int RS_TAB_OFF = 131072 + 1024;
struct Args { Ptrs p; int ph_lo, ph_hi; };
__global__ void __launch_bounds__(NTHREADS, 2) fwd_kernel(Args args) {
    extern __shared__ __attribute__((aligned(16))) unsigned char lds_raw[];
    LAS unsigned char* lds = (LAS unsigned char*)lds_raw;
    const Ptrs& P = args.p;
    const int tid = threadIdx.x, lane = tid & 63, wave = __builtin_amdgcn_readfirstlane(tid >> 6);
    const int G = gridDim.x, bx = blockIdx.x;
    const int vcu = (G % 8 == 0) ? (bx % 8) * (G / 8) + bx / 8 : bx;
    const int gw = vcu * NWAVES + wave, NGW = G * NWAVES;
    unsigned char* ws = P.ws;
    bf16_t* H = (bf16_t*)(ws + WS_H); bf16_t* HID = (bf16_t*)(ws + WS_HID); float* SS = (float*)(ws + WS_SS);
    const int lo = args.ph_lo, hi = args.ph_hi;
#if MK_XCD_BAR
    volatile LAS unsigned* MISC = (volatile LAS unsigned*)(lds + LDS_BYTES - 256);
    if (tid < 32) MISC[tid] = 0u;
#if MK_ONE_LAUNCH
    if (bx == 0) { unsigned* cw = (unsigned*)ws + 4096; for (int i = tid; i < 12288; i += NTHREADS) __hip_atomic_store(cw + i, 0u, __ATOMIC_RELAXED, __HIP_MEMORY_SCOPE_AGENT); }
    __syncthreads();
    XcdBarrier bar; bar.bar = (unsigned*)ws + 4096; bar.x = xb_xcc_id(); bar.st = MISC + 8;
#else
    __syncthreads();
    XcdBarrier bar = xcd_barrier_post((unsigned*)ws + 4096, MISC + 8);
#endif
#endif
#define IN(k) (lo <= (k) && (k) < hi)
#if MK_XCD_BAR
#define SEAM(k) do { if (IN(k) && IN((k) + 1)) { if ((k) == 0) { cg::this_grid().sync(); if (tid == 0) (void)xb_add(&bar.bar[XB_XCNT(bar.x)], 1u); } else xcd_barrier(bar); } } while (0)
#else
#define SEAM(k) do { if (IN(k) && IN((k) + 1)) { cg::this_grid().sync(); } } while (0)
#endif
#define SSB(i) (SS + (size_t)(i) * M * 16)
#define GEMM_GU(f, ssi) do { pg8::Gemm g{H, (const bf16_t*)(ws + WS_GU) + (size_t)(f) * 5632 * 1024, M, 5632, D}; pg8::StaticOrder S; S.init(M, 5632, G, bx); \
        pg8::EpiSwiGLU E{HID, pg8::rs_table_build(lds + RS_TAB_OFF, SSB(ssi), S, tid), FF}; pg8::gemm_phase<pg8::EpiSwiGLU, pg8::StaticOrder, true, true>(lds, g, S, E); } while (0)
#define GEMM_DN(f, sso) do { pg8::Gemm g{HID, (const bf16_t*)(ws + WS_DN) + (size_t)(f) * 1024 * 2816, M, D, FF}; pg8::StaticOrder S; S.init(M, D, G, bx); \
        pg8::EpiResid<false> E{H, SSB(sso), 0.5f, nullptr}; pg8::gemm_phase<pg8::EpiResid<false>, pg8::StaticOrder, true, true>(lds, g, S, E); } while (0)

    if (IN(0)) { p0_prologue(P, lds, gw, NGW, wave, lane); }
#ifdef PROBE_P0
    __syncthreads(); if (IN(0)) { p0_prologue(P, lds, gw, NGW, wave, lane); }
#endif
    SEAM(0);
#ifdef PROBE_EARLYBAR
    xcd_barrier(bar);
#endif
    if (IN(1)) { GEMM_GU(0, 0); }
#ifdef PROBE_LATE_WG
    if (bx == PROBE_LATE_WG) { for (int d_ = 0; d_ < 400; ++d_) __builtin_amdgcn_s_sleep(127); }
#endif
#ifdef PROBE_BAR10
#if PROBE_BAR10 == 2
    asm volatile("s_waitcnt vmcnt(0)" ::: "memory"); __syncthreads();
    if (tid == 0) { __builtin_amdgcn_fence(__ATOMIC_RELEASE, "agent"); asm volatile("s_waitcnt vmcnt(0)" ::: "memory"); __builtin_amdgcn_fence(__ATOMIC_ACQUIRE, "agent"); asm volatile("s_waitcnt vmcnt(0)" ::: "memory"); }
    __syncthreads();
#elif PROBE_BAR10 == 4
    cg::this_grid().sync();
#elif PROBE_BAR10 == 3
    asm volatile("s_waitcnt vmcnt(0)" ::: "memory"); __syncthreads(); __syncthreads();
#else
    for (int i_ = 0; i_ < PROBE_BAR10; ++i_) { xcd_barrier(bar); }
#endif
#endif
#ifdef PROBE_GU2X
    xcd_barrier(bar); if (IN(1)) { GEMM_GU(0, 0); }
#endif
    SEAM(1);
#ifdef PROBE_DN2X
    if (IN(2)) { pg8::Gemm g{HID, (const bf16_t*)(ws + WS_DN), M, D, FF}; pg8::StaticOrder S; S.init(M, D, G, bx);
        pg8::EpiResid<false> E{H, SSB(1), 0.0f, nullptr}; pg8::gemm_phase<pg8::EpiResid<false>, pg8::StaticOrder, true, true>(lds, g, S, E); }
    xcd_barrier(bar);
#endif
    if (IN(2)) { GEMM_DN(0, 1); }
    SEAM(2);
    if (IN(3)) { pg8::Gemm g{H, (const bf16_t*)(ws + WS_ABIN), M, 3072, D}; pg8::StaticOrder S; S.init(M, 3072, G, bx);
        pg8::EpiProjAB E{(bf16_t*)(ws + WS_PROJ), pg8::rs_table_build(lds + RS_TAB_OFF, SSB(1), S, tid), QSCALE}; pg8::gemm_phase<pg8::EpiProjAB, pg8::StaticOrder, true, true>(lds, g, S, E); }
    SEAM(3);
    if (IN(4)) { mix0_phase(P, lds, gw, NGW, wave, lane); }
#ifdef PROBE_P4
    if (IN(4)) { mix0_phase(P, lds, gw, NGW, wave, lane); }
#endif
    SEAM(4);
    if (IN(5)) { pg8::Gemm g{(const bf16_t*)(ws + WS_Y), (const bf16_t*)(ws + WS_ABOUT), M, D, D}; pg8::StaticOrder S; S.init(M, D, G, bx);
        pg8::EpiResid<false> E{H, SSB(2), 1.0f, nullptr}; pg8::gemm_phase<pg8::EpiResid<false>, pg8::StaticOrder, true, true>(lds, g, S, E); }
    SEAM(5);
#ifdef PROBE_BAR_AT5
    xcd_barrier(bar);
#endif
#ifdef PROBE_IDLE
    { const unsigned long long t0_ = __builtin_amdgcn_s_memrealtime(); while (__builtin_amdgcn_s_memrealtime() - t0_ < 100000ull) __builtin_amdgcn_s_sleep(64); }
#endif
    if (IN(6)) { GEMM_GU(1, 2); }
    SEAM(6);
#ifdef PROBE_BAR_AT6
    xcd_barrier(bar);
#endif
    if (IN(7)) { GEMM_DN(1, 3); }
    SEAM(7);
    if (IN(8)) { GEMM_GU(2, 3); }
    SEAM(8);
    if (IN(9)) { GEMM_DN(2, 4); }
    SEAM(9);
    if (IN(10)) { pg8::Gemm g{H, (const bf16_t*)(ws + WS_CIN), M, 4096, D}; pg8::StaticOrder S; S.init(M, 4096, G, bx);
        pg8::EpiProjC E{(bf16_t*)(ws + WS_QS), (float*)(ws + WS_LF), (bf16_t*)(ws + WS_IV), (bf16_t*)(ws + WS_GS), pg8::rs_table_build(lds + RS_TAB_OFF, SSB(4), S, tid), P.in[14]};
        pg8::gemm_phase<pg8::EpiProjC, pg8::StaticOrder, true, true>(lds, g, S, E); }
    SEAM(10);
    if (IN(11)) { const int bh = bx & 63, sc = bx >> 6; if (sc < 3) hgrn_unit<false>(P, lds, bh, sc, tid, wave, lane); }
    SEAM(11);
    if (IN(13)) { const int bh = bx & 63, sc = bx >> 6; if (sc < 4) hgrn_unit<true>(P, lds, bh, sc, tid, wave, lane); }
    SEAM(13);
    if (IN(14)) { pg8::Gemm g{(const bf16_t*)P.out, (const bf16_t*)(ws + WS_COUT), M, D, D}; pg8::StaticOrder S; S.init(M, D, G, bx);
        pg8::EpiResid<false> E{H, SSB(5), 1.0f, nullptr}; pg8::gemm_phase<pg8::EpiResid<false>, pg8::StaticOrder, true, true>(lds, g, S, E); }
    SEAM(14);
    if (IN(15)) { GEMM_GU(3, 5); }
    SEAM(15);
    if (IN(16)) { pg8::Gemm g{HID, (const bf16_t*)(ws + WS_DN) + (size_t)3 * 1024 * 2816, M, D, FF}; pg8::StaticOrder S; S.init(M, D, G, bx);
        pg8::EpiFinalNorm E{H, P.out, P.in[17], 0.5f, SSB(6), (unsigned*)ws + 8192, lds + FIN_LDS_OFF};
        pg8::gemm_phase<pg8::EpiFinalNorm, pg8::StaticOrder, true, true>(lds, g, S, E); }
    if (IN(18)) {
        for (int m = gw; m < M; m += NGW) { const u32x2* hr = (const u32x2*)(H + (size_t)m * D) + lane; f32x4* orow = (f32x4*)(P.out + (size_t)m * D) + lane;
#pragma unroll
            for (int j = 0; j < 4; ++j) { const u32x2 w = hr[64 * j]; orow[64 * j] = (f32x4){pg8::bf_lo(w.x), pg8::bf_hi(w.x), pg8::bf_lo(w.y), pg8::bf_hi(w.y)}; } }
    }
}

extern "C" void kernel_launch(void* const* d_in, const int* in_sizes, int n_in, void* d_out, int out_size, void* d_ws, size_t ws_size, hipStream_t stream) {
    static int grid = 0;
    if (grid == 0) {
        if (n_in != 18 || in_sizes[0] != M * D || out_size != M * D || ws_size < WS_END) { fprintf(stderr, "kernel_launch: unexpected shapes (n_in %d, in0 %d, out %d, ws %zu)\n", n_in, n_in > 0 ? in_sizes[0] : -1, out_size, ws_size); grid = -1; return; }
        int dev = 0, cus = 0, per_cu = 0;
        hipGetDevice(&dev); hipDeviceGetAttribute(&cus, hipDeviceAttributeMultiprocessorCount, dev);
        if (hipFuncSetAttribute((const void*)fwd_kernel, hipFuncAttributeMaxDynamicSharedMemorySize, LDS_BYTES) != hipSuccess) { fprintf(stderr, "kernel_launch: hipFuncSetAttribute failed\n"); grid = -1; return; }
        if (hipOccupancyMaxActiveBlocksPerMultiprocessor(&per_cu, (const void*)fwd_kernel, NTHREADS, LDS_BYTES) != hipSuccess || per_cu < 1) { fprintf(stderr, "kernel_launch: occupancy query gives %d\n", per_cu); per_cu = 1; }
        (void)hipGetLastError();
        grid = cus;
    }
    if (grid < 0) return;
    Args a{};
    for (int i = 0; i < 18; ++i) a.p.in[i] = (const float*)d_in[i];
    a.p.out = (float*)d_out; a.p.ws = (unsigned char*)d_ws;
#if MK_ONE_LAUNCH
    a.ph_lo = 0; a.ph_hi = N_PHASES;
    void* kargs[] = {&a};
    hipError_t e = hipLaunchCooperativeKernel((const void*)fwd_kernel, dim3(grid), dim3(NTHREADS), kargs, LDS_BYTES, stream);
    if (e != hipSuccess) fprintf(stderr, "kernel_launch: cooperative launch failed: %s (grid %d)\n", hipGetErrorString(e), grid);
#else
#ifdef DBG_STOP
    for (int ph = 0; ph <= DBG_STOP; ++ph) { a.ph_lo = ph; a.ph_hi = ph + 1; hipLaunchKernelGGL(fwd_kernel, dim3(grid), dim3(NTHREADS), LDS_BYTES, stream, a); }
    a.ph_lo = 18; a.ph_hi = 19; hipLaunchKernelGGL(fwd_kernel, dim3(grid), dim3(NTHREADS), LDS_BYTES, stream, a);
#else
    for (int ph = 0; ph < N_PHASES; ++ph) { a.ph_lo = ph; a.ph_hi = ph + 1; hipLaunchKernelGGL(fwd_kernel, dim3(grid), dim3(NTHREADS), LDS_BYTES, stream, a); }
#endif
#endif
}
```

```cpp
#include <hip/hip_runtime.h>
#include <hip/hip_cooperative_groups.h>
#include <cstdio>
#include <cstdint>
namespace cg = cooperative_groups;
#define MK_ONE_LAUNCH 1
namespace pg8 {
#define PG8_LAS __attribute__((address_space(3)))
typedef unsigned short bf16_t;
typedef short bf16x8 __attribute__((ext_vector_type(8)));
typedef float f32x4 __attribute__((ext_vector_type(4)));
typedef unsigned u32x4 __attribute__((ext_vector_type(4)));
constexpr int BM = 256, BK = 64, HALF = 128, HTB = HALF * BK * 2  , STAGE_BYTES = 8 * HTB, NXCD = 8, WGM = 8;

__host__ __device__ __forceinline__ int lds_byte(int r, int c) { const int st = (r >> 4) * 2 + (c >> 5), rr = r & 15, cc = c & 31, ob = rr * 64 + cc * 2; return st * 1024 + (ob ^ (((ob >> 9) & 1) << 5)); }
__host__ __device__ __forceinline__ void stage_rc(int b, int& R, int& C) { const int st = b / 1024, sb = b % 1024, swz = sb ^ (((sb >> 9) & 1) << 5); R = (st >> 1) * 16 + swz / 64; C = (st & 1) * 32 + (swz % 64) / 2; }
__host__ __device__ __forceinline__ int perm32(int rho) { const int n = rho >> 4, i = rho & 15; return 8 * (i >> 2) + 4 * n + (i & 3); }

struct Unit { int pm, pn; };
struct Gemm { const bf16_t* A; const bf16_t* Bt; int M, N, K; };

struct StaticOrder {
    int nM, nN, nwg, G, c;
    __host__ __device__ void init(int M, int N, int G_, int c_) { nM = M / BM; nN = N / BM; nwg = nM * nN; G = G_; c = c_; }
    __host__ __device__ bool next(int i, Unit& u) const {
        const long L = (long)i * G + c; if (L >= nwg) return false;
        int wgid = (int)L; { const int q = nwg / NXCD, r = nwg % NXCD, xcd = wgid % NXCD, off = wgid / NXCD; wgid = (xcd < r ? xcd * (q + 1) : r * (q + 1) + (xcd - r) * q) + off; }
        const int nig = WGM * nN, gid = wgid / nig, fm = gid * WGM, gsz = (nM - fm) < WGM ? (nM - fm) : WGM;
        u.pm = fm + ((wgid % nig) % gsz); u.pn = (wgid % nig) / gsz; return true;
    }
    __device__ __forceinline__ void a_ready(const Unit&) const {}
    __device__ __forceinline__ void done(const Unit&) const {}
};

__device__ __forceinline__ unsigned cvt_pk_bf16(float lo, float hi) { unsigned r; asm volatile("v_cvt_pk_bf16_f32 %0, %1, %2" : "=v"(r) : "v"(lo), "v"(hi)); return r; }
typedef float f32x2 __attribute__((ext_vector_type(2)));
__device__ __forceinline__ float row_rstd(const float* ss, int row) {
    const f32x4* p = (const f32x4*)(ss + (size_t)row * 16);
    const f32x4 a = p[0], b = p[1], c = p[2], d = p[3];
    const float s = ((a[0] + a[1]) + (a[2] + a[3])) + ((b[0] + b[1]) + (b[2] + b[3])) + ((c[0] + c[1]) + (c[2] + c[3])) + ((d[0] + d[1]) + (d[2] + d[3]));
    return __builtin_amdgcn_rsqf(s * (1.0f / 1024.0f) + 1e-6f);
}
struct RsTab { const PG8_LAS float* tab; int pmA, pmB; const float* ss; };
template <class Sched> __device__ __forceinline__ RsTab rs_table_build(PG8_LAS unsigned char* lds_tab, const float* ss, const Sched& S, int tid) {
    RsTab t; t.tab = (const PG8_LAS float*)lds_tab; t.pmA = -1; t.pmB = -1; t.ss = ss;
    Unit u; for (int i = 0; S.next(i, u); ++i) { if (t.pmA < 0) t.pmA = u.pm; else if (u.pm != t.pmA && t.pmB < 0) t.pmB = u.pm; }
    const int pm = tid < 256 ? t.pmA : t.pmB;
    if (pm >= 0) ((PG8_LAS float*)lds_tab)[tid] = row_rstd(ss, pm * BM + (tid & 255));
    __syncthreads();
    return t;
}
__device__ __forceinline__ float rs_lookup(const RsTab& t, const Unit& u, int r  ) {
    if (u.pm == t.pmA) return t.tab[r];
    if (u.pm == t.pmB) return t.tab[256 + r];
    return row_rstd(t.ss, u.pm * BM + r);
}
__device__ __forceinline__ float sigmoidf_(float x) { return __builtin_amdgcn_rcpf(1.0f + __builtin_amdgcn_exp2f(-1.4426950408889634f * x)); }
__device__ __forceinline__ float siluf_(float x) { return x * sigmoidf_(x); }
__device__ __forceinline__ float bf_lo(unsigned w) { return __uint_as_float(w << 16); }
__device__ __forceinline__ float bf_hi(unsigned w) { return __uint_as_float(w & 0xffff0000u); }

struct EpiSwiGLU {
    static constexpr bool PERM = true, AFTER_DRAIN = false;
    bf16_t* O; RsTab rt; int ldo;
    struct Pre {};
    __device__ __forceinline__ Pre pre(const Unit&, int, int) const { return Pre{}; }
    __device__ __forceinline__ void operator()(const f32x4 (&acc)[2][2][4][2], const Unit& u, int wr, int wc, int fr, int fq, const Pre&) const {
        const int row0 = u.pm * BM + wr * 64 + fr, col0 = u.pn * HALF + wc * 32 + 8 * fq;
#pragma unroll
        for (int ai = 0; ai < 2; ++ai)
#pragma unroll
            for (int m = 0; m < 4; ++m) {
                const int row = row0 + ai * HALF + m * 16; const float rs = rs_lookup(rt, u, ai * HALF + wr * 64 + m * 16 + fr), c1 = -1.4426950408889634f * rs, rs2 = rs * rs;
                float h[8];
#pragma unroll
                for (int n = 0; n < 2; ++n)
#pragma unroll
                    for (int i = 0; i < 4; ++i) { const float g = acc[ai][0][m][n][i], up = acc[ai][1][m][n][i];
                        h[4 * n + i] = (g * up) * (rs2 * __builtin_amdgcn_rcpf(1.0f + __builtin_amdgcn_exp2f(g * c1))); }
                u32x4 w; w.x = cvt_pk_bf16(h[0], h[1]); w.y = cvt_pk_bf16(h[2], h[3]); w.z = cvt_pk_bf16(h[4], h[5]); w.w = cvt_pk_bf16(h[6], h[7]);
                *(u32x4*)(O + (size_t)row * ldo + col0) = w;
            }
    }
};
template <bool F32OUT> struct EpiResid {
    static constexpr bool PERM = true, AFTER_DRAIN = false;
    bf16_t* H; float* ssout; float alpha; float* out32;
    struct Pre {};
    __device__ __forceinline__ Pre pre(const Unit&, int, int) const { return Pre{}; }
    __device__ __forceinline__ void operator()(const f32x4 (&acc)[2][2][4][2], const Unit& u, int wr, int wc, int fr, int fq, const Pre&) const {
        const int row0 = u.pm * BM + wr * 64 + fr, col0 = u.pn * BM + wc * 32 + 8 * fq;
#pragma unroll
        for (int ai = 0; ai < 2; ++ai) {
            u32x4 old[4][2];
#pragma unroll
            for (int m = 0; m < 4; ++m)
#pragma unroll
                for (int bj = 0; bj < 2; ++bj) old[m][bj] = *(const u32x4*)(H + (size_t)(row0 + ai * HALF + m * 16) * 1024 + col0 + bj * HALF);
#pragma unroll
            for (int m = 0; m < 4; ++m) {
                const int row = row0 + ai * HALF + m * 16; float sq = 0.f;
#pragma unroll
                for (int bj = 0; bj < 2; ++bj) {
                    bf16_t* hp = H + (size_t)row * 1024 + col0 + bj * HALF;
                    const u32x4 o4 = old[m][bj];
                    float v[8];
                    v[0] = bf_lo(o4.x); v[1] = bf_hi(o4.x); v[2] = bf_lo(o4.y); v[3] = bf_hi(o4.y); v[4] = bf_lo(o4.z); v[5] = bf_hi(o4.z); v[6] = bf_lo(o4.w); v[7] = bf_hi(o4.w);
#pragma unroll
                    for (int n = 0; n < 2; ++n)
#pragma unroll
                        for (int i = 0; i < 4; ++i) { v[4 * n + i] += alpha * acc[ai][bj][m][n][i]; sq += v[4 * n + i] * v[4 * n + i]; }
                    u32x4 w; w.x = cvt_pk_bf16(v[0], v[1]); w.y = cvt_pk_bf16(v[2], v[3]); w.z = cvt_pk_bf16(v[4], v[5]); w.w = cvt_pk_bf16(v[6], v[7]);
                    *(u32x4*)hp = w;
                    if (F32OUT) { float* op = out32 + (size_t)row * 1024 + col0 + bj * HALF; *(f32x4*)op = (f32x4){v[0], v[1], v[2], v[3]}; *(f32x4*)(op + 4) = (f32x4){v[4], v[5], v[6], v[7]}; }
                }
                sq += __shfl_xor(sq, 16); sq += __shfl_xor(sq, 32);
                if (fq == 0) ssout[(size_t)row * 16 + u.pn * 4 + wc] = sq;
            }
        }
    }
};
struct EpiFinalNorm {
    static constexpr bool PERM = false, AFTER_DRAIN = false;
    const bf16_t* H; float* out; const float* gain; float alpha;
    float* xslots;
    unsigned* cnt;
    PG8_LAS unsigned char* xl;
    struct Pre {};
    __device__ __forceinline__ Pre pre(const Unit&, int, int) const { return Pre{}; }
    __device__ __forceinline__ void operator()(f32x4 (&acc)[2][2][4][2], const Unit& u, int wr, int wc, int fr, int fq, const Pre&) const {
        const int tid = threadIdx.x, lane = tid & 63, wid = __builtin_amdgcn_readfirstlane(tid >> 6);
        PG8_LAS float* P = (PG8_LAS float*)xl; PG8_LAS float* S = (PG8_LAS float*)(xl + 4096);
        const int row0 = u.pm * BM + wr * 64 + fr, col0 = u.pn * BM + wc * 32 + 4 * fq;
        typedef unsigned u32x2_t __attribute__((ext_vector_type(2)));
#pragma unroll
        for (int ai = 0; ai < 2; ++ai)
#pragma unroll
            for (int m = 0; m < 4; ++m) {
                const int row = row0 + ai * HALF + m * 16; float sq = 0.f;
#pragma unroll
                for (int bj = 0; bj < 2; ++bj)
#pragma unroll
                    for (int n = 0; n < 2; ++n) {
                        const u32x2_t o = *(const u32x2_t*)(H + (size_t)row * 1024 + col0 + bj * HALF + n * 16);
                        f32x4 v = (f32x4){bf_lo(o.x), bf_hi(o.x), bf_lo(o.y), bf_hi(o.y)} + alpha * acc[ai][bj][m][n];
                        acc[ai][bj][m][n] = v; sq += (v[0] * v[0] + v[1] * v[1]) + (v[2] * v[2] + v[3] * v[3]);
                    }
                sq += __shfl_xor(sq, 16); sq += __shfl_xor(sq, 32);
                if (fq == 0) P[(ai * HALF + wr * 64 + m * 16 + fr) * 4 + wc] = sq;
            }
        asm volatile("s_waitcnt lgkmcnt(0)" ::: "memory"); __builtin_amdgcn_s_barrier(); asm volatile("" ::: "memory");
        if (tid < 256) { const f32x4 p = *(const PG8_LAS f32x4*)(P + tid * 4);
            __hip_atomic_store(xslots + ((size_t)u.pm * BM + tid) * 4 + u.pn, (p[0] + p[1]) + (p[2] + p[3]), __ATOMIC_RELAXED, __HIP_MEMORY_SCOPE_AGENT); }
        asm volatile("s_waitcnt vmcnt(0)" ::: "memory");
        if (tid < 256 && lane == 0) __hip_atomic_fetch_add(cnt + 64 * u.pm, 1u, __ATOMIC_RELAXED, __HIP_MEMORY_SCOPE_AGENT);
        if (wid == 0) {
            unsigned sp = 0;
            while ((unsigned)__builtin_amdgcn_readfirstlane(__hip_atomic_load(cnt + 64 * u.pm, __ATOMIC_RELAXED, __HIP_MEMORY_SCOPE_AGENT)) < 16u) { __builtin_amdgcn_s_sleep(2); if (++sp > (1u << 18)) break; }
            __builtin_amdgcn_fence(__ATOMIC_ACQUIRE, "agent");
        }
        asm volatile("s_waitcnt vmcnt(0) lgkmcnt(0)" ::: "memory"); __builtin_amdgcn_s_barrier(); asm volatile("" ::: "memory");
        if (tid < 256) { const float* sl = xslots + ((size_t)u.pm * BM + tid) * 4;
            const float t = (__hip_atomic_load(sl, __ATOMIC_RELAXED, __HIP_MEMORY_SCOPE_AGENT) + __hip_atomic_load(sl + 1, __ATOMIC_RELAXED, __HIP_MEMORY_SCOPE_AGENT))
                          + (__hip_atomic_load(sl + 2, __ATOMIC_RELAXED, __HIP_MEMORY_SCOPE_AGENT) + __hip_atomic_load(sl + 3, __ATOMIC_RELAXED, __HIP_MEMORY_SCOPE_AGENT));
            S[tid] = __builtin_amdgcn_rsqf(t * (1.0f / 1024.0f) + 1e-6f); }
        asm volatile("s_waitcnt lgkmcnt(0)" ::: "memory"); __builtin_amdgcn_s_barrier(); asm volatile("" ::: "memory");
        f32x4 gv[2][2];
#pragma unroll
        for (int bj = 0; bj < 2; ++bj)
#pragma unroll
            for (int n = 0; n < 2; ++n) gv[bj][n] = *(const f32x4*)(gain + col0 + bj * HALF + n * 16);
#pragma unroll
        for (int ai = 0; ai < 2; ++ai)
#pragma unroll
            for (int m = 0; m < 4; ++m) {
                const int r = ai * HALF + wr * 64 + m * 16 + fr; const float rs = S[r];
                float* op = out + (size_t)(u.pm * BM + r) * 1024 + col0;
#pragma unroll
                for (int bj = 0; bj < 2; ++bj)
#pragma unroll
                    for (int n = 0; n < 2; ++n) __builtin_nontemporal_store(acc[ai][bj][m][n] * rs * gv[bj][n], (f32x4*)(op + bj * HALF + n * 16));
            }
    }
};
struct EpiProjAB {
    static constexpr bool PERM = true, AFTER_DRAIN = false;
    bf16_t* O; RsTab rt; float qscale;
    struct Pre {};
    __device__ __forceinline__ Pre pre(const Unit&, int, int) const { return Pre{}; }
    __device__ __forceinline__ void operator()(const f32x4 (&acc)[2][2][4][2], const Unit& u, int wr, int wc, int fr, int fq, const Pre&) const {
        const int row0 = u.pm * BM + wr * 64 + fr, col0 = u.pn * BM + wc * 32 + 8 * fq;
        const float sc = (u.pn == 6 || u.pn == 7) ? qscale : 1.0f;
#pragma unroll
        for (int ai = 0; ai < 2; ++ai)
#pragma unroll
            for (int m = 0; m < 4; ++m) {
                const int row = row0 + ai * HALF + m * 16; const float rs = rs_lookup(rt, u, ai * HALF + wr * 64 + m * 16 + fr) * sc;
#pragma unroll
                for (int bj = 0; bj < 2; ++bj) {
                    const f32x4 a = acc[ai][bj][m][0] * rs, b = acc[ai][bj][m][1] * rs;
                    u32x4 w; w.x = cvt_pk_bf16(a[0], a[1]); w.y = cvt_pk_bf16(a[2], a[3]); w.z = cvt_pk_bf16(b[0], b[1]); w.w = cvt_pk_bf16(b[2], b[3]);
                    *(u32x4*)(O + (size_t)row * 3072 + col0 + bj * HALF) = w;
                }
            }
    }
};
struct EpiProjC {
    static constexpr bool PERM = true, AFTER_DRAIN = false;
    bf16_t* Qs; float* LF; bf16_t* Iv; bf16_t* Gs; RsTab rt; const float* clb;
    struct Pre {};
    __device__ __forceinline__ Pre pre(const Unit&, int, int) const { return Pre{}; }
    __device__ __forceinline__ void operator()(const f32x4 (&acc)[2][2][4][2], const Unit& u, int wr, int wc, int fr, int fq, const Pre&) const {
        const int kind = u.pn >> 2;
        const int row0 = u.pm * BM + wr * 64 + fr, col0 = (u.pn & 3) * BM + wc * 32 + 8 * fq;
        if (kind == 1) {
            float lb[2][8];
#pragma unroll
            for (int bj = 0; bj < 2; ++bj)
#pragma unroll
                for (int j = 0; j < 8; ++j) { const int c = col0 + bj * HALF + j; lb[bj][j] = sigmoidf_(clb[1024 + c] - clb[c]); }
#pragma unroll
            for (int ai = 0; ai < 2; ++ai)
#pragma unroll
                for (int m = 0; m < 4; ++m) {
                    const int row = row0 + ai * HALF + m * 16; const float rs = rs_lookup(rt, u, ai * HALF + wr * 64 + m * 16 + fr);
#pragma unroll
                    for (int bj = 0; bj < 2; ++bj) {
                        float v[8];
#pragma unroll
                        for (int n = 0; n < 2; ++n)
#pragma unroll
                            for (int i = 0; i < 4; ++i) { const float x = acc[ai][bj][m][n][i] * rs, l = lb[bj][4 * n + i]; v[4 * n + i] = __builtin_amdgcn_logf(l + (1.0f - l) * sigmoidf_(x)); }
                        float* op = LF + (size_t)row * 1024 + col0 + bj * HALF; *(f32x4*)op = (f32x4){v[0], v[1], v[2], v[3]}; *(f32x4*)(op + 4) = (f32x4){v[4], v[5], v[6], v[7]};
                    }
                }
        } else {
            bf16_t* O = Qs + (kind ? ((size_t)(64 + 64 * kind) << 19) : (size_t)0);
            const bool act = kind != 2;
#pragma unroll
            for (int ai = 0; ai < 2; ++ai)
#pragma unroll
                for (int m = 0; m < 4; ++m) {
                    const int row = row0 + ai * HALF + m * 16; const float rs = rs_lookup(rt, u, ai * HALF + wr * 64 + m * 16 + fr);
#pragma unroll
                    for (int bj = 0; bj < 2; ++bj) {
                        float v[8];
#pragma unroll
                        for (int n = 0; n < 2; ++n)
#pragma unroll
                            for (int i = 0; i < 4; ++i) { const float x = acc[ai][bj][m][n][i] * rs; v[4 * n + i] = act ? siluf_(x) : x; }
                        u32x4 w; w.x = cvt_pk_bf16(v[0], v[1]); w.y = cvt_pk_bf16(v[2], v[3]); w.z = cvt_pk_bf16(v[4], v[5]); w.w = cvt_pk_bf16(v[6], v[7]);
                        *(u32x4*)(O + (size_t)row * 1024 + col0 + bj * HALF) = w;
                    }
                }
        }
    }
};
template <class Epi, class Sched, bool ALIGN_EPI = false, bool SP2 = false>
__device__ __forceinline__ void gemm_phase(PG8_LAS unsigned char* lds, const Gemm g, const Sched& S, const Epi& E) {
    const int tid = threadIdx.x, wid = __builtin_amdgcn_readfirstlane(tid >> 6), lane = tid & 63, wr = wid >> 2, wc = wid & 3, fr = lane & 15, fq = lane >> 4;
    const int K = g.K, nt = K / BK;
    unsigned voffA[2], voffB[2];
#pragma unroll
    for (int i = 0; i < 2; ++i) { int R, C; stage_rc(tid * 16 + i * 8192, R, C); const int Rb = Epi::PERM ? ((R & ~31) + perm32(R & 31)) : R;
        voffA[i] = (unsigned)(R * K + C) * 2u; voffB[i] = (unsigned)(Rb * K + C) * 2u; }
    const size_t kstep = (size_t)(BK * 2);
    const size_t hstep = (size_t)HALF * K * 2;
    const size_t tstep = 2 * hstep;
    const unsigned ldsw = (unsigned)wid * 1024u;
    const int aoff = lds_byte(wr * 64 + fr, fq * 8), boff = lds_byte(wc * 32 + fr, fq * 8);
#define PG8_SA(b, h) (((b) * 2 + (h)) * HTB)
#define PG8_SB(b, h) ((4 + (b) * 2 + (h)) * HTB)
#define PG8_STAGE(bufoff, gbase, voff) do { _Pragma("unroll") for (int _i = 0; _i < 2; ++_i) \
        __builtin_amdgcn_global_load_lds((const unsigned*)((const char*)(gbase) + (voff)[_i]), (PG8_LAS unsigned*)(lds + (bufoff) + ldsw + _i * 8192), 16, 0, 0); } while (0)
#define PG8_LDA(dst, b, h) do { _Pragma("unroll") for (int m = 0; m < 4; ++m) _Pragma("unroll") for (int k = 0; k < 2; ++k) dst[m][k] = *(const PG8_LAS bf16x8*)(lds + PG8_SA(b, h) + aoff + m * 2048 + k * 1024); } while (0)
#define PG8_LDB(dst, b, h) do { _Pragma("unroll") for (int n = 0; n < 2; ++n) _Pragma("unroll") for (int k = 0; k < 2; ++k) dst[n][k] = *(const PG8_LAS bf16x8*)(lds + PG8_SB(b, h) + boff + n * 2048 + k * 1024); } while (0)
#define PG8_MMA(ai, bj, At, Bt) do { __builtin_amdgcn_s_setprio(1); _Pragma("unroll") for (int m = 0; m < 4; ++m) _Pragma("unroll") for (int n = 0; n < 2; ++n) _Pragma("unroll") for (int k = 0; k < 2; ++k) \
        acc[ai][bj][m][n] = __builtin_amdgcn_mfma_f32_16x16x32_bf16(Bt[n][k], At[m][k], acc[ai][bj][m][n], 0, 0, 0); __builtin_amdgcn_s_setprio(0); } while (0)
#define PG8_WAIT_V(n) asm volatile("s_waitcnt vmcnt(" #n ")" ::: "memory")
#define PG8_WAIT_L(n) asm volatile("s_waitcnt lgkmcnt(" #n ")" ::: "memory")
#define PG8_BAR __builtin_amdgcn_s_barrier()
#define PG8_SCHED __builtin_amdgcn_sched_barrier(0)
    Unit cur, nxt; int ui = 0;
    if (!S.next(0, cur)) return;
    f32x4 acc[2][2][4][2];
#pragma unroll
    for (int a = 0; a < 2; ++a)
#pragma unroll
        for (int b = 0; b < 2; ++b)
#pragma unroll
            for (int m = 0; m < 4; ++m)
#pragma unroll
                for (int n = 0; n < 2; ++n) acc[a][b][m][n] = (f32x4){0.f, 0.f, 0.f, 0.f};
    bf16x8 At[4][2], B0[2][2], B1[2][2];
    const char* cA = (const char*)g.A + (size_t)cur.pm * tstep; const char* cB = (const char*)g.Bt + (size_t)cur.pn * tstep;
    S.a_ready(cur);
    if constexpr (SP2) {
        PG8_STAGE(PG8_SB(0, 0), cB, voffB); PG8_STAGE(PG8_SB(0, 1), cB + hstep, voffB); PG8_STAGE(PG8_SA(0, 0), cA, voffA); PG8_STAGE(PG8_SA(0, 1), cA + hstep, voffA);
        if (wr == 1) PG8_BAR;
        PG8_WAIT_V(2); PG8_BAR;
        PG8_STAGE(PG8_SB(1, 0), cB + kstep, voffB); PG8_STAGE(PG8_SA(1, 0), cA + kstep, voffA); PG8_STAGE(PG8_SB(1, 1), cB + hstep + kstep, voffB);
        PG8_WAIT_V(6); PG8_BAR;
    } else {
        PG8_STAGE(PG8_SB(0, 0), cB, voffB); PG8_STAGE(PG8_SA(0, 0), cA, voffA); PG8_STAGE(PG8_SB(0, 1), cB + hstep, voffB); PG8_STAGE(PG8_SA(0, 1), cA + hstep, voffA);
        if (wr == 1) PG8_BAR;
        PG8_WAIT_V(4); PG8_BAR;
        PG8_STAGE(PG8_SB(1, 0), cB + kstep, voffB); PG8_STAGE(PG8_SA(1, 0), cA + kstep, voffA); PG8_STAGE(PG8_SB(1, 1), cB + hstep + kstep, voffB);
        PG8_WAIT_V(6); PG8_BAR;
    }
    for (;;) {
        const bool has_next = S.next(ui + 1, nxt);
        const char* nA = has_next ? (const char*)g.A + (size_t)nxt.pm * tstep : cA; const char* nB = has_next ? (const char*)g.Bt + (size_t)nxt.pn * tstep : cB;
        for (int t = 0; t < nt; t += 2) {
            const bool last = (t == nt - 2);
            const char* a1 = cA + (size_t)(t + 1) * kstep;
            const char* a2 = last ? nA : cA + (size_t)(t + 2) * kstep; const char* b2 = last ? nB : cB + (size_t)(t + 2) * kstep;
            const char* a3 = a2 + kstep; const char* b3 = b2 + kstep;
            if (last && has_next) S.a_ready(nxt);
            if constexpr (SP2) {
            PG8_LDB(B0, 0, 0); PG8_LDB(B1, 0, 1); PG8_SCHED; PG8_LDA(At, 0, 0); PG8_STAGE(PG8_SA(1, 1), a1 + hstep, voffA);
            PG8_WAIT_V(8); PG8_WAIT_L(0); PG8_BAR; PG8_MMA(0, 0, At, B0); PG8_MMA(0, 1, At, B1); PG8_BAR; PG8_SCHED;
            PG8_LDA(At, 0, 1); PG8_STAGE(PG8_SB(0, 0), b2, voffB); PG8_STAGE(PG8_SB(0, 1), b2 + hstep, voffB); PG8_STAGE(PG8_SA(0, 0), a2, voffA);
            PG8_WAIT_V(8); PG8_WAIT_L(0); PG8_BAR; PG8_MMA(1, 0, At, B0); PG8_MMA(1, 1, At, B1); PG8_BAR; PG8_SCHED;
            PG8_LDB(B0, 1, 0); PG8_LDB(B1, 1, 1); PG8_SCHED; PG8_LDA(At, 1, 0); PG8_STAGE(PG8_SA(0, 1), a2 + hstep, voffA);
            PG8_WAIT_V(8); PG8_WAIT_L(0); PG8_BAR; PG8_MMA(0, 0, At, B0); PG8_MMA(0, 1, At, B1); PG8_BAR; PG8_SCHED;
            PG8_LDA(At, 1, 1); PG8_STAGE(PG8_SB(1, 0), b3, voffB); PG8_STAGE(PG8_SB(1, 1), b3 + hstep, voffB); PG8_STAGE(PG8_SA(1, 0), a3, voffA);
            PG8_WAIT_V(8); PG8_WAIT_L(0); PG8_BAR; PG8_MMA(1, 0, At, B0); PG8_MMA(1, 1, At, B1); PG8_BAR; PG8_SCHED;
            } else {
            PG8_LDB(B0, 0, 0); PG8_SCHED; PG8_LDA(At, 0, 0); PG8_STAGE(PG8_SA(1, 1), a1 + hstep, voffA);
            PG8_WAIT_L(8); PG8_BAR; PG8_WAIT_L(0); PG8_MMA(0, 0, At, B0); PG8_BAR; PG8_SCHED;
            PG8_LDB(B1, 0, 1); PG8_STAGE(PG8_SB(0, 0), b2, voffB);
            PG8_BAR; PG8_WAIT_L(0); PG8_MMA(0, 1, At, B1); PG8_BAR;
            PG8_LDA(At, 0, 1); PG8_STAGE(PG8_SA(0, 0), a2, voffA);
            PG8_BAR; PG8_WAIT_L(0); PG8_MMA(1, 0, At, B0); PG8_BAR; PG8_SCHED;
            PG8_STAGE(PG8_SB(0, 1), b2 + hstep, voffB);
            PG8_WAIT_V(6); PG8_BAR; PG8_MMA(1, 1, At, B1); PG8_BAR;
            PG8_LDB(B0, 1, 0); PG8_SCHED; PG8_LDA(At, 1, 0); PG8_STAGE(PG8_SA(0, 1), a2 + hstep, voffA);
            PG8_WAIT_L(8); PG8_BAR; PG8_WAIT_L(0); PG8_MMA(0, 0, At, B0); PG8_BAR; PG8_SCHED;
            PG8_LDB(B1, 1, 1); PG8_STAGE(PG8_SB(1, 0), b3, voffB);
            PG8_BAR; PG8_WAIT_L(0); PG8_MMA(0, 1, At, B1); PG8_BAR;
            PG8_LDA(At, 1, 1); PG8_STAGE(PG8_SA(1, 0), a3, voffA);
            PG8_BAR; PG8_WAIT_L(0); PG8_MMA(1, 0, At, B0); PG8_BAR; PG8_SCHED;
            PG8_STAGE(PG8_SB(1, 1), b3 + hstep, voffB);
            PG8_WAIT_V(6); PG8_BAR; PG8_MMA(1, 1, At, B1); PG8_BAR;
            }
        }
        if constexpr (ALIGN_EPI) { if (wr == 0) PG8_BAR; }
        if constexpr (!Epi::AFTER_DRAIN) { E(acc, cur, wr, wc, fr, fq, E.pre(cur, wr, lane)); S.done(cur); }
        if (!has_next) break;
#pragma unroll
        for (int a = 0; a < 2; ++a)
#pragma unroll
            for (int b = 0; b < 2; ++b)
#pragma unroll
                for (int m = 0; m < 4; ++m)
#pragma unroll
                    for (int n = 0; n < 2; ++n) acc[a][b][m][n] = (f32x4){0.f, 0.f, 0.f, 0.f};
        cur = nxt; cA = nA; cB = nB; ++ui;
        if constexpr (ALIGN_EPI) { if (wr == 1) PG8_BAR; }
    }
    PG8_WAIT_V(0);
    if constexpr (!ALIGN_EPI) { if (wr == 0) PG8_BAR; }
    PG8_BAR;
    if constexpr (Epi::AFTER_DRAIN) { E.fused(acc, cur, wr, wc, fr, fq, lds, wid, lane); S.done(cur); }
#undef PG8_SA
#undef PG8_SB
#undef PG8_STAGE
#undef PG8_LDA
#undef PG8_LDB
#undef PG8_MMA
#undef PG8_WAIT_V
#undef PG8_WAIT_L
#undef PG8_BAR
#undef PG8_SCHED
}
}
using pg8::bf16_t; using pg8::bf16x8; using pg8::f32x4; using pg8::u32x4;
typedef float f32x16 __attribute__((ext_vector_type(16)));
typedef short s16x4 __attribute__((ext_vector_type(4)));
typedef unsigned u32x2 __attribute__((ext_vector_type(2)));
#define LAS __attribute__((address_space(3)))
constexpr int NWAVES = 8, NTHREADS = 512;
constexpr int BATCH = 8, SEQ = 4096, D = 1024, FF = 2816, M = BATCH * SEQ;
constexpr float QSCALE = 0.125f * 1.4426950408889634f;
constexpr size_t MiB = 1u << 20;
constexpr size_t WS_GU = 1 * MiB;
constexpr size_t WS_DN = WS_GU + 44 * MiB;
constexpr size_t WS_ABIN = WS_DN + 22 * MiB;
constexpr size_t WS_ABOUT = WS_ABIN + 6 * MiB;
constexpr size_t WS_CIN = WS_ABOUT + 2 * MiB;
constexpr size_t WS_COUT = WS_CIN + 8 * MiB;
constexpr size_t WS_H = WS_COUT + 2 * MiB;
constexpr size_t WS_SS = WS_H + 64 * MiB;
constexpr size_t WS_R = WS_SS + 14 * MiB;
constexpr size_t WS_HID = WS_R, WS_PROJ = WS_R, WS_Y = WS_R + 192 * MiB;
constexpr size_t WS_QS = WS_R, WS_LF = WS_R + 64 * MiB, WS_IV = WS_R + 192 * MiB, WS_GS = WS_R + 256 * MiB;
constexpr size_t WS_END = WS_R + 320 * MiB;
static_assert(WS_END <= 512 * MiB, "workspace map");
constexpr int LDS_BYTES = 147456;

__device__ __forceinline__ unsigned f2bf(float f) { unsigned u = __builtin_bit_cast(unsigned, f); return (u + 0x7fffu + ((u >> 16) & 1u)) >> 16; }
__device__ __forceinline__ unsigned pk2(float lo, float hi) { return pg8::cvt_pk_bf16(lo, hi); }
__device__ __forceinline__ float wave_sum(float v) {
#pragma unroll
    for (int o = 1; o < 64; o <<= 1) v += __shfl_xor(v, o);
    return v;
}
constexpr int P0_SCR = 64 * 65 * 4;
__device__ __forceinline__ void p0_transpose_item(const float* W, int K, int N, const float* gain, bf16_t* WT, int k0, int n0, int orow0, LAS float* scr, int lane) {
    const int lr = lane >> 4, lc = (lane & 15) * 4;
    f32x4 v[16];
#pragma unroll
    for (int j = 0; j < 16; ++j) v[j] = __builtin_nontemporal_load((const f32x4*)(W + (size_t)(k0 + 4 * j + lr) * N + n0 + lc));
    if (gain) {
#pragma unroll
        for (int j = 0; j < 16; ++j) v[j] = v[j] * gain[k0 + 4 * j + lr];
    }
#pragma unroll
    for (int j = 0; j < 16; ++j) { LAS float* d = scr + (4 * j + lr) * 65 + lc; d[0] = v[j][0]; d[1] = v[j][1]; d[2] = v[j][2]; d[3] = v[j][3]; }
    asm volatile("s_waitcnt lgkmcnt(0)" ::: "memory");
    const int c = lane & 7;
#pragma unroll
    for (int j = 0; j < 8; ++j) { const int n = (lane >> 3) + 8 * j; const LAS float* s = scr + (8 * c) * 65 + n;
        u32x4 o; o.x = pk2(s[0 * 65], s[1 * 65]); o.y = pk2(s[2 * 65], s[3 * 65]); o.z = pk2(s[4 * 65], s[5 * 65]); o.w = pk2(s[6 * 65], s[7 * 65]);
        *(u32x4*)(WT + (size_t)(orow0 + n) * K + k0 + 8 * c) = o; }
    asm volatile("s_waitcnt lgkmcnt(0)" ::: "memory");
}
struct Ptrs {
    const float* in[18]; float* out; unsigned char* ws;
};
__device__ __forceinline__ void p0_prologue(const Ptrs& P, LAS unsigned char* lds, int gw, int NGW, int wave, int lane) {
    unsigned char* ws = P.ws;
    const float* x = P.in[0]; bf16_t* H = (bf16_t*)(ws + WS_H); float* ss0 = (float*)(ws + WS_SS);
    for (int m0 = gw * 4; m0 < M; m0 += NGW * 4) {
        f32x4 v[4][4];
#pragma unroll
        for (int r = 0; r < 4; ++r)
#pragma unroll
            for (int j = 0; j < 4; ++j) v[r][j] = __builtin_nontemporal_load((const f32x4*)(x + (size_t)(m0 + r) * D) + lane + 64 * j);
#pragma unroll
        for (int r = 0; r < 4; ++r) {
            float s = 0.f;
#pragma unroll
            for (int j = 0; j < 4; ++j) s += (v[r][j][0] * v[r][j][0] + v[r][j][1] * v[r][j][1]) + (v[r][j][2] * v[r][j][2] + v[r][j][3] * v[r][j][3]);
            s = wave_sum(s);
            u32x2* o8 = (u32x2*)(H + (size_t)(m0 + r) * D) + lane;
#pragma unroll
            for (int j = 0; j < 4; ++j) { u32x2 w; w.x = pk2(v[r][j][0], v[r][j][1]); w.y = pk2(v[r][j][2], v[r][j][3]); o8[64 * j] = w; }
            if (lane < 16) ss0[(size_t)(m0 + r) * 16 + lane] = lane == 0 ? s : 0.f;
        }
    }
    LAS float* scr = (LAS float*)(lds + wave * P0_SCR);
    constexpr int I_FFN = 704;
    constexpr int I_ABIN = 16 * 48, I_ABOUT = 16 * 16, I_CIN = 16 * 64, I_COUT = 16 * 16;
    constexpr int NITEMS = 12 * I_FFN + I_ABIN + I_ABOUT + I_CIN + I_COUT;
    for (int it = gw; it < NITEMS; it += NGW) {
        int r = it;
        if (r < 12 * I_FFN) {
            const int mat = r / I_FFN, item = r % I_FFN, f = mat / 3, type = mat % 3;
            const int layer = f >> 1, post = f & 1;
            if (type < 2) {
                const float* Wg = post ? P.in[7] : P.in[2]; const float* Wu = post ? P.in[8] : P.in[3]; const float* W = (type == 0 ? Wg : Wu) + (size_t)layer * D * FF;
                const float* gain = (post ? P.in[6] : P.in[1]) + layer * D;
                const int nblk = FF / 64, kb = item / nblk, nb = item % nblk, n0 = 64 * nb;
                const int orow0 = (n0 >> 7) * 256 + (n0 & 127) + (type == 1 ? 128 : 0);
                p0_transpose_item(W, D, FF, gain, (bf16_t*)(ws + WS_GU) + (size_t)f * 5632 * 1024, 64 * kb, n0, orow0, scr, lane);
            } else {
                const float* W = (post ? P.in[9] : P.in[4]) + (size_t)layer * FF * D;
                const int nblk = D / 64, kb = item / nblk, nb = item % nblk, n0 = 64 * nb;
                p0_transpose_item(W, FF, D, nullptr, (bf16_t*)(ws + WS_DN) + (size_t)f * 1024 * 2816, 64 * kb, n0, n0, scr, lane);
            }
            continue;
        }
        r -= 12 * I_FFN;
        if (r < I_ABIN) { const int nblk = 48, kb = r / nblk, nb = r % nblk; p0_transpose_item(P.in[10], D, 3072, P.in[5], (bf16_t*)(ws + WS_ABIN), 64 * kb, 64 * nb, 64 * nb, scr, lane); continue; }
        r -= I_ABIN;
        if (r < I_ABOUT) { const int nblk = 16, kb = r / nblk, nb = r % nblk; p0_transpose_item(P.in[12], D, D, nullptr, (bf16_t*)(ws + WS_ABOUT), 64 * kb, 64 * nb, 64 * nb, scr, lane); continue; }
        r -= I_ABOUT;
        if (r < I_CIN) { const int nblk = 64, kb = r / nblk, nb = r % nblk; p0_transpose_item(P.in[13], D, 4096, P.in[5] + D, (bf16_t*)(ws + WS_CIN), 64 * kb, 64 * nb, 64 * nb, scr, lane); continue; }
        r -= I_CIN;
        { const int nblk = 16, kb = r / nblk, nb = r % nblk; p0_transpose_item(P.in[16], D, D, nullptr, (bf16_t*)(ws + WS_COUT), 64 * kb, 64 * nb, 64 * nb, scr, lane); }
    }
}
__device__ __forceinline__ void final_norm(const Ptrs& P, int gw, int NGW, int lane) {
    const float* ss = (const float*)(P.ws + WS_SS) + (size_t)6 * M * 16; const float* gain = P.in[17]; const bf16_t* H = (const bf16_t*)(P.ws + WS_H);
    f32x4 g[4];
#pragma unroll
    for (int j = 0; j < 4; ++j) g[j] = ((const f32x4*)gain)[lane + 64 * j];
    for (int m0 = gw * 4; m0 < M; m0 += NGW * 4) {
        u32x2 w[4][4]; float rs[4];
#pragma unroll
        for (int r = 0; r < 4; ++r) { rs[r] = pg8::row_rstd(ss, m0 + r);
#pragma unroll
            for (int j = 0; j < 4; ++j) w[r][j] = ((const u32x2*)(H + (size_t)(m0 + r) * D))[lane + 64 * j]; }
#pragma unroll
        for (int r = 0; r < 4; ++r) { f32x4* orow = (f32x4*)(P.out + (size_t)(m0 + r) * D) + lane;
#pragma unroll
            for (int j = 0; j < 4; ++j) { const f32x4 v = (f32x4){pg8::bf_lo(w[r][j].x), pg8::bf_hi(w[r][j].x), pg8::bf_lo(w[r][j].y), pg8::bf_hi(w[r][j].y)}; __builtin_nontemporal_store(v * rs[r] * g[j], orow + 64 * j); } }
    }
}
#define XB_TMO      128
#define XB_XCNT(j)  (256  + 64 * (j))
#define XB_XSUB(j)  (1280 + 64 * (j))
#define XB_XGEN(j)  (2304 + 64 * (j))
#define XB_TOP      3328
#define XB_TOPGEN   3392
#define XCD_BAR_WORDS 3456
#define XB_SPIN_CAP (1u << 18)

__device__ __forceinline__ unsigned xb_ld(unsigned* p)              { return __hip_atomic_load(p, __ATOMIC_RELAXED, __HIP_MEMORY_SCOPE_AGENT); }
__device__ __forceinline__ unsigned xb_add(unsigned* p, unsigned v) { return __hip_atomic_fetch_add(p, v, __ATOMIC_RELAXED, __HIP_MEMORY_SCOPE_AGENT); }
__device__ __forceinline__ unsigned xb_xcc_id() { return (unsigned)__builtin_amdgcn_s_getreg((3 << 11) | 20) & 0xFu; }
#define XB_SPIN(cond, bar) do { unsigned _sp = 0; while (cond) { __builtin_amdgcn_s_sleep(1); \
    if ((++_sp & 255u) == 0u) { if (xb_ld(&(bar)[XB_TMO])) break; if (_sp > XB_SPIN_CAP) { atomicAdd(&(bar)[XB_TMO], 1u); break; } } } } while (0)

struct XcdBarrier {
    unsigned* bar; unsigned x;
    volatile LAS unsigned* st;
};

__device__ __forceinline__ XcdBarrier xcd_barrier_post(unsigned* bar, volatile LAS unsigned* st) {
    XcdBarrier b; b.bar = bar; b.x = xb_xcc_id(); b.st = st;
    if (threadIdx.x == 0) (void)xb_add(&bar[XB_XCNT(b.x)], 1u);
    return b;
}
__device__ __forceinline__ void xcd_barrier_complete(unsigned* bar, unsigned x, unsigned& nloc, unsigned& nx) {
    const unsigned G = gridDim.x * gridDim.y * gridDim.z;
    unsigned sum, cnt, mine, sp = 0u;
    for (;;) {
        sum = 0u; cnt = 0u; mine = 0u;
#pragma unroll
        for (unsigned j = 0; j < 16; ++j) { const unsigned c = xb_ld(&bar[XB_XCNT(j)]); sum += c; cnt += (c > 0u) ? 1u : 0u; mine = (j == x) ? c : mine; }
        if (sum == G) break;
        __builtin_amdgcn_s_sleep(1);
        if ((++sp & 255u) == 0u) { if (xb_ld(&bar[XB_TMO])) break; if (sp > XB_SPIN_CAP) { atomicAdd(&bar[XB_TMO], 1u); break; } }
    }
    nloc = mine > 0u ? mine : 1u; nx = cnt > 0u ? cnt : 1u;
}

__device__ __forceinline__ void xcd_barrier(const XcdBarrier& b) {
    asm volatile("s_waitcnt vmcnt(0)" ::: "memory");
    __syncthreads();
    if (threadIdx.x == 0) {
        unsigned* bar = b.bar;
        __builtin_amdgcn_s_waitcnt(0);
        unsigned nloc = b.st[0], nx = b.st[1];
        if (nloc == 0u) { xcd_barrier_complete(bar, b.x, nloc, nx); b.st[0] = nloc; b.st[1] = nx; }
        const unsigned old = xb_add(&bar[XB_XSUB(b.x)], 1u);
        const unsigned gen = old / nloc;
        if (old + 1u == (gen + 1u) * nloc) {
            __builtin_amdgcn_fence(__ATOMIC_RELEASE, "agent");
            asm volatile("s_waitcnt vmcnt(0)" ::: "memory");
            const unsigned og = xb_add(&bar[XB_TOP], 1u);
            const unsigned tg = og / nx;
            if (og + 1u == (tg + 1u) * nx) xb_add(&bar[XB_TOPGEN], 1u);
            else XB_SPIN(xb_ld(&bar[XB_TOPGEN]) == tg, bar);
            __builtin_amdgcn_fence(__ATOMIC_ACQUIRE, "agent");
            xb_add(&bar[XB_XGEN(b.x)], 1u);
            asm volatile("s_waitcnt vmcnt(0)" ::: "memory");
        } else {
            XB_SPIN(xb_ld(&bar[XB_XGEN(b.x)]) == gen, bar);
            __builtin_amdgcn_fence(__ATOMIC_ACQUIRE, "agent");
            asm volatile("s_waitcnt vmcnt(0)" ::: "memory");
        }
    }
    __syncthreads();
}
__device__ __forceinline__ void unpack8(const u32x4 w, float (&v)[8]) {
    v[0] = pg8::bf_lo(w.x); v[1] = pg8::bf_hi(w.x); v[2] = pg8::bf_lo(w.y); v[3] = pg8::bf_hi(w.y); v[4] = pg8::bf_lo(w.z); v[5] = pg8::bf_hi(w.z); v[6] = pg8::bf_lo(w.w); v[7] = pg8::bf_hi(w.w);
}
__device__ __forceinline__ void conv_item(const bf16_t* PROJ, const float* cw, bf16_t* Y, int item, int lane) {
    const int r0 = item * 16, c0 = lane * 8;
    float w0[8], w1[8], w2[8];
#pragma unroll
    for (int j = 0; j < 8; ++j) { w0[j] = cw[c0 + j]; w1[j] = cw[512 + c0 + j]; w2[j] = cw[1024 + c0 + j]; }
    float um1[8], um2[8];
#pragma unroll
    for (int j = 0; j < 8; ++j) { um1[j] = 0.f; um2[j] = 0.f; }
    if ((r0 & (SEQ - 1)) != 0) {
        float a[8], b[8];
        const bf16_t* p2 = PROJ + (size_t)(r0 - 2) * 3072 + c0; unpack8(*(const u32x4*)(p2 + 512), a); unpack8(*(const u32x4*)(p2 + 1024), b);
#pragma unroll
        for (int j = 0; j < 8; ++j) um2[j] = a[j] * b[j];
        const bf16_t* p1 = PROJ + (size_t)(r0 - 1) * 3072 + c0; unpack8(*(const u32x4*)(p1 + 512), a); unpack8(*(const u32x4*)(p1 + 1024), b);
#pragma unroll
        for (int j = 0; j < 8; ++j) um1[j] = a[j] * b[j];
    }
#pragma unroll 4
    for (int r = 0; r < 16; ++r) {
        const bf16_t* p = PROJ + (size_t)(r0 + r) * 3072 + c0;
        float g[8], a[8], b[8], o[8];
        unpack8(*(const u32x4*)p, g); unpack8(*(const u32x4*)(p + 512), a); unpack8(*(const u32x4*)(p + 1024), b);
#pragma unroll
        for (int j = 0; j < 8; ++j) { const float u = a[j] * b[j]; o[j] = g[j] * (w0[j] * um2[j] + w1[j] * um1[j] + w2[j] * u); um2[j] = um1[j]; um1[j] = u; }
        u32x4 w; w.x = pk2(o[0], o[1]); w.y = pk2(o[2], o[3]); w.z = pk2(o[4], o[5]); w.w = pk2(o[6], o[7]);
        *(u32x4*)(Y + (size_t)(r0 + r) * 1024 + c0) = w;
    }
}
__device__ __forceinline__ s16x4 vtr(const LAS unsigned char* p) { typedef short v4i16_t __attribute__((ext_vector_type(4))); return __builtin_bit_cast(s16x4, __builtin_amdgcn_ds_read_tr16_b64_v4i16((LAS v4i16_t*)p)); }
__device__ __forceinline__ bf16x8 cat8(s16x4 a, s16x4 b) { bf16x8 r; r[0] = a[0]; r[1] = a[1]; r[2] = a[2]; r[3] = a[3]; r[4] = b[0]; r[5] = b[1]; r[6] = b[2]; r[7] = b[3]; return r; }
constexpr int AV_STRIDE = 144;
__device__ __forceinline__ void attn_unit(const bf16_t* PROJ, bf16_t* Y, int b, int h, int qb, LAS unsigned char* vlds, int lane) {
    const int r32 = lane & 31, hi = lane >> 5;
    const size_t rowbase = (size_t)b * SEQ;
    const int t0 = qb * 32;
    bf16x8 qf[4];
    { const bf16_t* qp = PROJ + (rowbase + t0 + r32) * 3072 + 1536 + h * 64 + 8 * hi;
#pragma unroll
      for (int kk = 0; kk < 4; ++kk) qf[kk] = *(const bf16x8*)(qp + 16 * kk); }
    f32x16 o0, o1;
#pragma unroll
    for (int i = 0; i < 16; ++i) { o0[i] = 0.f; o1[i] = 0.f; }
    float carry = 0.f;
    const int g4 = lane >> 4, li = lane & 15;
    const LAS unsigned char* trbase = vlds + (4 * (g4 >> 1) + (li >> 2)) * AV_STRIDE + (16 * (g4 & 1) + 4 * (li & 3)) * 2;
    bf16x8 kf[4]; u32x4 vr[4];
#define AT_LOAD(KF, VR, K0) do { const bf16_t* kp_ = PROJ + (rowbase + (K0) + r32) * 3072 + 2048 + h * 64 + 8 * hi; \
        _Pragma("unroll") for (int kk = 0; kk < 4; ++kk) KF[kk] = *(const bf16x8*)(kp_ + 16 * kk); \
        _Pragma("unroll") for (int j = 0; j < 4; ++j) VR[j] = *(const u32x4*)(PROJ + (rowbase + (K0) + (lane >> 3) + 8 * j) * 3072 + 2560 + h * 64 + 8 * (lane & 7)); } while (0)
    AT_LOAD(kf, vr, t0);
    for (int kt = qb; kt >= 0; --kt) {
#pragma unroll
        for (int j = 0; j < 4; ++j) *(LAS u32x4*)(vlds + ((lane >> 3) + 8 * j) * AV_STRIDE + 16 * (lane & 7)) = vr[j];
        bf16x8 kfn[4]; u32x4 vrn[4];
#pragma unroll
        for (int j = 0; j < 4; ++j) { kfn[j] = kf[j]; vrn[j] = vr[j]; }
        if (kt > 0) AT_LOAD(kfn, vrn, (kt - 1) * 32);
        f32x16 sc;
#pragma unroll
        for (int i = 0; i < 16; ++i) sc[i] = 0.f;
#pragma unroll
        for (int kk = 0; kk < 4; ++kk) sc = __builtin_amdgcn_mfma_f32_32x32x16_bf16(kf[kk], qf[kk], sc, 0, 0, 0);
        const bool diag = (kt == qb);
        float lk[16], lb[16];
#pragma unroll
        for (int r = 0; r < 16; ++r) {
            const float z = sc[r], az = __builtin_fabsf(z);
            const float L = __builtin_amdgcn_logf(1.0f + __builtin_amdgcn_exp2f(-az));
            float lbv = __builtin_fminf(z, 0.f) - L, lkv = lbv - z;
            if (diag) { const int key = (r & 3) + 8 * (r >> 2) + 4 * hi; if (!(key < r32)) { lkv = 0.f; lbv = -1.0e30f; } }
            lk[r] = lkv; lb[r] = lbv;
        }
        float gs[4], pg[4], T[4];
#pragma unroll
        for (int j = 0; j < 4; ++j) { gs[j] = (lk[4 * j] + lk[4 * j + 1]) + (lk[4 * j + 2] + lk[4 * j + 3]); pg[j] = __shfl_xor(gs[j], 32); T[j] = gs[j] + pg[j]; }
        float w[16];
        float suf = carry;
#pragma unroll
        for (int j = 3; j >= 0; --j) {
            float run = suf + (hi == 0 ? pg[j] : 0.f);
#pragma unroll
            for (int i = 3; i >= 0; --i) { w[4 * j + i] = __builtin_amdgcn_exp2f(lb[4 * j + i] + run); run += lk[4 * j + i]; }
            suf += T[j];
        }
        carry = suf;
        u32x4 p0, p1;
        p0.x = pk2(w[0], w[1]); p0.y = pk2(w[2], w[3]); p0.z = pk2(w[4], w[5]); p0.w = pk2(w[6], w[7]);
        p1.x = pk2(w[8], w[9]); p1.y = pk2(w[10], w[11]); p1.z = pk2(w[12], w[13]); p1.w = pk2(w[14], w[15]);
        const bf16x8 pf0 = __builtin_bit_cast(bf16x8, p0), pf1 = __builtin_bit_cast(bf16x8, p1);
        asm volatile("s_waitcnt lgkmcnt(0)" ::: "memory");
        const bf16x8 v00 = cat8(vtr(trbase), vtr(trbase + 8 * AV_STRIDE));
        const bf16x8 v01 = cat8(vtr(trbase + 16 * AV_STRIDE), vtr(trbase + 24 * AV_STRIDE));
        const bf16x8 v10 = cat8(vtr(trbase + 64), vtr(trbase + 8 * AV_STRIDE + 64));
        const bf16x8 v11 = cat8(vtr(trbase + 16 * AV_STRIDE + 64), vtr(trbase + 24 * AV_STRIDE + 64));
        o0 = __builtin_amdgcn_mfma_f32_32x32x16_bf16(v00, pf0, o0, 0, 0, 0);
        o0 = __builtin_amdgcn_mfma_f32_32x32x16_bf16(v01, pf1, o0, 0, 0, 0);
        o1 = __builtin_amdgcn_mfma_f32_32x32x16_bf16(v10, pf0, o1, 0, 0, 0);
        o1 = __builtin_amdgcn_mfma_f32_32x32x16_bf16(v11, pf1, o1, 0, 0, 0);
        if (__builtin_amdgcn_ballot_w64(carry > -160.0f) == 0ull) break;
#pragma unroll
        for (int j = 0; j < 4; ++j) { kf[j] = kfn[j]; vr[j] = vrn[j]; }
    }
#undef AT_LOAD
    bf16_t* yp = Y + (rowbase + t0 + r32) * 1024 + 512 + h * 64 + 4 * hi;
#pragma unroll
    for (int j = 0; j < 4; ++j) {
        u32x2 a; a.x = pk2(o0[4 * j], o0[4 * j + 1]); a.y = pk2(o0[4 * j + 2], o0[4 * j + 3]); *(u32x2*)(yp + 8 * j) = a;
        u32x2 c; c.x = pk2(o1[4 * j], o1[4 * j + 1]); c.y = pk2(o1[4 * j + 2], o1[4 * j + 3]); *(u32x2*)(yp + 32 + 8 * j) = c;
    }
}
__device__ __forceinline__ void mix0_phase(const Ptrs& P, LAS unsigned char* lds, int gw, int NGW, int wave, int lane) {
    const bf16_t* PROJ = (const bf16_t*)(P.ws + WS_PROJ); bf16_t* Y = (bf16_t*)(P.ws + WS_Y);
    LAS unsigned char* vlds = lds + wave * 8192;
#ifndef DBG_NO_ATTN
    for (int it = gw; it < BATCH * 8 * (SEQ / 32); it += NGW) { const int bh = it / (SEQ / 32), qb = it % (SEQ / 32); attn_unit(PROJ, Y, bh >> 3, bh & 7, qb, vlds, lane); }
#else
    for (int m = gw; m < M; m += NGW) { *(u32x4*)(Y + (size_t)m * 1024 + 512 + 8 * lane) = (u32x4){0u, 0u, 0u, 0u}; }
#endif
    for (int it = gw; it < M / 16; it += NGW) conv_item(PROJ, P.in[11], Y, it, lane);
}
constexpr int HS = 272;
constexpr int HL_QT = 0, HL_KT = 64 * HS, HL_KH = 2 * 64 * HS, HL_V = 3 * 64 * HS, HL_V2 = 4 * 64 * HS, HL_OUT = 4 * 64 * HS;
constexpr int HSC = 144;
constexpr int HL_SC = 5 * 64 * HS, HL_SEG = HL_SC + 64 * HSC, HL_DEC = HL_SEG + 8 * 128 * 4, HL_OSQ = HL_DEC + 512, HL_END = HL_OSQ + 64 * 8 * 4;
static_assert(HL_END <= 131072, "hgrn LDS map");
constexpr size_t WS_DTOT = 256 * 1024;
constexpr int HG_NCH = 16;
#define HG_BAR() do { asm volatile("s_waitcnt lgkmcnt(0)" ::: "memory"); __builtin_amdgcn_s_barrier(); asm volatile("" ::: "memory"); } while (0)
#define MFMA16(a, b, c) __builtin_amdgcn_mfma_f32_16x16x32_bf16((a), (b), (c), 0, 0, 0)
typedef float f32x2v __attribute__((ext_vector_type(2)));
template <bool FULL>
__device__ __forceinline__ void hgrn_unit(const Ptrs& P, LAS unsigned char* lds, int bh, int sc, int tid, int wave, int lane) {
    const bf16_t* Qs = (const bf16_t*)(P.ws + WS_QS); const float* LF = (const float*)(P.ws + WS_LF); const bf16_t* Iv = (const bf16_t*)(P.ws + WS_IV); const bf16_t* Gs = (const bf16_t*)(P.ws + WS_GS);
    bf16_t* Ob = (bf16_t*)P.out;
    float* SLOC = (float*)((unsigned char*)P.out + 64 * MiB);
    float* DTOT = (float*)(P.ws + WS_DTOT);
    const int b = bh >> 3, h = bh & 7, hc = h * 128;
    const int fr = lane & 15, fq = lane >> 4;
    const int kp = lane, seg = wave;
    f32x4 S[8];
    if (FULL && sc > 0) {
        const float* sp = SLOC + ((size_t)(bh * 4) << 14) + (16 * wave + fr) * 4;
        const float* dp = DTOT + (bh * 4) * 128 + 4 * fq;
#pragma unroll
        for (int kt = 0; kt < 8; ++kt) S[kt] = *(const f32x4*)(sp + (4 * kt + fq) * 512);
        for (int j = 1; j < sc; ++j) {
#pragma unroll
            for (int kt = 0; kt < 8; ++kt) S[kt] = S[kt] * *(const f32x4*)(dp + j * 128 + 16 * kt) + *(const f32x4*)(sp + ((size_t)j << 14) + (4 * kt + fq) * 512);
        }
    } else {
#pragma unroll
        for (int kt = 0; kt < 8; ++kt) S[kt] = (f32x4){0.f, 0.f, 0.f, 0.f};
    }
    LAS float* segtot = (LAS float*)(lds + HL_SEG); LAS float* dec = (LAS float*)(lds + HL_DEC); LAS float* osq = (LAS float*)(lds + HL_OSQ);
    f32x4 on0, on1;
    if (FULL) { const float* onp = P.in[15] + 8 * (tid & 15); on0 = *(const f32x4*)onp; on1 = *(const f32x4*)(onp + 4); }
    float dprod0 = 1.f, dprod1 = 1.f;
    f32x2v lf2[8]; unsigned q2[8]; u32x4 vch[2], gch[2];
    const size_t Rbase = (size_t)b * SEQ + (size_t)sc * (64 * HG_NCH);
#define HG_LOAD_E(R0_) do { _Pragma("unroll") for (int i = 0; i < 8; ++i) { const size_t off = ((R0_) + 8 * seg + i) * 1024 + hc + 2 * kp; lf2[i] = *(const f32x2v*)(LF + off); if (FULL) q2[i] = *(const unsigned*)(Qs + off); } \
        _Pragma("unroll") for (int j = 0; j < 2; ++j) { const int ch = tid + 512 * j; vch[j] = *(const u32x4*)(Iv + ((R0_) + (ch >> 4)) * 1024 + hc + 8 * (ch & 15)); } } while (0)
#define HG_LOAD_G(R0_) do { _Pragma("unroll") for (int j = 0; j < 2; ++j) { const int ch = tid + 512 * j; gch[j] = *(const u32x4*)(Gs + ((R0_) + (ch >> 4)) * 1024 + hc + 8 * (ch & 15)); } } while (0)
    HG_LOAD_E(Rbase);
    if (FULL) HG_LOAD_G(Rbase);
#pragma unroll 1
    for (int c = 0; c < HG_NCH; ++c) {
        const size_t R0 = Rbase + (size_t)c * 64;
        const int vimg = FULL ? HL_V : ((c & 1) ? HL_V2 : HL_V);
        f32x2v cs[8]; { f32x2v run = (f32x2v){0.f, 0.f};
#pragma unroll
          for (int i = 0; i < 8; ++i) { run += lf2[i]; cs[i] = run; } }
        *(LAS f32x2v*)(segtot + seg * 128 + 2 * kp) = cs[7];
#pragma unroll
        for (int j = 0; j < 2; ++j) { const int ch = tid + 512 * j; *(LAS u32x4*)(lds + vimg + (ch >> 4) * HS + 16 * (ch & 15)) = vch[j]; }
        HG_BAR();
        f32x2v pre = (f32x2v){0.f, 0.f}, tot = (f32x2v){0.f, 0.f};
#pragma unroll
        for (int s2 = 0; s2 < 8; ++s2) { const f32x2v v = *(const LAS f32x2v*)(segtot + s2 * 128 + 2 * kp); tot += v; if (s2 < seg) pre += v; }
        const float dl0 = __builtin_amdgcn_exp2f(tot[0]), dl1 = __builtin_amdgcn_exp2f(tot[1]);
        if (seg == 0) { *(LAS f32x2v*)(dec + 2 * kp) = (f32x2v){dl0, dl1}; dprod0 *= dl0; dprod1 *= dl1; }
#pragma unroll
        for (int i = 0; i < 8; ++i) {
            const float b0 = pre[0] + cs[i][0], b1 = pre[1] + cs[i][1];
            const float k0 = (1.0f - __builtin_amdgcn_exp2f(lf2[i][0])) * __builtin_amdgcn_exp2f(-b0), k1 = (1.0f - __builtin_amdgcn_exp2f(lf2[i][1])) * __builtin_amdgcn_exp2f(-b1);
            const int o = (8 * seg + i) * HS + 4 * kp;
            *(LAS unsigned*)(lds + HL_KH + o) = pk2(k0 * dl0, k1 * dl1);
            if (FULL) {
                *(LAS unsigned*)(lds + HL_KT + o) = pk2(k0, k1);
                *(LAS unsigned*)(lds + HL_QT + o) = pk2(pg8::bf_lo(q2[i]) * __builtin_amdgcn_exp2f(b0), pg8::bf_hi(q2[i]) * __builtin_amdgcn_exp2f(b1));
            }
        }
        if (c < HG_NCH - 1) HG_LOAD_E(R0 + 64);
        HG_BAR();
        f32x4 o[4];
        bf16x8 vf[2];
        if (FULL) {
            { const int tt = wave >> 1;
#pragma unroll
              for (int e = 0; e < 2; ++e) { const int st = 2 * (wave & 1) + e; const int t = 16 * tt + fr, s0 = 16 * st + 4 * fq;
                  u32x2 w = (u32x2){0u, 0u};
                  if (st <= tt) {
                      f32x4 a4 = (f32x4){0.f, 0.f, 0.f, 0.f};
#pragma unroll
                      for (int ks = 0; ks < 4; ++ks) {
                          const bf16x8 af = *(const LAS bf16x8*)(lds + HL_KT + (16 * st + fr) * HS + (32 * ks + 8 * fq) * 2);
                          const bf16x8 bfr = *(const LAS bf16x8*)(lds + HL_QT + (16 * tt + fr) * HS + (32 * ks + 8 * fq) * 2);
                          a4 = MFMA16(af, bfr, a4);
                      }
                      const float v0 = s0 + 0 <= t ? a4[0] : 0.f, v1 = s0 + 1 <= t ? a4[1] : 0.f, v2 = s0 + 2 <= t ? a4[2] : 0.f, v3 = s0 + 3 <= t ? a4[3] : 0.f;
                      w.x = pk2(v0, v1); w.y = pk2(v2, v3);
                  }
                  *(LAS u32x2*)(lds + HL_SC + t * HSC + s0 * 2) = w;
              } }
#pragma unroll
            for (int tt = 0; tt < 4; ++tt) o[tt] = (f32x4){0.f, 0.f, 0.f, 0.f};
#pragma unroll
            for (int ks = 0; ks < 4; ++ks) {
                u32x4 sb; sb.x = pk2(S[2 * ks][0], S[2 * ks][1]); sb.y = pk2(S[2 * ks][2], S[2 * ks][3]); sb.z = pk2(S[2 * ks + 1][0], S[2 * ks + 1][1]); sb.w = pk2(S[2 * ks + 1][2], S[2 * ks + 1][3]);
                const bf16x8 sfr = __builtin_bit_cast(bf16x8, sb);
#pragma unroll
                for (int tt = 0; tt < 4; ++tt) {
                    const LAS unsigned char* ap = lds + HL_QT + (16 * tt + fr) * HS + (32 * ks + 4 * fq) * 2;
                    const s16x4 a0 = *(const LAS s16x4*)ap, a1 = *(const LAS s16x4*)(ap + 32);
                    o[tt] = MFMA16(cat8(a0, a1), sfr, o[tt]);
                }
            }
        }
        { const LAS unsigned char* tb = lds + vimg + (8 * fq + (fr >> 2)) * HS + (16 * wave + 4 * (fr & 3)) * 2;
#pragma unroll
          for (int ss = 0; ss < 2; ++ss) vf[ss] = cat8(vtr(tb + (32 * ss) * HS), vtr(tb + (32 * ss + 4) * HS)); }
        f32x4 Sn[8];
#pragma unroll
        for (int kt = 0; kt < 8; ++kt) {
            const f32x4 d4 = *(const LAS f32x4*)(dec + 16 * kt + 4 * fq);
            f32x4 a4 = S[kt] * d4;
            const LAS unsigned char* tb = lds + HL_KH + (8 * fq + (fr >> 2)) * HS + (16 * kt + 4 * (fr & 3)) * 2;
#pragma unroll
            for (int ss = 0; ss < 2; ++ss) a4 = MFMA16(cat8(vtr(tb + (32 * ss) * HS), vtr(tb + (32 * ss + 4) * HS)), vf[ss], a4);
            Sn[kt] = a4;
        }
#pragma unroll
        for (int kt = 0; kt < 8; ++kt) S[kt] = Sn[kt];
        if (FULL) {
            HG_BAR();
#pragma unroll
            for (int ss = 0; ss < 2; ++ss)
#pragma unroll
                for (int tt = 0; tt < 4; ++tt) {
                    if (ss == 1 && tt < 2) continue;
                    const bf16x8 af = *(const LAS bf16x8*)(lds + HL_SC + (16 * tt + fr) * HSC + (32 * ss + 8 * fq) * 2);
                    o[tt] = MFMA16(af, vf[ss], o[tt]);
                }
#pragma unroll
            for (int tt = 0; tt < 4; ++tt)
#pragma unroll
                for (int r = 0; r < 4; ++r) { const int t = 16 * tt + 4 * fq + r; const float ov = o[tt][r]; float q = ov * ov;
                    *(LAS unsigned short*)(lds + HL_OUT + t * HS + (16 * wave + fr) * 2) = (unsigned short)f2bf(ov);
                    q += __shfl_xor(q, 1); q += __shfl_xor(q, 2); q += __shfl_xor(q, 4); q += __shfl_xor(q, 8);
                    if (fr == 0) osq[t * 8 + wave] = q; }
            HG_BAR();
#pragma unroll
            for (int j = 0; j < 2; ++j) { const int ch = tid + 512 * j, row = ch >> 4, c16 = ch & 15;
                const f32x4 qa = *(const LAS f32x4*)(osq + row * 8), qb = *(const LAS f32x4*)(osq + row * 8 + 4);
                const float rs = 1.0f / sqrtf((((qa[0] + qa[1]) + (qa[2] + qa[3])) + ((qb[0] + qb[1]) + (qb[2] + qb[3]))) * (1.0f / 128.0f) + 1e-6f);
                const u32x4 ow = *(const LAS u32x4*)(lds + HL_OUT + row * HS + 16 * c16);
                float ov[8], gv[8]; unpack8(ow, ov); unpack8(gch[j], gv);
                u32x4 w; w.x = pk2(ov[0] * rs * on0[0] * gv[0], ov[1] * rs * on0[1] * gv[1]); w.y = pk2(ov[2] * rs * on0[2] * gv[2], ov[3] * rs * on0[3] * gv[3]);
                w.z = pk2(ov[4] * rs * on1[0] * gv[4], ov[5] * rs * on1[1] * gv[5]); w.w = pk2(ov[6] * rs * on1[2] * gv[6], ov[7] * rs * on1[3] * gv[7]);
                *(u32x4*)(Ob + (R0 + row) * 1024 + hc + 8 * c16) = w; }
            if (c < HG_NCH - 1) HG_LOAD_G(R0 + 64);
        }
    }
    if (!FULL) {
        float* sp = SLOC + ((size_t)(bh * 4 + sc) << 14) + (16 * wave + fr) * 4;
#pragma unroll
        for (int kt = 0; kt < 8; ++kt) *(f32x4*)(sp + (4 * kt + fq) * 512) = S[kt];
        if (seg == 0) *(f32x2v*)(DTOT + (bh * 4 + sc) * 128 + 2 * kp) = (f32x2v){dprod0, dprod1};
    }
    HG_BAR();
#undef HG_LOAD_E
#undef HG_LOAD_G
}
__device__ __forceinline__ void hgrn_scan(const Ptrs& P, int gw, int NGW, int lane) {
    float* SLOC = (float*)((unsigned char*)P.out + 64 * MiB); const float* DTOT = (const float*)(P.ws + WS_DTOT);
    for (int it = gw; it < 64 * 64; it += NGW) {
        const int bh = it >> 6, e0 = (it & 63) * 256 + lane * 4, k0 = (e0 >> 9) * 4;
        f32x4 v[3], d[3];
#pragma unroll
        for (int s = 0; s < 3; ++s) { v[s] = *(const f32x4*)(SLOC + ((size_t)(bh * 4 + s) << 14) + e0); d[s] = *(const f32x4*)(DTOT + (bh * 4 + s) * 128 + k0); }
        f32x4 run = v[0];
#pragma unroll
        for (int s = 1; s < 3; ++s) { run = run * d[s] + v[s]; *(f32x4*)(SLOC + ((size_t)(bh * 4 + s) << 14) + e0) = run; }
    }
}
#ifndef MK_ONE_LAUNCH
#define MK_ONE_LAUNCH 1
#endif
#ifndef MK_XCD_BAR
#define MK_XCD_BAR 1
#endif
constexpr int N_PHASES = 18;
constexpr int FIN_LDS_OFF = 131072 + 4096;
constexpr int RS_TAB_OFF = 131072 + 1024;
struct Args { Ptrs p; int ph_lo, ph_hi; };
__global__ void __launch_bounds__(NTHREADS, 2) fwd_kernel(Args args) {
    extern __shared__ __attribute__((aligned(16))) unsigned char lds_raw[];
    LAS unsigned char* lds = (LAS unsigned char*)lds_raw;
    const Ptrs& P = args.p;
    const int tid = threadIdx.x, lane = tid & 63, wave = __builtin_amdgcn_readfirstlane(tid >> 6);
    const int G = gridDim.x, bx = blockIdx.x;
    const int vcu = (G % 8 == 0) ? (bx % 8) * (G / 8) + bx / 8 : bx;
    const int gw = vcu * NWAVES + wave, NGW = G * NWAVES;
    unsigned char* ws = P.ws;
    bf16_t* H = (bf16_t*)(ws + WS_H); bf16_t* HID = (bf16_t*)(ws + WS_HID); float* SS = (float*)(ws + WS_SS);
    const int lo = args.ph_lo, hi = args.ph_hi;
#if MK_XCD_BAR
    volatile LAS unsigned* MISC = (volatile LAS unsigned*)(lds + LDS_BYTES - 256);
    if (tid < 32) MISC[tid] = 0u;
#if MK_ONE_LAUNCH
    if (bx == 0) { unsigned* cw = (unsigned*)ws + 4096; for (int i = tid; i < 12288; i += NTHREADS) __hip_atomic_store(cw + i, 0u, __ATOMIC_RELAXED, __HIP_MEMORY_SCOPE_AGENT); }
    __syncthreads();
    XcdBarrier bar; bar.bar = (unsigned*)ws + 4096; bar.x = xb_xcc_id(); bar.st = MISC + 8;
#else
    __syncthreads();
    XcdBarrier bar = xcd_barrier_post((unsigned*)ws + 4096, MISC + 8);
#endif
#endif
#define IN(k) (lo <= (k) && (k) < hi)
#if MK_XCD_BAR
#define SEAM(k) do { if (IN(k) && IN((k) + 1)) { if ((k) == 0) { cg::this_grid().sync(); if (tid == 0) (void)xb_add(&bar.bar[XB_XCNT(bar.x)], 1u); } else xcd_barrier(bar); } } while (0)
#else
#define SEAM(k) do { if (IN(k) && IN((k) + 1)) { cg::this_grid().sync(); } } while (0)
#endif
#define SSB(i) (SS + (size_t)(i) * M * 16)
#define GEMM_GU(f, ssi) do { pg8::Gemm g{H, (const bf16_t*)(ws + WS_GU) + (size_t)(f) * 5632 * 1024, M, 5632, D}; pg8::StaticOrder S; S.init(M, 5632, G, bx); \
        pg8::EpiSwiGLU E{HID, pg8::rs_table_build(lds + RS_TAB_OFF, SSB(ssi), S, tid), FF}; pg8::gemm_phase<pg8::EpiSwiGLU, pg8::StaticOrder, true, true>(lds, g, S, E); } while (0)
#define GEMM_DN(f, sso) do { pg8::Gemm g{HID, (const bf16_t*)(ws + WS_DN) + (size_t)(f) * 1024 * 2816, M, D, FF}; pg8::StaticOrder S; S.init(M, D, G, bx); \
        pg8::EpiResid<false> E{H, SSB(sso), 0.5f, nullptr}; pg8::gemm_phase<pg8::EpiResid<false>, pg8::StaticOrder, true, true>(lds, g, S, E); } while (0)

    if (IN(0)) { p0_prologue(P, lds, gw, NGW, wave, lane); }
#ifdef PROBE_P0
    __syncthreads(); if (IN(0)) { p0_prologue(P, lds, gw, NGW, wave, lane); }
#endif
    SEAM(0);
#ifdef PROBE_EARLYBAR
    xcd_barrier(bar);
#endif
    if (IN(1)) { GEMM_GU(0, 0); }
#ifdef PROBE_LATE_WG
    if (bx == PROBE_LATE_WG) { for (int d_ = 0; d_ < 400; ++d_) __builtin_amdgcn_s_sleep(127); }
#endif
#ifdef PROBE_BAR10
#if PROBE_BAR10 == 2
    asm volatile("s_waitcnt vmcnt(0)" ::: "memory"); __syncthreads();
    if (tid == 0) { __builtin_amdgcn_fence(__ATOMIC_RELEASE, "agent"); asm volatile("s_waitcnt vmcnt(0)" ::: "memory"); __builtin_amdgcn_fence(__ATOMIC_ACQUIRE, "agent"); asm volatile("s_waitcnt vmcnt(0)" ::: "memory"); }
    __syncthreads();
#elif PROBE_BAR10 == 4
    cg::this_grid().sync();
#elif PROBE_BAR10 == 3
    asm volatile("s_waitcnt vmcnt(0)" ::: "memory"); __syncthreads(); __syncthreads();
#else
    for (int i_ = 0; i_ < PROBE_BAR10; ++i_) { xcd_barrier(bar); }
#endif
#endif
#ifdef PROBE_GU2X
    xcd_barrier(bar); if (IN(1)) { GEMM_GU(0, 0); }
#endif
    SEAM(1);
#ifdef PROBE_DN2X
    if (IN(2)) { pg8::Gemm g{HID, (const bf16_t*)(ws + WS_DN), M, D, FF}; pg8::StaticOrder S; S.init(M, D, G, bx);
        pg8::EpiResid<false> E{H, SSB(1), 0.0f, nullptr}; pg8::gemm_phase<pg8::EpiResid<false>, pg8::StaticOrder, true, true>(lds, g, S, E); }
    xcd_barrier(bar);
#endif
    if (IN(2)) { GEMM_DN(0, 1); }
    SEAM(2);
    if (IN(3)) { pg8::Gemm g{H, (const bf16_t*)(ws + WS_ABIN), M, 3072, D}; pg8::StaticOrder S; S.init(M, 3072, G, bx);
        pg8::EpiProjAB E{(bf16_t*)(ws + WS_PROJ), pg8::rs_table_build(lds + RS_TAB_OFF, SSB(1), S, tid), QSCALE}; pg8::gemm_phase<pg8::EpiProjAB, pg8::StaticOrder, true, true>(lds, g, S, E); }
    SEAM(3);
    if (IN(4)) { mix0_phase(P, lds, gw, NGW, wave, lane); }
#ifdef PROBE_P4
    if (IN(4)) { mix0_phase(P, lds, gw, NGW, wave, lane); }
#endif
    SEAM(4);
    if (IN(5)) { pg8::Gemm g{(const bf16_t*)(ws + WS_Y), (const bf16_t*)(ws + WS_ABOUT), M, D, D}; pg8::StaticOrder S; S.init(M, D, G, bx);
        pg8::EpiResid<false> E{H, SSB(2), 1.0f, nullptr}; pg8::gemm_phase<pg8::EpiResid<false>, pg8::StaticOrder, true, true>(lds, g, S, E); }
    SEAM(5);
#ifdef PROBE_BAR_AT5
    xcd_barrier(bar);
#endif
#ifdef PROBE_IDLE
    { const unsigned long long t0_ = __builtin_amdgcn_s_memrealtime(); while (__builtin_amdgcn_s_memrealtime() - t0_ < 100000ull) __builtin_amdgcn_s_sleep(64); }
#endif
    if (IN(6)) { GEMM_GU(1, 2); }
    SEAM(6);
#ifdef PROBE_BAR_AT6
    xcd_barrier(bar);
#endif
    if (IN(7)) { GEMM_DN(1, 3); }
    SEAM(7);
    if (IN(8)) { GEMM_GU(2, 3); }
    SEAM(8);
    if (IN(9)) { GEMM_DN(2, 4); }
    SEAM(9);
    if (IN(10)) { pg8::Gemm g{H, (const bf16_t*)(ws + WS_CIN), M, 4096, D}; pg8::StaticOrder S; S.init(M, 4096, G, bx);
        pg8::EpiProjC E{(bf16_t*)(ws + WS_QS), (float*)(ws + WS_LF), (bf16_t*)(ws + WS_IV), (bf16_t*)(ws + WS_GS), pg8::rs_table_build(lds + RS_TAB_OFF, SSB(4), S, tid), P.in[14]};
        pg8::gemm_phase<pg8::EpiProjC, pg8::StaticOrder, true, true>(lds, g, S, E); }
    SEAM(10);
    if (IN(11)) { const int bh = bx >> 2, sc = (bx + (bx >> 3)) & 3; if (sc < 3 && bh < 64) hgrn_unit<false>(P, lds, bh, sc, tid, wave, lane); }
    SEAM(11);
    if (IN(13)) { const int bh = bx >> 2, sc = (bx + (bx >> 3)) & 3; if (bh < 64) hgrn_unit<true>(P, lds, bh, sc, tid, wave, lane); }
    SEAM(13);
    if (IN(14)) { pg8::Gemm g{(const bf16_t*)P.out, (const bf16_t*)(ws + WS_COUT), M, D, D}; pg8::StaticOrder S; S.init(M, D, G, bx);
        pg8::EpiResid<false> E{H, SSB(5), 1.0f, nullptr}; pg8::gemm_phase<pg8::EpiResid<false>, pg8::StaticOrder, true, true>(lds, g, S, E); }
    SEAM(14);
    if (IN(15)) { GEMM_GU(3, 5); }
    SEAM(15);
    if (IN(16)) { pg8::Gemm g{HID, (const bf16_t*)(ws + WS_DN) + (size_t)3 * 1024 * 2816, M, D, FF}; pg8::StaticOrder S; S.init(M, D, G, bx);
        pg8::EpiFinalNorm E{H, P.out, P.in[17], 0.5f, SSB(6), (unsigned*)ws + 8192, lds + FIN_LDS_OFF};
        pg8::gemm_phase<pg8::EpiFinalNorm, pg8::StaticOrder, true, true>(lds, g, S, E); }
    if (IN(18)) {
        for (int m = gw; m < M; m += NGW) { const u32x2* hr = (const u32x2*)(H + (size_t)m * D) + lane; f32x4* orow = (f32x4*)(P.out + (size_t)m * D) + lane;
#pragma unroll
            for (int j = 0; j < 4; ++j) { const u32x2 w = hr[64 * j]; orow[64 * j] = (f32x4){pg8::bf_lo(w.x), pg8::bf_hi(w.x), pg8::bf_lo(w.y), pg8::bf_hi(w.y)}; } }
    }
}

extern "C" void kernel_launch(void* const* d_in, const int* in_sizes, int n_in, void* d_out, int out_size, void* d_ws, size_t ws_size, hipStream_t stream) {
    static int grid = 0;
    if (grid == 0) {
        if (n_in != 18 || in_sizes[0] != M * D || out_size != M * D || ws_size < WS_END) { fprintf(stderr, "kernel_launch: unexpected shapes (n_in %d, in0 %d, out %d, ws %zu)\n", n_in, n_in > 0 ? in_sizes[0] : -1, out_size, ws_size); grid = -1; return; }
        int dev = 0, cus = 0, per_cu = 0;
        hipGetDevice(&dev); hipDeviceGetAttribute(&cus, hipDeviceAttributeMultiprocessorCount, dev);
        if (hipFuncSetAttribute((const void*)fwd_kernel, hipFuncAttributeMaxDynamicSharedMemorySize, LDS_BYTES) != hipSuccess) { fprintf(stderr, "kernel_launch: hipFuncSetAttribute failed\n"); grid = -1; return; }
        if (hipOccupancyMaxActiveBlocksPerMultiprocessor(&per_cu, (const void*)fwd_kernel, NTHREADS, LDS_BYTES) != hipSuccess || per_cu < 1) { fprintf(stderr, "kernel_launch: occupancy query gives %d\n", per_cu); per_cu = 1; }
        (void)hipGetLastError();
        grid = cus;
    }
    if (grid < 0) return;
    Args a{};
    for (int i = 0; i < 18; ++i) a.p.in[i] = (const float*)d_in[i];
    a.p.out = (float*)d_out; a.p.ws = (unsigned char*)d_ws;
#if MK_ONE_LAUNCH
    a.ph_lo = 0; a.ph_hi = N_PHASES;
    void* kargs[] = {&a};
    hipError_t e = hipLaunchCooperativeKernel((const void*)fwd_kernel, dim3(grid), dim3(NTHREADS), kargs, LDS_BYTES, stream);
    if (e != hipSuccess) fprintf(stderr, "kernel_launch: cooperative launch failed: %s (grid %d)\n", hipGetErrorString(e), grid);
#else
#ifdef DBG_STOP
    for (int ph = 0; ph <= DBG_STOP; ++ph) { a.ph_lo = ph; a.ph_hi = ph + 1; hipLaunchKernelGGL(fwd_kernel, dim3(grid), dim3(NTHREADS), LDS_BYTES, stream, a); }
    a.ph_lo = 18; a.ph_hi = 19; hipLaunchKernelGGL(fwd_kernel, dim3(grid), dim3(NTHREADS), LDS_BYTES, stream, a);
#else
    for (int ph = 0; ph < N_PHASES; ++ph) { a.ph_lo = ph; a.ph_hi = ph + 1; hipLaunchKernelGGL(fwd_kernel, dim3(grid), dim3(NTHREADS), LDS_BYTES, stream, a); }
#endif
#endif
}
```

```cpp
#include <hip/hip_runtime.h>
#include <hip/hip_cooperative_groups.h>
#include <cstdio>
#include <cstdint>
namespace cg = cooperative_groups;
#define MK_ONE_LAUNCH 1
namespace pg8 {
#define PG8_LAS __attribute__((address_space(3)))
typedef unsigned short bf16_t;
typedef short bf16x8 __attribute__((ext_vector_type(8)));
typedef float f32x4 __attribute__((ext_vector_type(4)));
typedef unsigned u32x4 __attribute__((ext_vector_type(4)));
constexpr int BM = 256, BK = 64, HALF = 128, HTB = HALF * BK * 2  , STAGE_BYTES = 8 * HTB, NXCD = 8, WGM = 8;

__host__ __device__ __forceinline__ int lds_byte(int r, int c) { const int st = (r >> 4) * 2 + (c >> 5), rr = r & 15, cc = c & 31, ob = rr * 64 + cc * 2; return st * 1024 + (ob ^ (((ob >> 9) & 1) << 5)); }
__host__ __device__ __forceinline__ void stage_rc(int b, int& R, int& C) { const int st = b / 1024, sb = b % 1024, swz = sb ^ (((sb >> 9) & 1) << 5); R = (st >> 1) * 16 + swz / 64; C = (st & 1) * 32 + (swz % 64) / 2; }
__host__ __device__ __forceinline__ int perm32(int rho) { const int n = rho >> 4, i = rho & 15; return 8 * (i >> 2) + 4 * n + (i & 3); }

struct Unit { int pm, pn; };
struct Gemm { const bf16_t* A; const bf16_t* Bt; int M, N, K; };

struct StaticOrder {
    int nM, nN, nwg, G, c;
    __host__ __device__ void init(int M, int N, int G_, int c_) { nM = M / BM; nN = N / BM; nwg = nM * nN; G = G_; c = c_; }
    __host__ __device__ bool next(int i, Unit& u) const {
        const long L = (long)i * G + c; if (L >= nwg) return false;
        int wgid = (int)L; { const int q = nwg / NXCD, r = nwg % NXCD, xcd = wgid % NXCD, off = wgid / NXCD; wgid = (xcd < r ? xcd * (q + 1) : r * (q + 1) + (xcd - r) * q) + off; }
        const int nig = WGM * nN, gid = wgid / nig, fm = gid * WGM, gsz = (nM - fm) < WGM ? (nM - fm) : WGM;
        u.pm = fm + ((wgid % nig) % gsz); u.pn = (wgid % nig) / gsz; return true;
    }
    __device__ __forceinline__ void a_ready(const Unit&) const {}
    __device__ __forceinline__ void done(const Unit&) const {}
};

__device__ __forceinline__ unsigned cvt_pk_bf16(float lo, float hi) { unsigned r; asm volatile("v_cvt_pk_bf16_f32 %0, %1, %2" : "=v"(r) : "v"(lo), "v"(hi)); return r; }
typedef float f32x2 __attribute__((ext_vector_type(2)));
__device__ __forceinline__ float row_rstd(const float* ss, int row) {
    const f32x4* p = (const f32x4*)(ss + (size_t)row * 16);
    const f32x4 a = p[0], b = p[1], c = p[2], d = p[3];
    const float s = ((a[0] + a[1]) + (a[2] + a[3])) + ((b[0] + b[1]) + (b[2] + b[3])) + ((c[0] + c[1]) + (c[2] + c[3])) + ((d[0] + d[1]) + (d[2] + d[3]));
    return __builtin_amdgcn_rsqf(s * (1.0f / 1024.0f) + 1e-6f);
}
struct RsTab { const PG8_LAS float* tab; int pmA, pmB; const float* ss; };
template <class Sched> __device__ __forceinline__ RsTab rs_table_build(PG8_LAS unsigned char* lds_tab, const float* ss, const Sched& S, int tid) {
    RsTab t; t.tab = (const PG8_LAS float*)lds_tab; t.pmA = -1; t.pmB = -1; t.ss = ss;
    Unit u; for (int i = 0; S.next(i, u); ++i) { if (t.pmA < 0) t.pmA = u.pm; else if (u.pm != t.pmA && t.pmB < 0) t.pmB = u.pm; }
    const int pm = tid < 256 ? t.pmA : t.pmB;
    if (pm >= 0) ((PG8_LAS float*)lds_tab)[tid] = row_rstd(ss, pm * BM + (tid & 255));
    __syncthreads();
    return t;
}
__device__ __forceinline__ float rs_lookup(const RsTab& t, const Unit& u, int r  ) {
    if (u.pm == t.pmA) return t.tab[r];
    if (u.pm == t.pmB) return t.tab[256 + r];
    return row_rstd(t.ss, u.pm * BM + r);
}
__device__ __forceinline__ float sigmoidf_(float x) { return __builtin_amdgcn_rcpf(1.0f + __builtin_amdgcn_exp2f(-1.4426950408889634f * x)); }
__device__ __forceinline__ float siluf_(float x) { return x * sigmoidf_(x); }
__device__ __forceinline__ float bf_lo(unsigned w) { return __uint_as_float(w << 16); }
__device__ __forceinline__ float bf_hi(unsigned w) { return __uint_as_float(w & 0xffff0000u); }

struct EpiSwiGLU {
    static constexpr bool PERM = true, AFTER_DRAIN = false;
    bf16_t* O; RsTab rt; int ldo;
    struct Pre {};
    __device__ __forceinline__ Pre pre(const Unit&, int, int) const { return Pre{}; }
    __device__ __forceinline__ void operator()(const f32x4 (&acc)[2][2][4][2], const Unit& u, int wr, int wc, int fr, int fq, const Pre&) const {
        const int row0 = u.pm * BM + wr * 64 + fr, col0 = u.pn * HALF + wc * 32 + 8 * fq;
#pragma unroll
        for (int ai = 0; ai < 2; ++ai)
#pragma unroll
            for (int m = 0; m < 4; ++m) {
                const int row = row0 + ai * HALF + m * 16; const float rs = rs_lookup(rt, u, ai * HALF + wr * 64 + m * 16 + fr), c1 = -1.4426950408889634f * rs, rs2 = rs * rs;
                float h[8];
#pragma unroll
                for (int n = 0; n < 2; ++n)
#pragma unroll
                    for (int i = 0; i < 4; ++i) { const float g = acc[ai][0][m][n][i], up = acc[ai][1][m][n][i];
                        h[4 * n + i] = (g * up) * (rs2 * __builtin_amdgcn_rcpf(1.0f + __builtin_amdgcn_exp2f(g * c1))); }
                u32x4 w; w.x = cvt_pk_bf16(h[0], h[1]); w.y = cvt_pk_bf16(h[2], h[3]); w.z = cvt_pk_bf16(h[4], h[5]); w.w = cvt_pk_bf16(h[6], h[7]);
                *(u32x4*)(O + (size_t)row * ldo + col0) = w;
            }
    }
};
template <bool F32OUT> struct EpiResid {
    static constexpr bool PERM = true, AFTER_DRAIN = false;
    bf16_t* H; float* ssout; float alpha; float* out32;
    struct Pre {};
    __device__ __forceinline__ Pre pre(const Unit&, int, int) const { return Pre{}; }
    __device__ __forceinline__ void operator()(const f32x4 (&acc)[2][2][4][2], const Unit& u, int wr, int wc, int fr, int fq, const Pre&) const {
        const int row0 = u.pm * BM + wr * 64 + fr, col0 = u.pn * BM + wc * 32 + 8 * fq;
#pragma unroll
        for (int ai = 0; ai < 2; ++ai) {
            u32x4 old[4][2];
#pragma unroll
            for (int m = 0; m < 4; ++m)
#pragma unroll
                for (int bj = 0; bj < 2; ++bj) old[m][bj] = *(const u32x4*)(H + (size_t)(row0 + ai * HALF + m * 16) * 1024 + col0 + bj * HALF);
#pragma unroll
            for (int m = 0; m < 4; ++m) {
                const int row = row0 + ai * HALF + m * 16; float sq = 0.f;
#pragma unroll
                for (int bj = 0; bj < 2; ++bj) {
                    bf16_t* hp = H + (size_t)row * 1024 + col0 + bj * HALF;
                    const u32x4 o4 = old[m][bj];
                    float v[8];
                    v[0] = bf_lo(o4.x); v[1] = bf_hi(o4.x); v[2] = bf_lo(o4.y); v[3] = bf_hi(o4.y); v[4] = bf_lo(o4.z); v[5] = bf_hi(o4.z); v[6] = bf_lo(o4.w); v[7] = bf_hi(o4.w);
#pragma unroll
                    for (int n = 0; n < 2; ++n)
#pragma unroll
                        for (int i = 0; i < 4; ++i) { v[4 * n + i] += alpha * acc[ai][bj][m][n][i]; sq += v[4 * n + i] * v[4 * n + i]; }
                    u32x4 w; w.x = cvt_pk_bf16(v[0], v[1]); w.y = cvt_pk_bf16(v[2], v[3]); w.z = cvt_pk_bf16(v[4], v[5]); w.w = cvt_pk_bf16(v[6], v[7]);
                    *(u32x4*)hp = w;
                    if (F32OUT) { float* op = out32 + (size_t)row * 1024 + col0 + bj * HALF; *(f32x4*)op = (f32x4){v[0], v[1], v[2], v[3]}; *(f32x4*)(op + 4) = (f32x4){v[4], v[5], v[6], v[7]}; }
                }
                sq += __shfl_xor(sq, 16); sq += __shfl_xor(sq, 32);
                if (fq == 0) ssout[(size_t)row * 16 + u.pn * 4 + wc] = sq;
            }
        }
    }
};
struct EpiFinalNorm {
    static constexpr bool PERM = false, AFTER_DRAIN = false;
    const bf16_t* H; float* out; const float* gain; float alpha;
    float* xslots;
    unsigned* cnt;
    PG8_LAS unsigned char* xl;
    struct Pre {};
    __device__ __forceinline__ Pre pre(const Unit&, int, int) const { return Pre{}; }
    __device__ __forceinline__ void operator()(f32x4 (&acc)[2][2][4][2], const Unit& u, int wr, int wc, int fr, int fq, const Pre&) const {
        const int tid = threadIdx.x, lane = tid & 63, wid = __builtin_amdgcn_readfirstlane(tid >> 6);
        PG8_LAS float* P = (PG8_LAS float*)xl; PG8_LAS float* S = (PG8_LAS float*)(xl + 4096);
        const int row0 = u.pm * BM + wr * 64 + fr, col0 = u.pn * BM + wc * 32 + 4 * fq;
        typedef unsigned u32x2_t __attribute__((ext_vector_type(2)));
#pragma unroll
        for (int ai = 0; ai < 2; ++ai)
#pragma unroll
            for (int m = 0; m < 4; ++m) {
                const int row = row0 + ai * HALF + m * 16; float sq = 0.f;
#pragma unroll
                for (int bj = 0; bj < 2; ++bj)
#pragma unroll
                    for (int n = 0; n < 2; ++n) {
                        const u32x2_t o = *(const u32x2_t*)(H + (size_t)row * 1024 + col0 + bj * HALF + n * 16);
                        f32x4 v = (f32x4){bf_lo(o.x), bf_hi(o.x), bf_lo(o.y), bf_hi(o.y)} + alpha * acc[ai][bj][m][n];
                        acc[ai][bj][m][n] = v; sq += (v[0] * v[0] + v[1] * v[1]) + (v[2] * v[2] + v[3] * v[3]);
                    }
                sq += __shfl_xor(sq, 16); sq += __shfl_xor(sq, 32);
                if (fq == 0) P[(ai * HALF + wr * 64 + m * 16 + fr) * 4 + wc] = sq;
            }
        asm volatile("s_waitcnt lgkmcnt(0)" ::: "memory"); __builtin_amdgcn_s_barrier(); asm volatile("" ::: "memory");
        if (tid < 256) { const f32x4 p = *(const PG8_LAS f32x4*)(P + tid * 4);
            __hip_atomic_store(xslots + ((size_t)u.pm * BM + tid) * 4 + u.pn, (p[0] + p[1]) + (p[2] + p[3]), __ATOMIC_RELAXED, __HIP_MEMORY_SCOPE_AGENT); }
        asm volatile("s_waitcnt vmcnt(0)" ::: "memory");
        if (tid < 256 && lane == 0) __hip_atomic_fetch_add(cnt + 64 * u.pm, 1u, __ATOMIC_RELAXED, __HIP_MEMORY_SCOPE_AGENT);
        if (wid == 0) {
            unsigned sp = 0;
            while ((unsigned)__builtin_amdgcn_readfirstlane(__hip_atomic_load(cnt + 64 * u.pm, __ATOMIC_RELAXED, __HIP_MEMORY_SCOPE_AGENT)) < 16u) { __builtin_amdgcn_s_sleep(2); if (++sp > (1u << 18)) break; }
            __builtin_amdgcn_fence(__ATOMIC_ACQUIRE, "agent");
        }
        asm volatile("s_waitcnt vmcnt(0) lgkmcnt(0)" ::: "memory"); __builtin_amdgcn_s_barrier(); asm volatile("" ::: "memory");
        if (tid < 256) { const float* sl = xslots + ((size_t)u.pm * BM + tid) * 4;
            const float t = (__hip_atomic_load(sl, __ATOMIC_RELAXED, __HIP_MEMORY_SCOPE_AGENT) + __hip_atomic_load(sl + 1, __ATOMIC_RELAXED, __HIP_MEMORY_SCOPE_AGENT))
                          + (__hip_atomic_load(sl + 2, __ATOMIC_RELAXED, __HIP_MEMORY_SCOPE_AGENT) + __hip_atomic_load(sl + 3, __ATOMIC_RELAXED, __HIP_MEMORY_SCOPE_AGENT));
            S[tid] = __builtin_amdgcn_rsqf(t * (1.0f / 1024.0f) + 1e-6f); }
        asm volatile("s_waitcnt lgkmcnt(0)" ::: "memory"); __builtin_amdgcn_s_barrier(); asm volatile("" ::: "memory");
        f32x4 gv[2][2];
#pragma unroll
        for (int bj = 0; bj < 2; ++bj)
#pragma unroll
            for (int n = 0; n < 2; ++n) gv[bj][n] = *(const f32x4*)(gain + col0 + bj * HALF + n * 16);
#pragma unroll
        for (int ai = 0; ai < 2; ++ai)
#pragma unroll
            for (int m = 0; m < 4; ++m) {
                const int r = ai * HALF + wr * 64 + m * 16 + fr; const float rs = S[r];
                float* op = out + (size_t)(u.pm * BM + r) * 1024 + col0;
#pragma unroll
                for (int bj = 0; bj < 2; ++bj)
#pragma unroll
                    for (int n = 0; n < 2; ++n) __builtin_nontemporal_store(acc[ai][bj][m][n] * rs * gv[bj][n], (f32x4*)(op + bj * HALF + n * 16));
            }
    }
};
struct EpiProjAB {
    static constexpr bool PERM = true, AFTER_DRAIN = false;
    bf16_t* O; RsTab rt; float qscale;
    struct Pre {};
    __device__ __forceinline__ Pre pre(const Unit&, int, int) const { return Pre{}; }
    __device__ __forceinline__ void operator()(const f32x4 (&acc)[2][2][4][2], const Unit& u, int wr, int wc, int fr, int fq, const Pre&) const {
        const int row0 = u.pm * BM + wr * 64 + fr, col0 = u.pn * BM + wc * 32 + 8 * fq;
        const float sc = (u.pn == 6 || u.pn == 7) ? qscale : 1.0f;
#pragma unroll
        for (int ai = 0; ai < 2; ++ai)
#pragma unroll
            for (int m = 0; m < 4; ++m) {
                const int row = row0 + ai * HALF + m * 16; const float rs = rs_lookup(rt, u, ai * HALF + wr * 64 + m * 16 + fr) * sc;
#pragma unroll
                for (int bj = 0; bj < 2; ++bj) {
                    const f32x4 a = acc[ai][bj][m][0] * rs, b = acc[ai][bj][m][1] * rs;
                    u32x4 w; w.x = cvt_pk_bf16(a[0], a[1]); w.y = cvt_pk_bf16(a[2], a[3]); w.z = cvt_pk_bf16(b[0], b[1]); w.w = cvt_pk_bf16(b[2], b[3]);
                    *(u32x4*)(O + (size_t)row * 3072 + col0 + bj * HALF) = w;
                }
            }
    }
};
struct EpiProjC {
    static constexpr bool PERM = true, AFTER_DRAIN = false;
    bf16_t* Qs; float* LF; bf16_t* Iv; bf16_t* Gs; RsTab rt; const float* clb;
    struct Pre {};
    __device__ __forceinline__ Pre pre(const Unit&, int, int) const { return Pre{}; }
    __device__ __forceinline__ void operator()(const f32x4 (&acc)[2][2][4][2], const Unit& u, int wr, int wc, int fr, int fq, const Pre&) const {
        const int kind = u.pn >> 2;
        const int row0 = u.pm * BM + wr * 64 + fr, col0 = (u.pn & 3) * BM + wc * 32 + 8 * fq;
        if (kind == 1) {
            float lb[2][8];
#pragma unroll
            for (int bj = 0; bj < 2; ++bj)
#pragma unroll
                for (int j = 0; j < 8; ++j) { const int c = col0 + bj * HALF + j; lb[bj][j] = sigmoidf_(clb[1024 + c] - clb[c]); }
#pragma unroll
            for (int ai = 0; ai < 2; ++ai)
#pragma unroll
                for (int m = 0; m < 4; ++m) {
                    const int row = row0 + ai * HALF + m * 16; const float rs = rs_lookup(rt, u, ai * HALF + wr * 64 + m * 16 + fr);
#pragma unroll
                    for (int bj = 0; bj < 2; ++bj) {
                        float v[8];
#pragma unroll
                        for (int n = 0; n < 2; ++n)
#pragma unroll
                            for (int i = 0; i < 4; ++i) { const float x = acc[ai][bj][m][n][i] * rs, l = lb[bj][4 * n + i]; v[4 * n + i] = __builtin_amdgcn_logf(l + (1.0f - l) * sigmoidf_(x)); }
                        float* op = LF + (size_t)row * 1024 + col0 + bj * HALF; *(f32x4*)op = (f32x4){v[0], v[1], v[2], v[3]}; *(f32x4*)(op + 4) = (f32x4){v[4], v[5], v[6], v[7]};
                    }
                }
        } else {
            bf16_t* O = Qs + (kind ? ((size_t)(64 + 64 * kind) << 19) : (size_t)0);
            const bool act = kind != 2;
#pragma unroll
            for (int ai = 0; ai < 2; ++ai)
#pragma unroll
                for (int m = 0; m < 4; ++m) {
                    const int row = row0 + ai * HALF + m * 16; const float rs = rs_lookup(rt, u, ai * HALF + wr * 64 + m * 16 + fr);
#pragma unroll
                    for (int bj = 0; bj < 2; ++bj) {
                        float v[8];
#pragma unroll
                        for (int n = 0; n < 2; ++n)
#pragma unroll
                            for (int i = 0; i < 4; ++i) { const float x = acc[ai][bj][m][n][i] * rs; v[4 * n + i] = act ? siluf_(x) : x; }
                        u32x4 w; w.x = cvt_pk_bf16(v[0], v[1]); w.y = cvt_pk_bf16(v[2], v[3]); w.z = cvt_pk_bf16(v[4], v[5]); w.w = cvt_pk_bf16(v[6], v[7]);
                        *(u32x4*)(O + (size_t)row * 1024 + col0 + bj * HALF) = w;
                    }
                }
        }
    }
};
template <class Epi, class Sched, bool ALIGN_EPI = false, bool SP2 = false>
__device__ __forceinline__ void gemm_phase(PG8_LAS unsigned char* lds, const Gemm g, const Sched& S, const Epi& E) {
    const int tid = threadIdx.x, wid = __builtin_amdgcn_readfirstlane(tid >> 6), lane = tid & 63, wr = wid >> 2, wc = wid & 3, fr = lane & 15, fq = lane >> 4;
    const int K = g.K, nt = K / BK;
    unsigned voffA[2], voffB[2];
#pragma unroll
    for (int i = 0; i < 2; ++i) { int R, C; stage_rc(tid * 16 + i * 8192, R, C); const int Rb = Epi::PERM ? ((R & ~31) + perm32(R & 31)) : R;
        voffA[i] = (unsigned)(R * K + C) * 2u; voffB[i] = (unsigned)(Rb * K + C) * 2u; }
    const size_t kstep = (size_t)(BK * 2);
    const size_t hstep = (size_t)HALF * K * 2;
    const size_t tstep = 2 * hstep;
    const unsigned ldsw = (unsigned)wid * 1024u;
    const int aoff = lds_byte(wr * 64 + fr, fq * 8), boff = lds_byte(wc * 32 + fr, fq * 8);
#define PG8_SA(b, h) (((b) * 2 + (h)) * HTB)
#define PG8_SB(b, h) ((4 + (b) * 2 + (h)) * HTB)
#define PG8_STAGE(bufoff, gbase, voff) do { _Pragma("unroll") for (int _i = 0; _i < 2; ++_i) \
        __builtin_amdgcn_global_load_lds((const unsigned*)((const char*)(gbase) + (voff)[_i]), (PG8_LAS unsigned*)(lds + (bufoff) + ldsw + _i * 8192), 16, 0, 0); } while (0)
#define PG8_LDA(dst, b, h) do { _Pragma("unroll") for (int m = 0; m < 4; ++m) _Pragma("unroll") for (int k = 0; k < 2; ++k) dst[m][k] = *(const PG8_LAS bf16x8*)(lds + PG8_SA(b, h) + aoff + m * 2048 + k * 1024); } while (0)
#define PG8_LDB(dst, b, h) do { _Pragma("unroll") for (int n = 0; n < 2; ++n) _Pragma("unroll") for (int k = 0; k < 2; ++k) dst[n][k] = *(const PG8_LAS bf16x8*)(lds + PG8_SB(b, h) + boff + n * 2048 + k * 1024); } while (0)
#define PG8_MMA(ai, bj, At, Bt) do { __builtin_amdgcn_s_setprio(1); _Pragma("unroll") for (int m = 0; m < 4; ++m) _Pragma("unroll") for (int n = 0; n < 2; ++n) _Pragma("unroll") for (int k = 0; k < 2; ++k) \
        acc[ai][bj][m][n] = __builtin_amdgcn_mfma_f32_16x16x32_bf16(Bt[n][k], At[m][k], acc[ai][bj][m][n], 0, 0, 0); __builtin_amdgcn_s_setprio(0); } while (0)
#define PG8_WAIT_V(n) asm volatile("s_waitcnt vmcnt(" #n ")" ::: "memory")
#define PG8_WAIT_L(n) asm volatile("s_waitcnt lgkmcnt(" #n ")" ::: "memory")
#define PG8_BAR __builtin_amdgcn_s_barrier()
#define PG8_SCHED __builtin_amdgcn_sched_barrier(0)
    Unit cur, nxt; int ui = 0;
    if (!S.next(0, cur)) return;
    f32x4 acc[2][2][4][2];
#pragma unroll
    for (int a = 0; a < 2; ++a)
#pragma unroll
        for (int b = 0; b < 2; ++b)
#pragma unroll
            for (int m = 0; m < 4; ++m)
#pragma unroll
                for (int n = 0; n < 2; ++n) acc[a][b][m][n] = (f32x4){0.f, 0.f, 0.f, 0.f};
    bf16x8 At[4][2], B0[2][2], B1[2][2];
    const char* cA = (const char*)g.A + (size_t)cur.pm * tstep; const char* cB = (const char*)g.Bt + (size_t)cur.pn * tstep;
    S.a_ready(cur);
    if constexpr (SP2) {
        PG8_STAGE(PG8_SB(0, 0), cB, voffB); PG8_STAGE(PG8_SB(0, 1), cB + hstep, voffB); PG8_STAGE(PG8_SA(0, 0), cA, voffA); PG8_STAGE(PG8_SA(0, 1), cA + hstep, voffA);
        if (wr == 1) PG8_BAR;
        PG8_WAIT_V(2); PG8_BAR;
        PG8_STAGE(PG8_SB(1, 0), cB + kstep, voffB); PG8_STAGE(PG8_SA(1, 0), cA + kstep, voffA); PG8_STAGE(PG8_SB(1, 1), cB + hstep + kstep, voffB);
        PG8_WAIT_V(6); PG8_BAR;
    } else {
        PG8_STAGE(PG8_SB(0, 0), cB, voffB); PG8_STAGE(PG8_SA(0, 0), cA, voffA); PG8_STAGE(PG8_SB(0, 1), cB + hstep, voffB); PG8_STAGE(PG8_SA(0, 1), cA + hstep, voffA);
        if (wr == 1) PG8_BAR;
        PG8_WAIT_V(4); PG8_BAR;
        PG8_STAGE(PG8_SB(1, 0), cB + kstep, voffB); PG8_STAGE(PG8_SA(1, 0), cA + kstep, voffA); PG8_STAGE(PG8_SB(1, 1), cB + hstep + kstep, voffB);
        PG8_WAIT_V(6); PG8_BAR;
    }
    for (;;) {
        const bool has_next = S.next(ui + 1, nxt);
        const char* nA = has_next ? (const char*)g.A + (size_t)nxt.pm * tstep : cA; const char* nB = has_next ? (const char*)g.Bt + (size_t)nxt.pn * tstep : cB;
        for (int t = 0; t < nt; t += 2) {
            const bool last = (t == nt - 2);
            const char* a1 = cA + (size_t)(t + 1) * kstep;
            const char* a2 = last ? nA : cA + (size_t)(t + 2) * kstep; const char* b2 = last ? nB : cB + (size_t)(t + 2) * kstep;
            const char* a3 = a2 + kstep; const char* b3 = b2 + kstep;
            if (last && has_next) S.a_ready(nxt);
            if constexpr (SP2) {
            PG8_LDB(B0, 0, 0); PG8_LDB(B1, 0, 1); PG8_SCHED; PG8_LDA(At, 0, 0); PG8_STAGE(PG8_SA(1, 1), a1 + hstep, voffA);
            PG8_WAIT_V(8); PG8_WAIT_L(0); PG8_BAR; PG8_MMA(0, 0, At, B0); PG8_MMA(0, 1, At, B1); PG8_BAR; PG8_SCHED;
            PG8_LDA(At, 0, 1); PG8_STAGE(PG8_SB(0, 0), b2, voffB); PG8_STAGE(PG8_SB(0, 1), b2 + hstep, voffB); PG8_STAGE(PG8_SA(0, 0), a2, voffA);
            PG8_WAIT_V(8); PG8_WAIT_L(0); PG8_BAR; PG8_MMA(1, 0, At, B0); PG8_MMA(1, 1, At, B1); PG8_BAR; PG8_SCHED;
            PG8_LDB(B0, 1, 0); PG8_LDB(B1, 1, 1); PG8_SCHED; PG8_LDA(At, 1, 0); PG8_STAGE(PG8_SA(0, 1), a2 + hstep, voffA);
            PG8_WAIT_V(8); PG8_WAIT_L(0); PG8_BAR; PG8_MMA(0, 0, At, B0); PG8_MMA(0, 1, At, B1); PG8_BAR; PG8_SCHED;
            PG8_LDA(At, 1, 1); PG8_STAGE(PG8_SB(1, 0), b3, voffB); PG8_STAGE(PG8_SB(1, 1), b3 + hstep, voffB); PG8_STAGE(PG8_SA(1, 0), a3, voffA);
            PG8_WAIT_V(8); PG8_WAIT_L(0); PG8_BAR; PG8_MMA(1, 0, At, B0); PG8_MMA(1, 1, At, B1); PG8_BAR; PG8_SCHED;
            } else {
            PG8_LDB(B0, 0, 0); PG8_SCHED; PG8_LDA(At, 0, 0); PG8_STAGE(PG8_SA(1, 1), a1 + hstep, voffA);
            PG8_WAIT_L(8); PG8_BAR; PG8_WAIT_L(0); PG8_MMA(0, 0, At, B0); PG8_BAR; PG8_SCHED;
            PG8_LDB(B1, 0, 1); PG8_STAGE(PG8_SB(0, 0), b2, voffB);
            PG8_BAR; PG8_WAIT_L(0); PG8_MMA(0, 1, At, B1); PG8_BAR;
            PG8_LDA(At, 0, 1); PG8_STAGE(PG8_SA(0, 0), a2, voffA);
            PG8_BAR; PG8_WAIT_L(0); PG8_MMA(1, 0, At, B0); PG8_BAR; PG8_SCHED;
            PG8_STAGE(PG8_SB(0, 1), b2 + hstep, voffB);
            PG8_WAIT_V(6); PG8_BAR; PG8_MMA(1, 1, At, B1); PG8_BAR;
            PG8_LDB(B0, 1, 0); PG8_SCHED; PG8_LDA(At, 1, 0); PG8_STAGE(PG8_SA(0, 1), a2 + hstep, voffA);
            PG8_WAIT_L(8); PG8_BAR; PG8_WAIT_L(0); PG8_MMA(0, 0, At, B0); PG8_BAR; PG8_SCHED;
            PG8_LDB(B1, 1, 1); PG8_STAGE(PG8_SB(1, 0), b3, voffB);
            PG8_BAR; PG8_WAIT_L(0); PG8_MMA(0, 1, At, B1); PG8_BAR;
            PG8_LDA(At, 1, 1); PG8_STAGE(PG8_SA(1, 0), a3, voffA);
            PG8_BAR; PG8_WAIT_L(0); PG8_MMA(1, 0, At, B0); PG8_BAR; PG8_SCHED;
            PG8_STAGE(PG8_SB(1, 1), b3 + hstep, voffB);
            PG8_WAIT_V(6); PG8_BAR; PG8_MMA(1, 1, At, B1); PG8_BAR;
            }
        }
        if constexpr (ALIGN_EPI) { if (wr == 0) PG8_BAR; }
        if constexpr (!Epi::AFTER_DRAIN) { E(acc, cur, wr, wc, fr, fq, E.pre(cur, wr, lane)); S.done(cur); }
        if (!has_next) break;
#pragma unroll
        for (int a = 0; a < 2; ++a)
#pragma unroll
            for (int b = 0; b < 2; ++b)
#pragma unroll
                for (int m = 0; m < 4; ++m)
#pragma unroll
                    for (int n = 0; n < 2; ++n) acc[a][b][m][n] = (f32x4){0.f, 0.f, 0.f, 0.f};
        cur = nxt; cA = nA; cB = nB; ++ui;
        if constexpr (ALIGN_EPI) { if (wr == 1) PG8_BAR; }
    }
    PG8_WAIT_V(0);
    if constexpr (!ALIGN_EPI) { if (wr == 0) PG8_BAR; }
    PG8_BAR;
    if constexpr (Epi::AFTER_DRAIN) { E.fused(acc, cur, wr, wc, fr, fq, lds, wid, lane); S.done(cur); }
#undef PG8_SA
#undef PG8_SB
#undef PG8_STAGE
#undef PG8_LDA
#undef PG8_LDB
#undef PG8_MMA
#undef PG8_WAIT_V
#undef PG8_WAIT_L
#undef PG8_BAR
#undef PG8_SCHED
}
}
using pg8::bf16_t; using pg8::bf16x8; using pg8::f32x4; using pg8::u32x4;
typedef float f32x16 __attribute__((ext_vector_type(16)));
typedef short s16x4 __attribute__((ext_vector_type(4)));
typedef unsigned u32x2 __attribute__((ext_vector_type(2)));
#define LAS __attribute__((address_space(3)))
constexpr int NWAVES = 8, NTHREADS = 512;
constexpr int BATCH = 8, SEQ = 4096, D = 1024, FF = 2816, M = BATCH * SEQ;
constexpr float QSCALE = 0.125f * 1.4426950408889634f;
constexpr size_t MiB = 1u << 20;
constexpr size_t WS_GU = 1 * MiB;
constexpr size_t WS_DN = WS_GU + 44 * MiB;
constexpr size_t WS_ABIN = WS_DN + 22 * MiB;
constexpr size_t WS_ABOUT = WS_ABIN + 6 * MiB;
constexpr size_t WS_CIN = WS_ABOUT + 2 * MiB;
constexpr size_t WS_COUT = WS_CIN + 8 * MiB;
constexpr size_t WS_H = WS_COUT + 2 * MiB;
constexpr size_t WS_SS = WS_H + 64 * MiB;
constexpr size_t WS_R = WS_SS + 14 * MiB;
constexpr size_t WS_HID = WS_R, WS_PROJ = WS_R, WS_Y = WS_R + 192 * MiB;
constexpr size_t WS_QS = WS_R, WS_LF = WS_R + 64 * MiB, WS_IV = WS_R + 192 * MiB, WS_GS = WS_R + 256 * MiB;
constexpr size_t WS_END = WS_R + 320 * MiB;
static_assert(WS_END <= 512 * MiB, "workspace map");
constexpr int LDS_BYTES = 147456;

__device__ __forceinline__ unsigned f2bf(float f) { unsigned u = __builtin_bit_cast(unsigned, f); return (u + 0x7fffu + ((u >> 16) & 1u)) >> 16; }
__device__ __forceinline__ unsigned pk2(float lo, float hi) { return pg8::cvt_pk_bf16(lo, hi); }
__device__ __forceinline__ float wave_sum(float v) {
#pragma unroll
    for (int o = 1; o < 64; o <<= 1) v += __shfl_xor(v, o);
    return v;
}
constexpr int P0_SCR = 64 * 65 * 4;
__device__ __forceinline__ void p0_transpose_item(const float* W, int K, int N, const float* gain, bf16_t* WT, int k0, int n0, int orow0, LAS float* scr, int lane) {
    const int lr = lane >> 4, lc = (lane & 15) * 4;
    f32x4 v[16];
#pragma unroll
    for (int j = 0; j < 16; ++j) v[j] = __builtin_nontemporal_load((const f32x4*)(W + (size_t)(k0 + 4 * j + lr) * N + n0 + lc));
    if (gain) {
#pragma unroll
        for (int j = 0; j < 16; ++j) v[j] = v[j] * gain[k0 + 4 * j + lr];
    }
#pragma unroll
    for (int j = 0; j < 16; ++j) { LAS float* d = scr + (4 * j + lr) * 65 + lc; d[0] = v[j][0]; d[1] = v[j][1]; d[2] = v[j][2]; d[3] = v[j][3]; }
    asm volatile("s_waitcnt lgkmcnt(0)" ::: "memory");
    const int c = lane & 7;
#pragma unroll
    for (int j = 0; j < 8; ++j) { const int n = (lane >> 3) + 8 * j; const LAS float* s = scr + (8 * c) * 65 + n;
        u32x4 o; o.x = pk2(s[0 * 65], s[1 * 65]); o.y = pk2(s[2 * 65], s[3 * 65]); o.z = pk2(s[4 * 65], s[5 * 65]); o.w = pk2(s[6 * 65], s[7 * 65]);
        *(u32x4*)(WT + (size_t)(orow0 + n) * K + k0 + 8 * c) = o; }
    asm volatile("s_waitcnt lgkmcnt(0)" ::: "memory");
}
struct Ptrs {
    const float* in[18]; float* out; unsigned char* ws;
};
__device__ __forceinline__ void p0_prologue(const Ptrs& P, LAS unsigned char* lds, int gw, int NGW, int wave, int lane) {
    unsigned char* ws = P.ws;
    const float* x = P.in[0]; bf16_t* H = (bf16_t*)(ws + WS_H); float* ss0 = (float*)(ws + WS_SS);
    for (int m0 = gw * 4; m0 < M; m0 += NGW * 4) {
        f32x4 v[4][4];
#pragma unroll
        for (int r = 0; r < 4; ++r)
#pragma unroll
            for (int j = 0; j < 4; ++j) v[r][j] = __builtin_nontemporal_load((const f32x4*)(x + (size_t)(m0 + r) * D) + lane + 64 * j);
#pragma unroll
        for (int r = 0; r < 4; ++r) {
            float s = 0.f;
#pragma unroll
            for (int j = 0; j < 4; ++j) s += (v[r][j][0] * v[r][j][0] + v[r][j][1] * v[r][j][1]) + (v[r][j][2] * v[r][j][2] + v[r][j][3] * v[r][j][3]);
            s = wave_sum(s);
            u32x2* o8 = (u32x2*)(H + (size_t)(m0 + r) * D) + lane;
#pragma unroll
            for (int j = 0; j < 4; ++j) { u32x2 w; w.x = pk2(v[r][j][0], v[r][j][1]); w.y = pk2(v[r][j][2], v[r][j][3]); o8[64 * j] = w; }
            if (lane < 16) ss0[(size_t)(m0 + r) * 16 + lane] = lane == 0 ? s : 0.f;
        }
    }
    LAS float* scr = (LAS float*)(lds + wave * P0_SCR);
    constexpr int I_FFN = 704;
    constexpr int I_ABIN = 16 * 48, I_ABOUT = 16 * 16, I_CIN = 16 * 64, I_COUT = 16 * 16;
    constexpr int NITEMS = 12 * I_FFN + I_ABIN + I_ABOUT + I_CIN + I_COUT;
    for (int it = gw; it < NITEMS; it += NGW) {
        int r = it;
        if (r < 12 * I_FFN) {
            const int mat = r / I_FFN, item = r % I_FFN, f = mat / 3, type = mat % 3;
            const int layer = f >> 1, post = f & 1;
            if (type < 2) {
                const float* Wg = post ? P.in[7] : P.in[2]; const float* Wu = post ? P.in[8] : P.in[3]; const float* W = (type == 0 ? Wg : Wu) + (size_t)layer * D * FF;
                const float* gain = (post ? P.in[6] : P.in[1]) + layer * D;
                const int nblk = FF / 64, kb = item / nblk, nb = item % nblk, n0 = 64 * nb;
                const int orow0 = (n0 >> 7) * 256 + (n0 & 127) + (type == 1 ? 128 : 0);
                p0_transpose_item(W, D, FF, gain, (bf16_t*)(ws + WS_GU) + (size_t)f * 5632 * 1024, 64 * kb, n0, orow0, scr, lane);
            } else {
                const float* W = (post ? P.in[9] : P.in[4]) + (size_t)layer * FF * D;
                const int nblk = D / 64, kb = item / nblk, nb = item % nblk, n0 = 64 * nb;
                p0_transpose_item(W, FF, D, nullptr, (bf16_t*)(ws + WS_DN) + (size_t)f * 1024 * 2816, 64 * kb, n0, n0, scr, lane);
            }
            continue;
        }
        r -= 12 * I_FFN;
        if (r < I_ABIN) { const int nblk = 48, kb = r / nblk, nb = r % nblk; p0_transpose_item(P.in[10], D, 3072, P.in[5], (bf16_t*)(ws + WS_ABIN), 64 * kb, 64 * nb, 64 * nb, scr, lane); continue; }
        r -= I_ABIN;
        if (r < I_ABOUT) { const int nblk = 16, kb = r / nblk, nb = r % nblk; p0_transpose_item(P.in[12], D, D, nullptr, (bf16_t*)(ws + WS_ABOUT), 64 * kb, 64 * nb, 64 * nb, scr, lane); continue; }
        r -= I_ABOUT;
        if (r < I_CIN) { const int nblk = 64, kb = r / nblk, nb = r % nblk; p0_transpose_item(P.in[13], D, 4096, P.in[5] + D, (bf16_t*)(ws + WS_CIN), 64 * kb, 64 * nb, 64 * nb, scr, lane); continue; }
        r -= I_CIN;
        { const int nblk = 16, kb = r / nblk, nb = r % nblk; p0_transpose_item(P.in[16], D, D, nullptr, (bf16_t*)(ws + WS_COUT), 64 * kb, 64 * nb, 64 * nb, scr, lane); }
    }
}
__device__ __forceinline__ void final_norm(const Ptrs& P, int gw, int NGW, int lane) {
    const float* ss = (const float*)(P.ws + WS_SS) + (size_t)6 * M * 16; const float* gain = P.in[17]; const bf16_t* H = (const bf16_t*)(P.ws + WS_H);
    f32x4 g[4];
#pragma unroll
    for (int j = 0; j < 4; ++j) g[j] = ((const f32x4*)gain)[lane + 64 * j];
    for (int m0 = gw * 4; m0 < M; m0 += NGW * 4) {
        u32x2 w[4][4]; float rs[4];
#pragma unroll
        for (int r = 0; r < 4; ++r) { rs[r] = pg8::row_rstd(ss, m0 + r);
#pragma unroll
            for (int j = 0; j < 4; ++j) w[r][j] = ((const u32x2*)(H + (size_t)(m0 + r) * D))[lane + 64 * j]; }
#pragma unroll
        for (int r = 0; r < 4; ++r) { f32x4* orow = (f32x4*)(P.out + (size_t)(m0 + r) * D) + lane;
#pragma unroll
            for (int j = 0; j < 4; ++j) { const f32x4 v = (f32x4){pg8::bf_lo(w[r][j].x), pg8::bf_hi(w[r][j].x), pg8::bf_lo(w[r][j].y), pg8::bf_hi(w[r][j].y)}; __builtin_nontemporal_store(v * rs[r] * g[j], orow + 64 * j); } }
    }
}
#define XB_TMO      128
#define XB_XCNT(j)  (256  + 64 * (j))
#define XB_XSUB(j)  (1280 + 64 * (j))
#define XB_XGEN(j)  (2304 + 64 * (j))
#define XB_TOP      3328
#define XB_TOPGEN   3392
#define XCD_BAR_WORDS 3456
#define XB_SPIN_CAP (1u << 18)

__device__ __forceinline__ unsigned xb_ld(unsigned* p)              { return __hip_atomic_load(p, __ATOMIC_RELAXED, __HIP_MEMORY_SCOPE_AGENT); }
__device__ __forceinline__ unsigned xb_add(unsigned* p, unsigned v) { return __hip_atomic_fetch_add(p, v, __ATOMIC_RELAXED, __HIP_MEMORY_SCOPE_AGENT); }
__device__ __forceinline__ unsigned xb_xcc_id() { return (unsigned)__builtin_amdgcn_s_getreg((3 << 11) | 20) & 0xFu; }
#define XB_SPIN(cond, bar) do { unsigned _sp = 0; while (cond) { __builtin_amdgcn_s_sleep(1); \
    if ((++_sp & 255u) == 0u) { if (xb_ld(&(bar)[XB_TMO])) break; if (_sp > XB_SPIN_CAP) { atomicAdd(&(bar)[XB_TMO], 1u); break; } } } } while (0)

struct XcdBarrier {
    unsigned* bar; unsigned x;
    volatile LAS unsigned* st;
};

__device__ __forceinline__ XcdBarrier xcd_barrier_post(unsigned* bar, volatile LAS unsigned* st) {
    XcdBarrier b; b.bar = bar; b.x = xb_xcc_id(); b.st = st;
    if (threadIdx.x == 0) (void)xb_add(&bar[XB_XCNT(b.x)], 1u);
    return b;
}
__device__ __forceinline__ void xcd_barrier_complete(unsigned* bar, unsigned x, unsigned& nloc, unsigned& nx) {
    const unsigned G = gridDim.x * gridDim.y * gridDim.z;
    unsigned sum, cnt, mine, sp = 0u;
    for (;;) {
        sum = 0u; cnt = 0u; mine = 0u;
#pragma unroll
        for (unsigned j = 0; j < 16; ++j) { const unsigned c = xb_ld(&bar[XB_XCNT(j)]); sum += c; cnt += (c > 0u) ? 1u : 0u; mine = (j == x) ? c : mine; }
        if (sum == G) break;
        __builtin_amdgcn_s_sleep(1);
        if ((++sp & 255u) == 0u) { if (xb_ld(&bar[XB_TMO])) break; if (sp > XB_SPIN_CAP) { atomicAdd(&bar[XB_TMO], 1u); break; } }
    }
    nloc = mine > 0u ? mine : 1u; nx = cnt > 0u ? cnt : 1u;
}

__device__ __forceinline__ void xcd_barrier(const XcdBarrier& b) {
    asm volatile("s_waitcnt vmcnt(0)" ::: "memory");
    __syncthreads();
    if (threadIdx.x == 0) {
        unsigned* bar = b.bar;
        __builtin_amdgcn_s_waitcnt(0);
        unsigned nloc = b.st[0], nx = b.st[1];
        if (nloc == 0u) { xcd_barrier_complete(bar, b.x, nloc, nx); b.st[0] = nloc; b.st[1] = nx; }
        const unsigned old = xb_add(&bar[XB_XSUB(b.x)], 1u);
        const unsigned gen = old / nloc;
        if (old + 1u == (gen + 1u) * nloc) {
            __builtin_amdgcn_fence(__ATOMIC_RELEASE, "agent");
            asm volatile("s_waitcnt vmcnt(0)" ::: "memory");
            const unsigned og = xb_add(&bar[XB_TOP], 1u);
            const unsigned tg = og / nx;
            if (og + 1u == (tg + 1u) * nx) xb_add(&bar[XB_TOPGEN], 1u);
            else XB_SPIN(xb_ld(&bar[XB_TOPGEN]) == tg, bar);
            __builtin_amdgcn_fence(__ATOMIC_ACQUIRE, "agent");
            xb_add(&bar[XB_XGEN(b.x)], 1u);
            asm volatile("s_waitcnt vmcnt(0)" ::: "memory");
        } else {
            XB_SPIN(xb_ld(&bar[XB_XGEN(b.x)]) == gen, bar);
            __builtin_amdgcn_fence(__ATOMIC_ACQUIRE, "agent");
            asm volatile("s_waitcnt vmcnt(0)" ::: "memory");
        }
    }
    __syncthreads();
}
__device__ __forceinline__ void unpack8(const u32x4 w, float (&v)[8]) {
    v[0] = pg8::bf_lo(w.x); v[1] = pg8::bf_hi(w.x); v[2] = pg8::bf_lo(w.y); v[3] = pg8::bf_hi(w.y); v[4] = pg8::bf_lo(w.z); v[5] = pg8::bf_hi(w.z); v[6] = pg8::bf_lo(w.w); v[7] = pg8::bf_hi(w.w);
}
__device__ __forceinline__ void conv_item(const bf16_t* PROJ, const float* cw, bf16_t* Y, int item, int lane) {
    const int r0 = item * 16, c0 = lane * 8;
    float w0[8], w1[8], w2[8];
#pragma unroll
    for (int j = 0; j < 8; ++j) { w0[j] = cw[c0 + j]; w1[j] = cw[512 + c0 + j]; w2[j] = cw[1024 + c0 + j]; }
    float um1[8], um2[8];
#pragma unroll
    for (int j = 0; j < 8; ++j) { um1[j] = 0.f; um2[j] = 0.f; }
    if ((r0 & (SEQ - 1)) != 0) {
        float a[8], b[8];
        const bf16_t* p2 = PROJ + (size_t)(r0 - 2) * 3072 + c0; unpack8(*(const u32x4*)(p2 + 512), a); unpack8(*(const u32x4*)(p2 + 1024), b);
#pragma unroll
        for (int j = 0; j < 8; ++j) um2[j] = a[j] * b[j];
        const bf16_t* p1 = PROJ + (size_t)(r0 - 1) * 3072 + c0; unpack8(*(const u32x4*)(p1 + 512), a); unpack8(*(const u32x4*)(p1 + 1024), b);
#pragma unroll
        for (int j = 0; j < 8; ++j) um1[j] = a[j] * b[j];
    }
#pragma unroll 4
    for (int r = 0; r < 16; ++r) {
        const bf16_t* p = PROJ + (size_t)(r0 + r) * 3072 + c0;
        float g[8], a[8], b[8], o[8];
        unpack8(*(const u32x4*)p, g); unpack8(*(const u32x4*)(p + 512), a); unpack8(*(const u32x4*)(p + 1024), b);
#pragma unroll
        for (int j = 0; j < 8; ++j) { const float u = a[j] * b[j]; o[j] = g[j] * (w0[j] * um2[j] + w1[j] * um1[j] + w2[j] * u); um2[j] = um1[j]; um1[j] = u; }
        u32x4 w; w.x = pk2(o[0], o[1]); w.y = pk2(o[2], o[3]); w.z = pk2(o[4], o[5]); w.w = pk2(o[6], o[7]);
        *(u32x4*)(Y + (size_t)(r0 + r) * 1024 + c0) = w;
    }
}
__device__ __forceinline__ s16x4 vtr(const LAS unsigned char* p) { typedef short v4i16_t __attribute__((ext_vector_type(4))); return __builtin_bit_cast(s16x4, __builtin_amdgcn_ds_read_tr16_b64_v4i16((LAS v4i16_t*)p)); }
__device__ __forceinline__ bf16x8 cat8(s16x4 a, s16x4 b) { bf16x8 r; r[0] = a[0]; r[1] = a[1]; r[2] = a[2]; r[3] = a[3]; r[4] = b[0]; r[5] = b[1]; r[6] = b[2]; r[7] = b[3]; return r; }
constexpr int AV_STRIDE = 144;
__device__ __forceinline__ void attn_unit(const bf16_t* PROJ, bf16_t* Y, int b, int h, int qb, LAS unsigned char* vlds, int lane) {
    const int r32 = lane & 31, hi = lane >> 5;
    const size_t rowbase = (size_t)b * SEQ;
    const int t0 = qb * 32;
    bf16x8 qf[4];
    { const bf16_t* qp = PROJ + (rowbase + t0 + r32) * 3072 + 1536 + h * 64 + 8 * hi;
#pragma unroll
      for (int kk = 0; kk < 4; ++kk) qf[kk] = *(const bf16x8*)(qp + 16 * kk); }
    f32x16 o0, o1;
#pragma unroll
    for (int i = 0; i < 16; ++i) { o0[i] = 0.f; o1[i] = 0.f; }
    float carry = 0.f;
    const int g4 = lane >> 4, li = lane & 15;
    const LAS unsigned char* trbase = vlds + (4 * (g4 >> 1) + (li >> 2)) * AV_STRIDE + (16 * (g4 & 1) + 4 * (li & 3)) * 2;
    bf16x8 kf[4]; u32x4 vr[4];
#define AT_LOAD(KF, VR, K0) do { const bf16_t* kp_ = PROJ + (rowbase + (K0) + r32) * 3072 + 2048 + h * 64 + 8 * hi; \
        _Pragma("unroll") for (int kk = 0; kk < 4; ++kk) KF[kk] = *(const bf16x8*)(kp_ + 16 * kk); \
        _Pragma("unroll") for (int j = 0; j < 4; ++j) VR[j] = *(const u32x4*)(PROJ + (rowbase + (K0) + (lane >> 3) + 8 * j) * 3072 + 2560 + h * 64 + 8 * (lane & 7)); } while (0)
    AT_LOAD(kf, vr, t0);
    for (int kt = qb; kt >= 0; --kt) {
#pragma unroll
        for (int j = 0; j < 4; ++j) *(LAS u32x4*)(vlds + ((lane >> 3) + 8 * j) * AV_STRIDE + 16 * (lane & 7)) = vr[j];
        bf16x8 kfn[4]; u32x4 vrn[4];
#pragma unroll
        for (int j = 0; j < 4; ++j) { kfn[j] = kf[j]; vrn[j] = vr[j]; }
        if (kt > 0) AT_LOAD(kfn, vrn, (kt - 1) * 32);
        f32x16 sc;
#pragma unroll
        for (int i = 0; i < 16; ++i) sc[i] = 0.f;
#pragma unroll
        for (int kk = 0; kk < 4; ++kk) sc = __builtin_amdgcn_mfma_f32_32x32x16_bf16(kf[kk], qf[kk], sc, 0, 0, 0);
        const bool diag = (kt == qb);
        float lk[16], lb[16];
#pragma unroll
        for (int r = 0; r < 16; ++r) {
            const float z = sc[r], az = __builtin_fabsf(z);
            const float L = __builtin_amdgcn_logf(1.0f + __builtin_amdgcn_exp2f(-az));
            float lbv = __builtin_fminf(z, 0.f) - L, lkv = lbv - z;
            if (diag) { const int key = (r & 3) + 8 * (r >> 2) + 4 * hi; if (!(key < r32)) { lkv = 0.f; lbv = -1.0e30f; } }
            lk[r] = lkv; lb[r] = lbv;
        }
        float gs[4], pg[4], T[4];
#pragma unroll
        for (int j = 0; j < 4; ++j) { gs[j] = (lk[4 * j] + lk[4 * j + 1]) + (lk[4 * j + 2] + lk[4 * j + 3]); pg[j] = __shfl_xor(gs[j], 32); T[j] = gs[j] + pg[j]; }
        float w[16];
        float suf = carry;
#pragma unroll
        for (int j = 3; j >= 0; --j) {
            float run = suf + (hi == 0 ? pg[j] : 0.f);
#pragma unroll
            for (int i = 3; i >= 0; --i) { w[4 * j + i] = __builtin_amdgcn_exp2f(lb[4 * j + i] + run); run += lk[4 * j + i]; }
            suf += T[j];
        }
        carry = suf;
        u32x4 p0, p1;
        p0.x = pk2(w[0], w[1]); p0.y = pk2(w[2], w[3]); p0.z = pk2(w[4], w[5]); p0.w = pk2(w[6], w[7]);
        p1.x = pk2(w[8], w[9]); p1.y = pk2(w[10], w[11]); p1.z = pk2(w[12], w[13]); p1.w = pk2(w[14], w[15]);
        const bf16x8 pf0 = __builtin_bit_cast(bf16x8, p0), pf1 = __builtin_bit_cast(bf16x8, p1);
        asm volatile("s_waitcnt lgkmcnt(0)" ::: "memory");
        const bf16x8 v00 = cat8(vtr(trbase), vtr(trbase + 8 * AV_STRIDE));
        const bf16x8 v01 = cat8(vtr(trbase + 16 * AV_STRIDE), vtr(trbase + 24 * AV_STRIDE));
        const bf16x8 v10 = cat8(vtr(trbase + 64), vtr(trbase + 8 * AV_STRIDE + 64));
        const bf16x8 v11 = cat8(vtr(trbase + 16 * AV_STRIDE + 64), vtr(trbase + 24 * AV_STRIDE + 64));
        o0 = __builtin_amdgcn_mfma_f32_32x32x16_bf16(v00, pf0, o0, 0, 0, 0);
        o0 = __builtin_amdgcn_mfma_f32_32x32x16_bf16(v01, pf1, o0, 0, 0, 0);
        o1 = __builtin_amdgcn_mfma_f32_32x32x16_bf16(v10, pf0, o1, 0, 0, 0);
        o1 = __builtin_amdgcn_mfma_f32_32x32x16_bf16(v11, pf1, o1, 0, 0, 0);
        if (__builtin_amdgcn_ballot_w64(carry > -160.0f) == 0ull) break;
#pragma unroll
        for (int j = 0; j < 4; ++j) { kf[j] = kfn[j]; vr[j] = vrn[j]; }
    }
#undef AT_LOAD
    bf16_t* yp = Y + (rowbase + t0 + r32) * 1024 + 512 + h * 64 + 4 * hi;
#pragma unroll
    for (int j = 0; j < 4; ++j) {
        u32x2 a; a.x = pk2(o0[4 * j], o0[4 * j + 1]); a.y = pk2(o0[4 * j + 2], o0[4 * j + 3]); *(u32x2*)(yp + 8 * j) = a;
        u32x2 c; c.x = pk2(o1[4 * j], o1[4 * j + 1]); c.y = pk2(o1[4 * j + 2], o1[4 * j + 3]); *(u32x2*)(yp + 32 + 8 * j) = c;
    }
}
__device__ __forceinline__ void mix0_phase(const Ptrs& P, LAS unsigned char* lds, int gw, int NGW, int wave, int lane) {
    const bf16_t* PROJ = (const bf16_t*)(P.ws + WS_PROJ); bf16_t* Y = (bf16_t*)(P.ws + WS_Y);
    LAS unsigned char* vlds = lds + wave * 8192;
#ifndef DBG_NO_ATTN
    for (int it = gw; it < BATCH * 8 * (SEQ / 32); it += NGW) { const int bh = it / (SEQ / 32), qb = it % (SEQ / 32); attn_unit(PROJ, Y, bh >> 3, bh & 7, qb, vlds, lane); }
#else
    for (int m = gw; m < M; m += NGW) { *(u32x4*)(Y + (size_t)m * 1024 + 512 + 8 * lane) = (u32x4){0u, 0u, 0u, 0u}; }
#endif
    for (int it = gw; it < M / 16; it += NGW) conv_item(PROJ, P.in[11], Y, it, lane);
}
constexpr int HS = 272;
constexpr int HL_QT = 0, HL_KT = 64 * HS, HL_KH = 2 * 64 * HS, HL_V = 3 * 64 * HS, HL_V2 = 4 * 64 * HS, HL_OUT = 4 * 64 * HS;
constexpr int HSC = 144;
constexpr int HL_SC = 5 * 64 * HS, HL_SEG = HL_SC + 64 * HSC, HL_DEC = HL_SEG + 8 * 128 * 4, HL_OSQ = HL_DEC + 512, HL_END = HL_OSQ + 64 * 8 * 4;
static_assert(HL_END <= 131072, "hgrn LDS map");
constexpr size_t WS_DTOT = 256 * 1024;
constexpr int HG_NCH = 16;
#define HG_BAR() do { asm volatile("s_waitcnt lgkmcnt(0)" ::: "memory"); __builtin_amdgcn_s_barrier(); asm volatile("" ::: "memory"); } while (0)
#define MFMA16(a, b, c) __builtin_amdgcn_mfma_f32_16x16x32_bf16((a), (b), (c), 0, 0, 0)
typedef float f32x2v __attribute__((ext_vector_type(2)));
template <bool FULL>
__device__ __forceinline__ void hgrn_unit(const Ptrs& P, LAS unsigned char* lds, int bh, int sc, int tid, int wave, int lane) {
    const bf16_t* Qs = (const bf16_t*)(P.ws + WS_QS); const float* LF = (const float*)(P.ws + WS_LF); const bf16_t* Iv = (const bf16_t*)(P.ws + WS_IV); const bf16_t* Gs = (const bf16_t*)(P.ws + WS_GS);
    bf16_t* Ob = (bf16_t*)P.out;
    float* SLOC = (float*)((unsigned char*)P.out + 64 * MiB);
    float* DTOT = (float*)(P.ws + WS_DTOT);
    const int b = bh >> 3, h = bh & 7, hc = h * 128;
    const int fr = lane & 15, fq = lane >> 4;
    const int kp = lane, seg = wave;
    f32x4 S[8];
    if (FULL && sc > 0) {
        const float* sp = SLOC + ((size_t)(bh * 4) << 14) + (16 * wave + fr) * 4;
        const float* dp = DTOT + (bh * 4) * 128 + 4 * fq;
#pragma unroll
        for (int kt = 0; kt < 8; ++kt) S[kt] = *(const f32x4*)(sp + (4 * kt + fq) * 512);
        for (int j = 1; j < sc; ++j) {
#pragma unroll
            for (int kt = 0; kt < 8; ++kt) S[kt] = S[kt] * *(const f32x4*)(dp + j * 128 + 16 * kt) + *(const f32x4*)(sp + ((size_t)j << 14) + (4 * kt + fq) * 512);
        }
    } else {
#pragma unroll
        for (int kt = 0; kt < 8; ++kt) S[kt] = (f32x4){0.f, 0.f, 0.f, 0.f};
    }
    LAS float* segtot = (LAS float*)(lds + HL_SEG); LAS float* dec = (LAS float*)(lds + HL_DEC); LAS float* osq = (LAS float*)(lds + HL_OSQ);
    f32x4 on0, on1;
    if (FULL) { const float* onp = P.in[15] + 8 * (tid & 15); on0 = *(const f32x4*)onp; on1 = *(const f32x4*)(onp + 4); }
    float dprod0 = 1.f, dprod1 = 1.f;
    f32x2v lf2[8]; unsigned q2[8]; u32x4 vch[2], gch[2];
    const size_t Rbase = (size_t)b * SEQ + (size_t)sc * (64 * HG_NCH);
#define HG_LOAD_E(R0_) do { _Pragma("unroll") for (int i = 0; i < 8; ++i) { const size_t off = ((R0_) + 8 * seg + i) * 1024 + hc + 2 * kp; lf2[i] = *(const f32x2v*)(LF + off); if (FULL) q2[i] = *(const unsigned*)(Qs + off); } \
        _Pragma("unroll") for (int j = 0; j < 2; ++j) { const int ch = tid + 512 * j; vch[j] = *(const u32x4*)(Iv + ((R0_) + (ch >> 4)) * 1024 + hc + 8 * (ch & 15)); } } while (0)
#define HG_LOAD_G(R0_) do { _Pragma("unroll") for (int j = 0; j < 2; ++j) { const int ch = tid + 512 * j; gch[j] = *(const u32x4*)(Gs + ((R0_) + (ch >> 4)) * 1024 + hc + 8 * (ch & 15)); } } while (0)
    HG_LOAD_E(Rbase);
    if (FULL) HG_LOAD_G(Rbase);
#pragma unroll 1
    for (int c = 0; c < HG_NCH; ++c) {
        const size_t R0 = Rbase + (size_t)c * 64;
        const int vimg = FULL ? HL_V : ((c & 1) ? HL_V2 : HL_V);
        f32x2v cs[8]; { f32x2v run = (f32x2v){0.f, 0.f};
#pragma unroll
          for (int i = 0; i < 8; ++i) { run += lf2[i]; cs[i] = run; } }
        *(LAS f32x2v*)(segtot + seg * 128 + 2 * kp) = cs[7];
#pragma unroll
        for (int j = 0; j < 2; ++j) { const int ch = tid + 512 * j; *(LAS u32x4*)(lds + vimg + (ch >> 4) * HS + 16 * (ch & 15)) = vch[j]; }
        HG_BAR();
        f32x2v pre = (f32x2v){0.f, 0.f}, tot = (f32x2v){0.f, 0.f};
#pragma unroll
        for (int s2 = 0; s2 < 8; ++s2) { const f32x2v v = *(const LAS f32x2v*)(segtot + s2 * 128 + 2 * kp); tot += v; if (s2 < seg) pre += v; }
        const float dl0 = __builtin_amdgcn_exp2f(tot[0]), dl1 = __builtin_amdgcn_exp2f(tot[1]);
        if (seg == 0) { *(LAS f32x2v*)(dec + 2 * kp) = (f32x2v){dl0, dl1}; dprod0 *= dl0; dprod1 *= dl1; }
#pragma unroll
        for (int i = 0; i < 8; ++i) {
            const float b0 = pre[0] + cs[i][0], b1 = pre[1] + cs[i][1];
            const float k0 = (1.0f - __builtin_amdgcn_exp2f(lf2[i][0])) * __builtin_amdgcn_exp2f(-b0), k1 = (1.0f - __builtin_amdgcn_exp2f(lf2[i][1])) * __builtin_amdgcn_exp2f(-b1);
            const int o = (8 * seg + i) * HS + 4 * kp;
            *(LAS unsigned*)(lds + HL_KH + o) = pk2(k0 * dl0, k1 * dl1);
            if (FULL) {
                *(LAS unsigned*)(lds + HL_KT + o) = pk2(k0, k1);
                *(LAS unsigned*)(lds + HL_QT + o) = pk2(pg8::bf_lo(q2[i]) * __builtin_amdgcn_exp2f(b0), pg8::bf_hi(q2[i]) * __builtin_amdgcn_exp2f(b1));
            }
        }
        if (c < HG_NCH - 1) HG_LOAD_E(R0 + 64);
        HG_BAR();
        f32x4 o[4];
        bf16x8 vf[2];
        if (FULL) {
            { const int tt = wave >> 1;
#pragma unroll
              for (int e = 0; e < 2; ++e) { const int st = 2 * (wave & 1) + e; const int t = 16 * tt + fr, s0 = 16 * st + 4 * fq;
                  u32x2 w = (u32x2){0u, 0u};
                  if (st <= tt) {
                      f32x4 a4 = (f32x4){0.f, 0.f, 0.f, 0.f};
#pragma unroll
                      for (int ks = 0; ks < 4; ++ks) {
                          const bf16x8 af = *(const LAS bf16x8*)(lds + HL_KT + (16 * st + fr) * HS + (32 * ks + 8 * fq) * 2);
                          const bf16x8 bfr = *(const LAS bf16x8*)(lds + HL_QT + (16 * tt + fr) * HS + (32 * ks + 8 * fq) * 2);
                          a4 = MFMA16(af, bfr, a4);
                      }
                      const float v0 = s0 + 0 <= t ? a4[0] : 0.f, v1 = s0 + 1 <= t ? a4[1] : 0.f, v2 = s0 + 2 <= t ? a4[2] : 0.f, v3 = s0 + 3 <= t ? a4[3] : 0.f;
                      w.x = pk2(v0, v1); w.y = pk2(v2, v3);
                  }
                  *(LAS u32x2*)(lds + HL_SC + t * HSC + s0 * 2) = w;
              } }
#pragma unroll
            for (int tt = 0; tt < 4; ++tt) o[tt] = (f32x4){0.f, 0.f, 0.f, 0.f};
#pragma unroll
            for (int ks = 0; ks < 4; ++ks) {
                u32x4 sb; sb.x = pk2(S[2 * ks][0], S[2 * ks][1]); sb.y = pk2(S[2 * ks][2], S[2 * ks][3]); sb.z = pk2(S[2 * ks + 1][0], S[2 * ks + 1][1]); sb.w = pk2(S[2 * ks + 1][2], S[2 * ks + 1][3]);
                const bf16x8 sfr = __builtin_bit_cast(bf16x8, sb);
#pragma unroll
                for (int tt = 0; tt < 4; ++tt) {
                    const LAS unsigned char* ap = lds + HL_QT + (16 * tt + fr) * HS + (32 * ks + 4 * fq) * 2;
                    const s16x4 a0 = *(const LAS s16x4*)ap, a1 = *(const LAS s16x4*)(ap + 32);
                    o[tt] = MFMA16(cat8(a0, a1), sfr, o[tt]);
                }
            }
        }
        { const LAS unsigned char* tb = lds + vimg + (8 * fq + (fr >> 2)) * HS + (16 * wave + 4 * (fr & 3)) * 2;
#pragma unroll
          for (int ss = 0; ss < 2; ++ss) vf[ss] = cat8(vtr(tb + (32 * ss) * HS), vtr(tb + (32 * ss + 4) * HS)); }
        f32x4 Sn[8];
#pragma unroll
        for (int kt = 0; kt < 8; ++kt) {
            const f32x4 d4 = *(const LAS f32x4*)(dec + 16 * kt + 4 * fq);
            f32x4 a4 = S[kt] * d4;
            const LAS unsigned char* tb = lds + HL_KH + (8 * fq + (fr >> 2)) * HS + (16 * kt + 4 * (fr & 3)) * 2;
#pragma unroll
            for (int ss = 0; ss < 2; ++ss) a4 = MFMA16(cat8(vtr(tb + (32 * ss) * HS), vtr(tb + (32 * ss + 4) * HS)), vf[ss], a4);
            Sn[kt] = a4;
        }
#pragma unroll
        for (int kt = 0; kt < 8; ++kt) S[kt] = Sn[kt];
        if (FULL) {
            HG_BAR();
#pragma unroll
            for (int ss = 0; ss < 2; ++ss)
#pragma unroll
                for (int tt = 0; tt < 4; ++tt) {
                    if (ss == 1 && tt < 2) continue;
                    const bf16x8 af = *(const LAS bf16x8*)(lds + HL_SC + (16 * tt + fr) * HSC + (32 * ss + 8 * fq) * 2);
                    o[tt] = MFMA16(af, vf[ss], o[tt]);
                }
#pragma unroll
            for (int tt = 0; tt < 4; ++tt)
#pragma unroll
                for (int r = 0; r < 4; ++r) { const int t = 16 * tt + 4 * fq + r; const float ov = o[tt][r]; float q = ov * ov;
                    *(LAS unsigned short*)(lds + HL_OUT + t * HS + (16 * wave + fr) * 2) = (unsigned short)f2bf(ov);
                    q += __shfl_xor(q, 1); q += __shfl_xor(q, 2); q += __shfl_xor(q, 4); q += __shfl_xor(q, 8);
                    if (fr == 0) osq[t * 8 + wave] = q; }
            HG_BAR();
#pragma unroll
            for (int j = 0; j < 2; ++j) { const int ch = tid + 512 * j, row = ch >> 4, c16 = ch & 15;
                const f32x4 qa = *(const LAS f32x4*)(osq + row * 8), qb = *(const LAS f32x4*)(osq + row * 8 + 4);
                const float rs = 1.0f / sqrtf((((qa[0] + qa[1]) + (qa[2] + qa[3])) + ((qb[0] + qb[1]) + (qb[2] + qb[3]))) * (1.0f / 128.0f) + 1e-6f);
                const u32x4 ow = *(const LAS u32x4*)(lds + HL_OUT + row * HS + 16 * c16);
                float ov[8], gv[8]; unpack8(ow, ov); unpack8(gch[j], gv);
                u32x4 w; w.x = pk2(ov[0] * rs * on0[0] * gv[0], ov[1] * rs * on0[1] * gv[1]); w.y = pk2(ov[2] * rs * on0[2] * gv[2], ov[3] * rs * on0[3] * gv[3]);
                w.z = pk2(ov[4] * rs * on1[0] * gv[4], ov[5] * rs * on1[1] * gv[5]); w.w = pk2(ov[6] * rs * on1[2] * gv[6], ov[7] * rs * on1[3] * gv[7]);
                *(u32x4*)(Ob + (R0 + row) * 1024 + hc + 8 * c16) = w; }
            if (c < HG_NCH - 1) HG_LOAD_G(R0 + 64);
        }
    }
    if (!FULL) {
        float* sp = SLOC + ((size_t)(bh * 4 + sc) << 14) + (16 * wave + fr) * 4;
#pragma unroll
        for (int kt = 0; kt < 8; ++kt) *(f32x4*)(sp + (4 * kt + fq) * 512) = S[kt];
        if (seg == 0) *(f32x2v*)(DTOT + (bh * 4 + sc) * 128 + 2 * kp) = (f32x2v){dprod0, dprod1};
    }
    HG_BAR();
#undef HG_LOAD_E
#undef HG_LOAD_G
}
__device__ __forceinline__ void hgrn_scan(const Ptrs& P, int gw, int NGW, int lane) {
    float* SLOC = (float*)((unsigned char*)P.out + 64 * MiB); const float* DTOT = (const float*)(P.ws + WS_DTOT);
    for (int it = gw; it < 64 * 64; it += NGW) {
        const int bh = it >> 6, e0 = (it & 63) * 256 + lane * 4, k0 = (e0 >> 9) * 4;
        f32x4 v[3], d[3];
#pragma unroll
        for (int s = 0; s < 3; ++s) { v[s] = *(const f32x4*)(SLOC + ((size_t)(bh * 4 + s) << 14) + e0); d[s] = *(const f32x4*)(DTOT + (bh * 4 + s) * 128 + k0); }
        f32x4 run = v[0];
#pragma unroll
        for (int s = 1; s < 3; ++s) { run = run * d[s] + v[s]; *(f32x4*)(SLOC + ((size_t)(bh * 4 + s) << 14) + e0) = run; }
    }
}
#ifndef MK_ONE_LAUNCH
#define MK_ONE_LAUNCH 1
#endif
#ifndef MK_XCD_BAR
#define MK_XCD_BAR 1
#endif
constexpr int N_PHASES = 18;
constexpr int FIN_LDS_OFF = 131072 + 4096;
constexpr int RS_TAB_OFF = 131072 + 1024;
struct Args { Ptrs p; int ph_lo, ph_hi; };
__global__ void __launch_bounds__(NTHREADS, 2) fwd_kernel(Args args) {
    extern __shared__ __attribute__((aligned(16))) unsigned char lds_raw[];
    LAS unsigned char* lds = (LAS unsigned char*)lds_raw;
    const Ptrs& P = args.p;
    const int tid = threadIdx.x, lane = tid & 63, wave = __builtin_amdgcn_readfirstlane(tid >> 6);
    const int G = gridDim.x, bx = blockIdx.x;
    const int vcu = (G % 8 == 0) ? (bx % 8) * (G / 8) + bx / 8 : bx;
    const int gw = vcu * NWAVES + wave, NGW = G * NWAVES;
    unsigned char* ws = P.ws;
    bf16_t* H = (bf16_t*)(ws + WS_H); bf16_t* HID = (bf16_t*)(ws + WS_HID); float* SS = (float*)(ws + WS_SS);
    const int lo = args.ph_lo, hi = args.ph_hi;
#if MK_XCD_BAR
    volatile LAS unsigned* MISC = (volatile LAS unsigned*)(lds + LDS_BYTES - 256);
    if (tid < 32) MISC[tid] = 0u;
#if MK_ONE_LAUNCH
    if (bx == 0) { unsigned* cw = (unsigned*)ws + 4096; for (int i = tid; i < 12288; i += NTHREADS) __hip_atomic_store(cw + i, 0u, __ATOMIC_RELAXED, __HIP_MEMORY_SCOPE_AGENT); }
    __syncthreads();
    XcdBarrier bar; bar.bar = (unsigned*)ws + 4096; bar.x = xb_xcc_id(); bar.st = MISC + 8;
#else
    __syncthreads();
    XcdBarrier bar = xcd_barrier_post((unsigned*)ws + 4096, MISC + 8);
#endif
#endif
#define IN(k) (lo <= (k) && (k) < hi)
#if MK_XCD_BAR
#define SEAM(k) do { if (IN(k) && IN((k) + 1)) { if ((k) == 0) { cg::this_grid().sync(); if (tid == 0) (void)xb_add(&bar.bar[XB_XCNT(bar.x)], 1u); } else xcd_barrier(bar); } } while (0)
#else
#define SEAM(k) do { if (IN(k) && IN((k) + 1)) { cg::this_grid().sync(); } } while (0)
#endif
#define SSB(i) (SS + (size_t)(i) * M * 16)
#define GEMM_GU(f, ssi) do { pg8::Gemm g{H, (const bf16_t*)(ws + WS_GU) + (size_t)(f) * 5632 * 1024, M, 5632, D}; pg8::StaticOrder S; S.init(M, 5632, G, bx); \
        pg8::EpiSwiGLU E{HID, pg8::rs_table_build(lds + RS_TAB_OFF, SSB(ssi), S, tid), FF}; pg8::gemm_phase<pg8::EpiSwiGLU, pg8::StaticOrder, true, true>(lds, g, S, E); } while (0)
#define GEMM_DN(f, sso) do { pg8::Gemm g{HID, (const bf16_t*)(ws + WS_DN) + (size_t)(f) * 1024 * 2816, M, D, FF}; pg8::StaticOrder S; S.init(M, D, G, bx); \
        pg8::EpiResid<false> E{H, SSB(sso), 0.5f, nullptr}; pg8::gemm_phase<pg8::EpiResid<false>, pg8::StaticOrder, false, true>(lds, g, S, E); } while (0)

    if (IN(0)) { p0_prologue(P, lds, gw, NGW, wave, lane); }
#ifdef PROBE_P0
    __syncthreads(); if (IN(0)) { p0_prologue(P, lds, gw, NGW, wave, lane); }
#endif
    SEAM(0);
#ifdef PROBE_EARLYBAR
    xcd_barrier(bar);
#endif
    if (IN(1)) { GEMM_GU(0, 0); }
#ifdef PROBE_LATE_WG
    if (bx == PROBE_LATE_WG) { for (int d_ = 0; d_ < 400; ++d_) __builtin_amdgcn_s_sleep(127); }
#endif
#ifdef PROBE_BAR10
#if PROBE_BAR10 == 2
    asm volatile("s_waitcnt vmcnt(0)" ::: "memory"); __syncthreads();
    if (tid == 0) { __builtin_amdgcn_fence(__ATOMIC_RELEASE, "agent"); asm volatile("s_waitcnt vmcnt(0)" ::: "memory"); __builtin_amdgcn_fence(__ATOMIC_ACQUIRE, "agent"); asm volatile("s_waitcnt vmcnt(0)" ::: "memory"); }
    __syncthreads();
#elif PROBE_BAR10 == 4
    cg::this_grid().sync();
#elif PROBE_BAR10 == 3
    asm volatile("s_waitcnt vmcnt(0)" ::: "memory"); __syncthreads(); __syncthreads();
#else
    for (int i_ = 0; i_ < PROBE_BAR10; ++i_) { xcd_barrier(bar); }
#endif
#endif
#ifdef PROBE_GU2X
    xcd_barrier(bar); if (IN(1)) { GEMM_GU(0, 0); }
#endif
    SEAM(1);
#ifdef PROBE_DN2X
    if (IN(2)) { pg8::Gemm g{HID, (const bf16_t*)(ws + WS_DN), M, D, FF}; pg8::StaticOrder S; S.init(M, D, G, bx);
        pg8::EpiResid<false> E{H, SSB(1), 0.0f, nullptr}; pg8::gemm_phase<pg8::EpiResid<false>, pg8::StaticOrder, false, true>(lds, g, S, E); }
    xcd_barrier(bar);
#endif
    if (IN(2)) { GEMM_DN(0, 1); }
    SEAM(2);
    if (IN(3)) { pg8::Gemm g{H, (const bf16_t*)(ws + WS_ABIN), M, 3072, D}; pg8::StaticOrder S; S.init(M, 3072, G, bx);
        pg8::EpiProjAB E{(bf16_t*)(ws + WS_PROJ), pg8::rs_table_build(lds + RS_TAB_OFF, SSB(1), S, tid), QSCALE}; pg8::gemm_phase<pg8::EpiProjAB, pg8::StaticOrder, true, true>(lds, g, S, E); }
    SEAM(3);
    if (IN(4)) { mix0_phase(P, lds, gw, NGW, wave, lane); }
#ifdef PROBE_P4
    if (IN(4)) { mix0_phase(P, lds, gw, NGW, wave, lane); }
#endif
    SEAM(4);
    if (IN(5)) { pg8::Gemm g{(const bf16_t*)(ws + WS_Y), (const bf16_t*)(ws + WS_ABOUT), M, D, D}; pg8::StaticOrder S; S.init(M, D, G, bx);
        pg8::EpiResid<false> E{H, SSB(2), 1.0f, nullptr}; pg8::gemm_phase<pg8::EpiResid<false>, pg8::StaticOrder, false, true>(lds, g, S, E); }
    SEAM(5);
#ifdef PROBE_BAR_AT5
    xcd_barrier(bar);
#endif
#ifdef PROBE_IDLE
    { const unsigned long long t0_ = __builtin_amdgcn_s_memrealtime(); while (__builtin_amdgcn_s_memrealtime() - t0_ < 100000ull) __builtin_amdgcn_s_sleep(64); }
#endif
    if (IN(6)) { GEMM_GU(1, 2); }
    SEAM(6);
#ifdef PROBE_BAR_AT6
    xcd_barrier(bar);
#endif
    if (IN(7)) { GEMM_DN(1, 3); }
    SEAM(7);
    if (IN(8)) { GEMM_GU(2, 3); }
    SEAM(8);
    if (IN(9)) { GEMM_DN(2, 4); }
    SEAM(9);
    if (IN(10)) { pg8::Gemm g{H, (const bf16_t*)(ws + WS_CIN), M, 4096, D}; pg8::StaticOrder S; S.init(M, 4096, G, bx);
        pg8::EpiProjC E{(bf16_t*)(ws + WS_QS), (float*)(ws + WS_LF), (bf16_t*)(ws + WS_IV), (bf16_t*)(ws + WS_GS), pg8::rs_table_build(lds + RS_TAB_OFF, SSB(4), S, tid), P.in[14]};
        pg8::gemm_phase<pg8::EpiProjC, pg8::StaticOrder, true, true>(lds, g, S, E); }
    SEAM(10);
    if (IN(11)) { const int bh = bx >> 2, sc = bx & 3; if (sc < 3 && bh < 64) hgrn_unit<false>(P, lds, bh, sc, tid, wave, lane); }
    SEAM(11);
    if (IN(13)) { const int bh = bx >> 2, sc = bx & 3; if (bh < 64) hgrn_unit<true>(P, lds, bh, sc, tid, wave, lane); }
    SEAM(13);
    if (IN(14)) { pg8::Gemm g{(const bf16_t*)P.out, (const bf16_t*)(ws + WS_COUT), M, D, D}; pg8::StaticOrder S; S.init(M, D, G, bx);
        pg8::EpiResid<false> E{H, SSB(5), 1.0f, nullptr}; pg8::gemm_phase<pg8::EpiResid<false>, pg8::StaticOrder, false, true>(lds, g, S, E); }
    SEAM(14);
    if (IN(15)) { GEMM_GU(3, 5); }
    SEAM(15);
    if (IN(16)) { pg8::Gemm g{HID, (const bf16_t*)(ws + WS_DN) + (size_t)3 * 1024 * 2816, M, D, FF}; pg8::StaticOrder S; S.init(M, D, G, bx);
        pg8::EpiFinalNorm E{H, P.out, P.in[17], 0.5f, SSB(6), (unsigned*)ws + 8192, lds + FIN_LDS_OFF};
        pg8::gemm_phase<pg8::EpiFinalNorm, pg8::StaticOrder, true, true>(lds, g, S, E); }
    if (IN(18)) {
        for (int m = gw; m < M; m += NGW) { const u32x2* hr = (const u32x2*)(H + (size_t)m * D) + lane; f32x4* orow = (f32x4*)(P.out + (size_t)m * D) + lane;
#pragma unroll
            for (int j = 0; j < 4; ++j) { const u32x2 w = hr[64 * j]; orow[64 * j] = (f32x4){pg8::bf_lo(w.x), pg8::bf_hi(w.x), pg8::bf_lo(w.y), pg8::bf_hi(w.y)}; } }
    }
}

extern "C" void kernel_launch(void* const* d_in, const int* in_sizes, int n_in, void* d_out, int out_size, void* d_ws, size_t ws_size, hipStream_t stream) {
    static int grid = 0;
    if (grid == 0) {
        if (n_in != 18 || in_sizes[0] != M * D || out_size != M * D || ws_size < WS_END) { fprintf(stderr, "kernel_launch: unexpected shapes (n_in %d, in0 %d, out %d, ws %zu)\n", n_in, n_in > 0 ? in_sizes[0] : -1, out_size, ws_size); grid = -1; return; }
        int dev = 0, cus = 0, per_cu = 0;
        hipGetDevice(&dev); hipDeviceGetAttribute(&cus, hipDeviceAttributeMultiprocessorCount, dev);
        if (hipFuncSetAttribute((const void*)fwd_kernel, hipFuncAttributeMaxDynamicSharedMemorySize, LDS_BYTES) != hipSuccess) { fprintf(stderr, "kernel_launch: hipFuncSetAttribute failed\n"); grid = -1; return; }
        if (hipOccupancyMaxActiveBlocksPerMultiprocessor(&per_cu, (const void*)fwd_kernel, NTHREADS, LDS_BYTES) != hipSuccess || per_cu < 1) { fprintf(stderr, "kernel_launch: occupancy query gives %d\n", per_cu); per_cu = 1; }
        (void)hipGetLastError();
        grid = cus;
    }
    if (grid < 0) return;
    Args a{};
    for (int i = 0; i < 18; ++i) a.p.in[i] = (const float*)d_in[i];
    a.p.out = (float*)d_out; a.p.ws = (unsigned char*)d_ws;
#if MK_ONE_LAUNCH
    a.ph_lo = 0; a.ph_hi = N_PHASES;
    void* kargs[] = {&a};
    hipError_t e = hipLaunchCooperativeKernel((const void*)fwd_kernel, dim3(grid), dim3(NTHREADS), kargs, LDS_BYTES, stream);
    if (e != hipSuccess) fprintf(stderr, "kernel_launch: cooperative launch failed: %s (grid %d)\n", hipGetErrorString(e), grid);
#else
#ifdef DBG_STOP
    for (int ph = 0; ph <= DBG_STOP; ++ph) { a.ph_lo = ph; a.ph_hi = ph + 1; hipLaunchKernelGGL(fwd_kernel, dim3(grid), dim3(NTHREADS), LDS_BYTES, stream, a); }
    a.ph_lo = 18; a.ph_hi = 19; hipLaunchKernelGGL(fwd_kernel, dim3(grid), dim3(NTHREADS), LDS_BYTES, stream, a);
#else
    for (int ph = 0; ph < N_PHASES; ++ph) { a.ph_lo = ph; a.ph_hi = ph + 1; hipLaunchKernelGGL(fwd_kernel, dim3(grid), dim3(NTHREADS), LDS_BYTES, stream, a); }
#endif
#endif
}
```

```cpp
#include <hip/hip_runtime.h>
#include <hip/hip_cooperative_groups.h>
#include <cstdio>
#include <cstdint>
namespace cg = cooperative_groups;
#define MK_ONE_LAUNCH 1
namespace pg8 {
#define PG8_LAS __attribute__((address_space(3)))
typedef unsigned short bf16_t;
typedef short bf16x8 __attribute__((ext_vector_type(8)));
typedef float f32x4 __attribute__((ext_vector_type(4)));
typedef unsigned u32x4 __attribute__((ext_vector_type(4)));
constexpr int BM = 256, BK = 64, HALF = 128, HTB = HALF * BK * 2  , STAGE_BYTES = 8 * HTB, NXCD = 8, WGM = 8;

__host__ __device__ __forceinline__ int lds_byte(int r, int c) { const int st = (r >> 4) * 2 + (c >> 5), rr = r & 15, cc = c & 31, ob = rr * 64 + cc * 2; return st * 1024 + (ob ^ (((ob >> 9) & 1) << 5)); }
__host__ __device__ __forceinline__ void stage_rc(int b, int& R, int& C) { const int st = b / 1024, sb = b % 1024, swz = sb ^ (((sb >> 9) & 1) << 5); R = (st >> 1) * 16 + swz / 64; C = (st & 1) * 32 + (swz % 64) / 2; }
__host__ __device__ __forceinline__ int perm32(int rho) { const int n = rho >> 4, i = rho & 15; return 8 * (i >> 2) + 4 * n + (i & 3); }

struct Unit { int pm, pn; };
struct Gemm { const bf16_t* A; const bf16_t* Bt; int M, N, K; };

struct StaticOrder {
    int nM, nN, nwg, G, c;
    __host__ __device__ void init(int M, int N, int G_, int c_) { nM = M / BM; nN = N / BM; nwg = nM * nN; G = G_; c = c_; }
    __host__ __device__ bool next(int i, Unit& u) const {
        const long L = (long)i * G + c; if (L >= nwg) return false;
        int wgid = (int)L; { const int q = nwg / NXCD, r = nwg % NXCD, xcd = wgid % NXCD, off = wgid / NXCD; wgid = (xcd < r ? xcd * (q + 1) : r * (q + 1) + (xcd - r) * q) + off; }
        const int nig = WGM * nN, gid = wgid / nig, fm = gid * WGM, gsz = (nM - fm) < WGM ? (nM - fm) : WGM;
        u.pm = fm + ((wgid % nig) % gsz); u.pn = (wgid % nig) / gsz; return true;
    }
    __device__ __forceinline__ void a_ready(const Unit&) const {}
    __device__ __forceinline__ void done(const Unit&) const {}
};

__device__ __forceinline__ unsigned cvt_pk_bf16(float lo, float hi) { unsigned r; asm volatile("v_cvt_pk_bf16_f32 %0, %1, %2" : "=v"(r) : "v"(lo), "v"(hi)); return r; }
typedef float f32x2 __attribute__((ext_vector_type(2)));
__device__ __forceinline__ float row_rstd(const float* ss, int row) {
    const f32x4* p = (const f32x4*)(ss + (size_t)row * 16);
    const f32x4 a = p[0], b = p[1], c = p[2], d = p[3];
    const float s = ((a[0] + a[1]) + (a[2] + a[3])) + ((b[0] + b[1]) + (b[2] + b[3])) + ((c[0] + c[1]) + (c[2] + c[3])) + ((d[0] + d[1]) + (d[2] + d[3]));
    return __builtin_amdgcn_rsqf(s * (1.0f / 1024.0f) + 1e-6f);
}
struct RsTab { const PG8_LAS float* tab; int pmA, pmB; const float* ss; };
template <class Sched> __device__ __forceinline__ RsTab rs_table_build(PG8_LAS unsigned char* lds_tab, const float* ss, const Sched& S, int tid) {
    RsTab t; t.tab = (const PG8_LAS float*)lds_tab; t.pmA = -1; t.pmB = -1; t.ss = ss;
    Unit u; for (int i = 0; S.next(i, u); ++i) { if (t.pmA < 0) t.pmA = u.pm; else if (u.pm != t.pmA && t.pmB < 0) t.pmB = u.pm; }
    const int pm = tid < 256 ? t.pmA : t.pmB;
    if (pm >= 0) ((PG8_LAS float*)lds_tab)[tid] = row_rstd(ss, pm * BM + (tid & 255));
    __syncthreads();
    return t;
}
__device__ __forceinline__ float rs_lookup(const RsTab& t, const Unit& u, int r  ) {
    if (u.pm == t.pmA) return t.tab[r];
    if (u.pm == t.pmB) return t.tab[256 + r];
    return row_rstd(t.ss, u.pm * BM + r);
}
__device__ __forceinline__ float sigmoidf_(float x) { return __builtin_amdgcn_rcpf(1.0f + __builtin_amdgcn_exp2f(-1.4426950408889634f * x)); }
__device__ __forceinline__ float siluf_(float x) { return x * sigmoidf_(x); }
__device__ __forceinline__ float bf_lo(unsigned w) { return __uint_as_float(w << 16); }
__device__ __forceinline__ float bf_hi(unsigned w) { return __uint_as_float(w & 0xffff0000u); }

struct EpiSwiGLU {
    static constexpr bool PERM = true, AFTER_DRAIN = false;
    bf16_t* O; RsTab rt; int ldo;
    struct Pre {};
    __device__ __forceinline__ Pre pre(const Unit&, int, int) const { return Pre{}; }
    __device__ __forceinline__ void operator()(const f32x4 (&acc)[2][2][4][2], const Unit& u, int wr, int wc, int fr, int fq, const Pre&) const {
        const int row0 = u.pm * BM + wr * 64 + fr, col0 = u.pn * HALF + wc * 32 + 8 * fq;
        float rsv[2][4];
        if (u.pm == rt.pmA || u.pm == rt.pmB) {
            const PG8_LAS float* tb = rt.tab + (u.pm == rt.pmA ? 0 : 256) + wr * 64 + fr;
#pragma unroll
            for (int ai = 0; ai < 2; ++ai)
#pragma unroll
                for (int m = 0; m < 4; ++m) rsv[ai][m] = tb[ai * HALF + m * 16];
        } else {
#pragma unroll
            for (int ai = 0; ai < 2; ++ai)
#pragma unroll
                for (int m = 0; m < 4; ++m) rsv[ai][m] = row_rstd(rt.ss, row0 + ai * HALF + m * 16);
        }
#pragma unroll
        for (int ai = 0; ai < 2; ++ai)
#pragma unroll
            for (int m = 0; m < 4; ++m) {
                const int row = row0 + ai * HALF + m * 16; const float rs = rsv[ai][m];
                const f32x2 c1 = (f32x2){-1.4426950408889634f * rs, -1.4426950408889634f * rs}, rs2 = (f32x2){rs * rs, rs * rs};
                unsigned wv[4];
#pragma unroll
                for (int n = 0; n < 2; ++n)
#pragma unroll
                    for (int hh = 0; hh < 2; ++hh) {
                        const f32x2 g2 = (f32x2){acc[ai][0][m][n][2 * hh], acc[ai][0][m][n][2 * hh + 1]}, u2 = (f32x2){acc[ai][1][m][n][2 * hh], acc[ai][1][m][n][2 * hh + 1]};
                        const f32x2 t2 = g2 * c1;
                        f32x2 d2; d2.x = __builtin_amdgcn_exp2f(t2.x); d2.y = __builtin_amdgcn_exp2f(t2.y); d2 = d2 + 1.0f;
                        f32x2 r2; r2.x = __builtin_amdgcn_rcpf(d2.x); r2.y = __builtin_amdgcn_rcpf(d2.y);
                        const f32x2 h2 = (g2 * u2) * (r2 * rs2);
                        wv[2 * n + hh] = cvt_pk_bf16(h2.x, h2.y);
                    }
                u32x4 w; w.x = wv[0]; w.y = wv[1]; w.z = wv[2]; w.w = wv[3];
                *(u32x4*)(O + (size_t)row * ldo + col0) = w;
            }
    }
};
template <bool F32OUT> struct EpiResid {
    static constexpr bool PERM = true, AFTER_DRAIN = false;
    bf16_t* H; float* ssout; float alpha; float* out32;
    struct Pre {};
    __device__ __forceinline__ Pre pre(const Unit&, int, int) const { return Pre{}; }
    __device__ __forceinline__ void operator()(const f32x4 (&acc)[2][2][4][2], const Unit& u, int wr, int wc, int fr, int fq, const Pre&) const {
        const int row0 = u.pm * BM + wr * 64 + fr, col0 = u.pn * BM + wc * 32 + 8 * fq;
#pragma unroll
        for (int ai = 0; ai < 2; ++ai) {
            u32x4 old[4][2];
#pragma unroll
            for (int m = 0; m < 4; ++m)
#pragma unroll
                for (int bj = 0; bj < 2; ++bj) old[m][bj] = *(const u32x4*)(H + (size_t)(row0 + ai * HALF + m * 16) * 1024 + col0 + bj * HALF);
#pragma unroll
            for (int m = 0; m < 4; ++m) {
                const int row = row0 + ai * HALF + m * 16; float sq = 0.f;
#pragma unroll
                for (int bj = 0; bj < 2; ++bj) {
                    bf16_t* hp = H + (size_t)row * 1024 + col0 + bj * HALF;
                    const u32x4 o4 = old[m][bj];
                    float v[8];
                    v[0] = bf_lo(o4.x); v[1] = bf_hi(o4.x); v[2] = bf_lo(o4.y); v[3] = bf_hi(o4.y); v[4] = bf_lo(o4.z); v[5] = bf_hi(o4.z); v[6] = bf_lo(o4.w); v[7] = bf_hi(o4.w);
#pragma unroll
                    for (int n = 0; n < 2; ++n)
#pragma unroll
                        for (int i = 0; i < 4; ++i) { v[4 * n + i] += alpha * acc[ai][bj][m][n][i]; sq += v[4 * n + i] * v[4 * n + i]; }
                    u32x4 w; w.x = cvt_pk_bf16(v[0], v[1]); w.y = cvt_pk_bf16(v[2], v[3]); w.z = cvt_pk_bf16(v[4], v[5]); w.w = cvt_pk_bf16(v[6], v[7]);
                    *(u32x4*)hp = w;
                    if (F32OUT) { float* op = out32 + (size_t)row * 1024 + col0 + bj * HALF; *(f32x4*)op = (f32x4){v[0], v[1], v[2], v[3]}; *(f32x4*)(op + 4) = (f32x4){v[4], v[5], v[6], v[7]}; }
                }
                sq += __shfl_xor(sq, 16); sq += __shfl_xor(sq, 32);
                if (fq == 0) ssout[(size_t)row * 16 + u.pn * 4 + wc] = sq;
            }
        }
    }
};
struct EpiFinalNorm {
    static constexpr bool PERM = false, AFTER_DRAIN = false;
    const bf16_t* H; float* out; const float* gain; float alpha;
    float* xslots;
    unsigned* cnt;
    PG8_LAS unsigned char* xl;
    struct Pre {};
    __device__ __forceinline__ Pre pre(const Unit&, int, int) const { return Pre{}; }
    __device__ __forceinline__ void operator()(f32x4 (&acc)[2][2][4][2], const Unit& u, int wr, int wc, int fr, int fq, const Pre&) const {
        const int tid = threadIdx.x, lane = tid & 63, wid = __builtin_amdgcn_readfirstlane(tid >> 6);
        PG8_LAS float* P = (PG8_LAS float*)xl; PG8_LAS float* S = (PG8_LAS float*)(xl + 4096);
        const int row0 = u.pm * BM + wr * 64 + fr, col0 = u.pn * BM + wc * 32 + 4 * fq;
        typedef unsigned u32x2_t __attribute__((ext_vector_type(2)));
#pragma unroll
        for (int ai = 0; ai < 2; ++ai)
#pragma unroll
            for (int m = 0; m < 4; ++m) {
                const int row = row0 + ai * HALF + m * 16; float sq = 0.f;
#pragma unroll
                for (int bj = 0; bj < 2; ++bj)
#pragma unroll
                    for (int n = 0; n < 2; ++n) {
                        const u32x2_t o = *(const u32x2_t*)(H + (size_t)row * 1024 + col0 + bj * HALF + n * 16);
                        f32x4 v = (f32x4){bf_lo(o.x), bf_hi(o.x), bf_lo(o.y), bf_hi(o.y)} + alpha * acc[ai][bj][m][n];
                        acc[ai][bj][m][n] = v; sq += (v[0] * v[0] + v[1] * v[1]) + (v[2] * v[2] + v[3] * v[3]);
                    }
                sq += __shfl_xor(sq, 16); sq += __shfl_xor(sq, 32);
                if (fq == 0) P[(ai * HALF + wr * 64 + m * 16 + fr) * 4 + wc] = sq;
            }
        asm volatile("s_waitcnt lgkmcnt(0)" ::: "memory"); __builtin_amdgcn_s_barrier(); asm volatile("" ::: "memory");
        if (tid < 256) { const f32x4 p = *(const PG8_LAS f32x4*)(P + tid * 4);
            __hip_atomic_store(xslots + ((size_t)u.pm * BM + tid) * 4 + u.pn, (p[0] + p[1]) + (p[2] + p[3]), __ATOMIC_RELAXED, __HIP_MEMORY_SCOPE_AGENT); }
        asm volatile("s_waitcnt vmcnt(0)" ::: "memory");
        if (tid < 256 && lane == 0) __hip_atomic_fetch_add(cnt + 64 * u.pm, 1u, __ATOMIC_RELAXED, __HIP_MEMORY_SCOPE_AGENT);
        if (wid == 0) {
            unsigned sp = 0;
            while ((unsigned)__builtin_amdgcn_readfirstlane(__hip_atomic_load(cnt + 64 * u.pm, __ATOMIC_RELAXED, __HIP_MEMORY_SCOPE_AGENT)) < 16u) { __builtin_amdgcn_s_sleep(2); if (++sp > (1u << 18)) break; }
            __builtin_amdgcn_fence(__ATOMIC_ACQUIRE, "agent");
        }
        asm volatile("s_waitcnt vmcnt(0) lgkmcnt(0)" ::: "memory"); __builtin_amdgcn_s_barrier(); asm volatile("" ::: "memory");
        if (tid < 256) { const float* sl = xslots + ((size_t)u.pm * BM + tid) * 4;
            const float t = (__hip_atomic_load(sl, __ATOMIC_RELAXED, __HIP_MEMORY_SCOPE_AGENT) + __hip_atomic_load(sl + 1, __ATOMIC_RELAXED, __HIP_MEMORY_SCOPE_AGENT))
                          + (__hip_atomic_load(sl + 2, __ATOMIC_RELAXED, __HIP_MEMORY_SCOPE_AGENT) + __hip_atomic_load(sl + 3, __ATOMIC_RELAXED, __HIP_MEMORY_SCOPE_AGENT));
            S[tid] = __builtin_amdgcn_rsqf(t * (1.0f / 1024.0f) + 1e-6f); }
        asm volatile("s_waitcnt lgkmcnt(0)" ::: "memory"); __builtin_amdgcn_s_barrier(); asm volatile("" ::: "memory");
        f32x4 gv[2][2];
#pragma unroll
        for (int bj = 0; bj < 2; ++bj)
#pragma unroll
            for (int n = 0; n < 2; ++n) gv[bj][n] = *(const f32x4*)(gain + col0 + bj * HALF + n * 16);
#pragma unroll
        for (int ai = 0; ai < 2; ++ai)
#pragma unroll
            for (int m = 0; m < 4; ++m) {
                const int r = ai * HALF + wr * 64 + m * 16 + fr; const float rs = S[r];
                float* op = out + (size_t)(u.pm * BM + r) * 1024 + col0;
#pragma unroll
                for (int bj = 0; bj < 2; ++bj)
#pragma unroll
                    for (int n = 0; n < 2; ++n) __builtin_nontemporal_store(acc[ai][bj][m][n] * rs * gv[bj][n], (f32x4*)(op + bj * HALF + n * 16));
            }
    }
};
struct EpiProjAB {
    static constexpr bool PERM = true, AFTER_DRAIN = false;
    bf16_t* O; RsTab rt; float qscale;
    struct Pre {};
    __device__ __forceinline__ Pre pre(const Unit&, int, int) const { return Pre{}; }
    __device__ __forceinline__ void operator()(const f32x4 (&acc)[2][2][4][2], const Unit& u, int wr, int wc, int fr, int fq, const Pre&) const {
        const int row0 = u.pm * BM + wr * 64 + fr, col0 = u.pn * BM + wc * 32 + 8 * fq;
        const float sc = (u.pn == 6 || u.pn == 7) ? qscale : 1.0f;
#pragma unroll
        for (int ai = 0; ai < 2; ++ai)
#pragma unroll
            for (int m = 0; m < 4; ++m) {
                const int row = row0 + ai * HALF + m * 16; const float rs = rs_lookup(rt, u, ai * HALF + wr * 64 + m * 16 + fr) * sc;
#pragma unroll
                for (int bj = 0; bj < 2; ++bj) {
                    const f32x4 a = acc[ai][bj][m][0] * rs, b = acc[ai][bj][m][1] * rs;
                    u32x4 w; w.x = cvt_pk_bf16(a[0], a[1]); w.y = cvt_pk_bf16(a[2], a[3]); w.z = cvt_pk_bf16(b[0], b[1]); w.w = cvt_pk_bf16(b[2], b[3]);
                    *(u32x4*)(O + (size_t)row * 3072 + col0 + bj * HALF) = w;
                }
            }
    }
};
struct EpiProjC {
    static constexpr bool PERM = true, AFTER_DRAIN = false;
    bf16_t* Qs; float* LF; bf16_t* Iv; bf16_t* Gs; RsTab rt; const float* clb;
    struct Pre {};
    __device__ __forceinline__ Pre pre(const Unit&, int, int) const { return Pre{}; }
    __device__ __forceinline__ void operator()(const f32x4 (&acc)[2][2][4][2], const Unit& u, int wr, int wc, int fr, int fq, const Pre&) const {
        const int kind = u.pn >> 2;
        const int row0 = u.pm * BM + wr * 64 + fr, col0 = (u.pn & 3) * BM + wc * 32 + 8 * fq;
        if (kind == 1) {
            float lb[2][8];
#pragma unroll
            for (int bj = 0; bj < 2; ++bj)
#pragma unroll
                for (int j = 0; j < 8; ++j) { const int c = col0 + bj * HALF + j; lb[bj][j] = sigmoidf_(clb[1024 + c] - clb[c]); }
#pragma unroll
            for (int ai = 0; ai < 2; ++ai)
#pragma unroll
                for (int m = 0; m < 4; ++m) {
                    const int row = row0 + ai * HALF + m * 16; const float rs = rs_lookup(rt, u, ai * HALF + wr * 64 + m * 16 + fr);
#pragma unroll
                    for (int bj = 0; bj < 2; ++bj) {
                        float v[8];
#pragma unroll
                        for (int n = 0; n < 2; ++n)
#pragma unroll
                            for (int i = 0; i < 4; ++i) { const float x = acc[ai][bj][m][n][i] * rs, l = lb[bj][4 * n + i]; v[4 * n + i] = __builtin_amdgcn_logf(l + (1.0f - l) * sigmoidf_(x)); }
                        float* op = LF + (size_t)row * 1024 + col0 + bj * HALF; *(f32x4*)op = (f32x4){v[0], v[1], v[2], v[3]}; *(f32x4*)(op + 4) = (f32x4){v[4], v[5], v[6], v[7]};
                    }
                }
        } else {
            bf16_t* O = Qs + (kind ? ((size_t)(64 + 64 * kind) << 19) : (size_t)0);
            const bool act = kind != 2;
#pragma unroll
            for (int ai = 0; ai < 2; ++ai)
#pragma unroll
                for (int m = 0; m < 4; ++m) {
                    const int row = row0 + ai * HALF + m * 16; const float rs = rs_lookup(rt, u, ai * HALF + wr * 64 + m * 16 + fr);
#pragma unroll
                    for (int bj = 0; bj < 2; ++bj) {
                        float v[8];
#pragma unroll
                        for (int n = 0; n < 2; ++n)
#pragma unroll
                            for (int i = 0; i < 4; ++i) { const float x = acc[ai][bj][m][n][i] * rs; v[4 * n + i] = act ? siluf_(x) : x; }
                        u32x4 w; w.x = cvt_pk_bf16(v[0], v[1]); w.y = cvt_pk_bf16(v[2], v[3]); w.z = cvt_pk_bf16(v[4], v[5]); w.w = cvt_pk_bf16(v[6], v[7]);
                        *(u32x4*)(O + (size_t)row * 1024 + col0 + bj * HALF) = w;
                    }
                }
        }
    }
};
template <class Epi, class Sched, bool ALIGN_EPI = false, bool SP2 = false>
__device__ __forceinline__ void gemm_phase(PG8_LAS unsigned char* lds, const Gemm g, const Sched& S, const Epi& E) {
    const int tid = threadIdx.x, wid = __builtin_amdgcn_readfirstlane(tid >> 6), lane = tid & 63, wr = wid >> 2, wc = wid & 3, fr = lane & 15, fq = lane >> 4;
    const int K = g.K, nt = K / BK;
    unsigned voffA[2], voffB[2];
#pragma unroll
    for (int i = 0; i < 2; ++i) { int R, C; stage_rc(tid * 16 + i * 8192, R, C); const int Rb = Epi::PERM ? ((R & ~31) + perm32(R & 31)) : R;
        voffA[i] = (unsigned)(R * K + C) * 2u; voffB[i] = (unsigned)(Rb * K + C) * 2u; }
    const size_t kstep = (size_t)(BK * 2);
    const size_t hstep = (size_t)HALF * K * 2;
    const size_t tstep = 2 * hstep;
    const unsigned ldsw = (unsigned)wid * 1024u;
    const int aoff = lds_byte(wr * 64 + fr, fq * 8), boff = lds_byte(wc * 32 + fr, fq * 8);
#define PG8_SA(b, h) (((b) * 2 + (h)) * HTB)
#define PG8_SB(b, h) ((4 + (b) * 2 + (h)) * HTB)
#define PG8_STAGE(bufoff, gbase, voff) do { _Pragma("unroll") for (int _i = 0; _i < 2; ++_i) \
        __builtin_amdgcn_global_load_lds((const unsigned*)((const char*)(gbase) + (voff)[_i]), (PG8_LAS unsigned*)(lds + (bufoff) + ldsw + _i * 8192), 16, 0, 0); } while (0)
#define PG8_LDA(dst, b, h) do { _Pragma("unroll") for (int m = 0; m < 4; ++m) _Pragma("unroll") for (int k = 0; k < 2; ++k) dst[m][k] = *(const PG8_LAS bf16x8*)(lds + PG8_SA(b, h) + aoff + m * 2048 + k * 1024); } while (0)
#define PG8_LDB(dst, b, h) do { _Pragma("unroll") for (int n = 0; n < 2; ++n) _Pragma("unroll") for (int k = 0; k < 2; ++k) dst[n][k] = *(const PG8_LAS bf16x8*)(lds + PG8_SB(b, h) + boff + n * 2048 + k * 1024); } while (0)
#define PG8_MMA(ai, bj, At, Bt) do { __builtin_amdgcn_s_setprio(1); _Pragma("unroll") for (int m = 0; m < 4; ++m) _Pragma("unroll") for (int n = 0; n < 2; ++n) _Pragma("unroll") for (int k = 0; k < 2; ++k) \
        acc[ai][bj][m][n] = __builtin_amdgcn_mfma_f32_16x16x32_bf16(Bt[n][k], At[m][k], acc[ai][bj][m][n], 0, 0, 0); __builtin_amdgcn_s_setprio(0); } while (0)
#define PG8_WAIT_V(n) asm volatile("s_waitcnt vmcnt(" #n ")" ::: "memory")
#define PG8_WAIT_L(n) asm volatile("s_waitcnt lgkmcnt(" #n ")" ::: "memory")
#define PG8_BAR __builtin_amdgcn_s_barrier()
#define PG8_SCHED __builtin_amdgcn_sched_barrier(0)
    Unit cur, nxt; int ui = 0;
    if (!S.next(0, cur)) return;
    f32x4 acc[2][2][4][2];
#pragma unroll
    for (int a = 0; a < 2; ++a)
#pragma unroll
        for (int b = 0; b < 2; ++b)
#pragma unroll
            for (int m = 0; m < 4; ++m)
#pragma unroll
                for (int n = 0; n < 2; ++n) acc[a][b][m][n] = (f32x4){0.f, 0.f, 0.f, 0.f};
    bf16x8 At[4][2], B0[2][2], B1[2][2];
    const char* cA = (const char*)g.A + (size_t)cur.pm * tstep; const char* cB = (const char*)g.Bt + (size_t)cur.pn * tstep;
    S.a_ready(cur);
    if constexpr (SP2) {
        PG8_STAGE(PG8_SB(0, 0), cB, voffB); PG8_STAGE(PG8_SB(0, 1), cB + hstep, voffB); PG8_STAGE(PG8_SA(0, 0), cA, voffA); PG8_STAGE(PG8_SA(0, 1), cA + hstep, voffA);
        if (wr == 1) PG8_BAR;
        PG8_WAIT_V(2); PG8_BAR;
        PG8_STAGE(PG8_SB(1, 0), cB + kstep, voffB); PG8_STAGE(PG8_SA(1, 0), cA + kstep, voffA); PG8_STAGE(PG8_SB(1, 1), cB + hstep + kstep, voffB);
        PG8_WAIT_V(6); PG8_BAR;
    } else {
        PG8_STAGE(PG8_SB(0, 0), cB, voffB); PG8_STAGE(PG8_SA(0, 0), cA, voffA); PG8_STAGE(PG8_SB(0, 1), cB + hstep, voffB); PG8_STAGE(PG8_SA(0, 1), cA + hstep, voffA);
        if (wr == 1) PG8_BAR;
        PG8_WAIT_V(4); PG8_BAR;
        PG8_STAGE(PG8_SB(1, 0), cB + kstep, voffB); PG8_STAGE(PG8_SA(1, 0), cA + kstep, voffA); PG8_STAGE(PG8_SB(1, 1), cB + hstep + kstep, voffB);
        PG8_WAIT_V(6); PG8_BAR;
    }
    for (;;) {
        const bool has_next = S.next(ui + 1, nxt);
        const char* nA = has_next ? (const char*)g.A + (size_t)nxt.pm * tstep : cA; const char* nB = has_next ? (const char*)g.Bt + (size_t)nxt.pn * tstep : cB;
        for (int t = 0; t < nt; t += 2) {
            const bool last = (t == nt - 2);
            const char* a1 = cA + (size_t)(t + 1) * kstep;
            const char* a2 = last ? nA : cA + (size_t)(t + 2) * kstep; const char* b2 = last ? nB : cB + (size_t)(t + 2) * kstep;
            const char* a3 = a2 + kstep; const char* b3 = b2 + kstep;
            if (last && has_next) S.a_ready(nxt);
            if constexpr (SP2) {
            PG8_LDB(B0, 0, 0); PG8_LDB(B1, 0, 1); PG8_SCHED; PG8_LDA(At, 0, 0); PG8_STAGE(PG8_SA(1, 1), a1 + hstep, voffA);
            PG8_WAIT_V(8); PG8_WAIT_L(0); PG8_BAR; PG8_MMA(0, 0, At, B0); PG8_MMA(0, 1, At, B1); PG8_BAR; PG8_SCHED;
            PG8_LDA(At, 0, 1); PG8_STAGE(PG8_SB(0, 0), b2, voffB); PG8_STAGE(PG8_SB(0, 1), b2 + hstep, voffB); PG8_STAGE(PG8_SA(0, 0), a2, voffA);
            PG8_WAIT_V(8); PG8_WAIT_L(0); PG8_BAR; PG8_MMA(1, 0, At, B0); PG8_MMA(1, 1, At, B1); PG8_BAR; PG8_SCHED;
            PG8_LDB(B0, 1, 0); PG8_LDB(B1, 1, 1); PG8_SCHED; PG8_LDA(At, 1, 0); PG8_STAGE(PG8_SA(0, 1), a2 + hstep, voffA);
            PG8_WAIT_V(8); PG8_WAIT_L(0); PG8_BAR; PG8_MMA(0, 0, At, B0); PG8_MMA(0, 1, At, B1); PG8_BAR; PG8_SCHED;
            PG8_LDA(At, 1, 1); PG8_STAGE(PG8_SB(1, 0), b3, voffB); PG8_STAGE(PG8_SB(1, 1), b3 + hstep, voffB); PG8_STAGE(PG8_SA(1, 0), a3, voffA);
            PG8_WAIT_V(8); PG8_WAIT_L(0); PG8_BAR; PG8_MMA(1, 0, At, B0); PG8_MMA(1, 1, At, B1); PG8_BAR; PG8_SCHED;
            } else {
            PG8_LDB(B0, 0, 0); PG8_SCHED; PG8_LDA(At, 0, 0); PG8_STAGE(PG8_SA(1, 1), a1 + hstep, voffA);
            PG8_WAIT_L(8); PG8_BAR; PG8_WAIT_L(0); PG8_MMA(0, 0, At, B0); PG8_BAR; PG8_SCHED;
            PG8_LDB(B1, 0, 1); PG8_STAGE(PG8_SB(0, 0), b2, voffB);
            PG8_BAR; PG8_WAIT_L(0); PG8_MMA(0, 1, At, B1); PG8_BAR;
            PG8_LDA(At, 0, 1); PG8_STAGE(PG8_SA(0, 0), a2, voffA);
            PG8_BAR; PG8_WAIT_L(0); PG8_MMA(1, 0, At, B0); PG8_BAR; PG8_SCHED;
            PG8_STAGE(PG8_SB(0, 1), b2 + hstep, voffB);
            PG8_WAIT_V(6); PG8_BAR; PG8_MMA(1, 1, At, B1); PG8_BAR;
            PG8_LDB(B0, 1, 0); PG8_SCHED; PG8_LDA(At, 1, 0); PG8_STAGE(PG8_SA(0, 1), a2 + hstep, voffA);
            PG8_WAIT_L(8); PG8_BAR; PG8_WAIT_L(0); PG8_MMA(0, 0, At, B0); PG8_BAR; PG8_SCHED;
            PG8_LDB(B1, 1, 1); PG8_STAGE(PG8_SB(1, 0), b3, voffB);
            PG8_BAR; PG8_WAIT_L(0); PG8_MMA(0, 1, At, B1); PG8_BAR;
            PG8_LDA(At, 1, 1); PG8_STAGE(PG8_SA(1, 0), a3, voffA);
            PG8_BAR; PG8_WAIT_L(0); PG8_MMA(1, 0, At, B0); PG8_BAR; PG8_SCHED;
            PG8_STAGE(PG8_SB(1, 1), b3 + hstep, voffB);
            PG8_WAIT_V(6); PG8_BAR; PG8_MMA(1, 1, At, B1); PG8_BAR;
            }
        }
        if constexpr (ALIGN_EPI) { if (wr == 0) PG8_BAR; }
        if constexpr (!Epi::AFTER_DRAIN) { E(acc, cur, wr, wc, fr, fq, E.pre(cur, wr, lane)); S.done(cur); }
        if (!has_next) break;
#pragma unroll
        for (int a = 0; a < 2; ++a)
#pragma unroll
            for (int b = 0; b < 2; ++b)
#pragma unroll
                for (int m = 0; m < 4; ++m)
#pragma unroll
                    for (int n = 0; n < 2; ++n) acc[a][b][m][n] = (f32x4){0.f, 0.f, 0.f, 0.f};
        cur = nxt; cA = nA; cB = nB; ++ui;
        if constexpr (ALIGN_EPI) { if (wr == 1) PG8_BAR; }
    }
    PG8_WAIT_V(0);
    if constexpr (!ALIGN_EPI) { if (wr == 0) PG8_BAR; }
    PG8_BAR;
    if constexpr (Epi::AFTER_DRAIN) { E.fused(acc, cur, wr, wc, fr, fq, lds, wid, lane); S.done(cur); }
#undef PG8_SA
#undef PG8_SB
#undef PG8_STAGE
#undef PG8_LDA
#undef PG8_LDB
#undef PG8_MMA
#undef PG8_WAIT_V
#undef PG8_WAIT_L
#undef PG8_BAR
#undef PG8_SCHED
}
}
using pg8::bf16_t; using pg8::bf16x8; using pg8::f32x4; using pg8::u32x4;
typedef float f32x16 __attribute__((ext_vector_type(16)));
typedef short s16x4 __attribute__((ext_vector_type(4)));
typedef unsigned u32x2 __attribute__((ext_vector_type(2)));
#define LAS __attribute__((address_space(3)))
constexpr int NWAVES = 8, NTHREADS = 512;
constexpr int BATCH = 8, SEQ = 4096, D = 1024, FF = 2816, M = BATCH * SEQ;
constexpr float QSCALE = 0.125f * 1.4426950408889634f;
constexpr size_t MiB = 1u << 20;
constexpr size_t WS_GU = 1 * MiB;
constexpr size_t WS_DN = WS_GU + 44 * MiB;
constexpr size_t WS_ABIN = WS_DN + 22 * MiB;
constexpr size_t WS_ABOUT = WS_ABIN + 6 * MiB;
constexpr size_t WS_CIN = WS_ABOUT + 2 * MiB;
constexpr size_t WS_COUT = WS_CIN + 8 * MiB;
constexpr size_t WS_H = WS_COUT + 2 * MiB;
constexpr size_t WS_SS = WS_H + 64 * MiB;
constexpr size_t WS_R = WS_SS + 14 * MiB;
constexpr size_t WS_HID = WS_R, WS_PROJ = WS_R, WS_Y = WS_R + 192 * MiB;
constexpr size_t WS_QS = WS_R, WS_LF = WS_R + 64 * MiB, WS_IV = WS_R + 192 * MiB, WS_GS = WS_R + 256 * MiB;
constexpr size_t WS_END = WS_R + 320 * MiB;
static_assert(WS_END <= 512 * MiB, "workspace map");
constexpr int LDS_BYTES = 147456;

__device__ __forceinline__ unsigned f2bf(float f) { unsigned u = __builtin_bit_cast(unsigned, f); return (u + 0x7fffu + ((u >> 16) & 1u)) >> 16; }
__device__ __forceinline__ unsigned pk2(float lo, float hi) { return pg8::cvt_pk_bf16(lo, hi); }
__device__ __forceinline__ float wave_sum(float v) {
#pragma unroll
    for (int o = 1; o < 64; o <<= 1) v += __shfl_xor(v, o);
    return v;
}
constexpr int P0_SCR = 64 * 65 * 4;
__device__ __forceinline__ void p0_transpose_item(const float* W, int K, int N, const float* gain, bf16_t* WT, int k0, int n0, int orow0, LAS float* scr, int lane) {
    const int lr = lane >> 4, lc = (lane & 15) * 4;
    f32x4 v[16];
#pragma unroll
    for (int j = 0; j < 16; ++j) v[j] = __builtin_nontemporal_load((const f32x4*)(W + (size_t)(k0 + 4 * j + lr) * N + n0 + lc));
    if (gain) {
#pragma unroll
        for (int j = 0; j < 16; ++j) v[j] = v[j] * gain[k0 + 4 * j + lr];
    }
#pragma unroll
    for (int j = 0; j < 16; ++j) { LAS float* d = scr + (4 * j + lr) * 65 + lc; d[0] = v[j][0]; d[1] = v[j][1]; d[2] = v[j][2]; d[3] = v[j][3]; }
    asm volatile("s_waitcnt lgkmcnt(0)" ::: "memory");
    const int c = lane & 7;
#pragma unroll
    for (int j = 0; j < 8; ++j) { const int n = (lane >> 3) + 8 * j; const LAS float* s = scr + (8 * c) * 65 + n;
        u32x4 o; o.x = pk2(s[0 * 65], s[1 * 65]); o.y = pk2(s[2 * 65], s[3 * 65]); o.z = pk2(s[4 * 65], s[5 * 65]); o.w = pk2(s[6 * 65], s[7 * 65]);
        *(u32x4*)(WT + (size_t)(orow0 + n) * K + k0 + 8 * c) = o; }
    asm volatile("s_waitcnt lgkmcnt(0)" ::: "memory");
}
struct Ptrs {
    const float* in[18]; float* out; unsigned char* ws;
};
__device__ __forceinline__ void p0_prologue(const Ptrs& P, LAS unsigned char* lds, int gw, int NGW, int wave, int lane) {
    unsigned char* ws = P.ws;
    const float* x = P.in[0]; bf16_t* H = (bf16_t*)(ws + WS_H); float* ss0 = (float*)(ws + WS_SS);
    for (int m0 = gw * 4; m0 < M; m0 += NGW * 4) {
        f32x4 v[4][4];
#pragma unroll
        for (int r = 0; r < 4; ++r)
#pragma unroll
            for (int j = 0; j < 4; ++j) v[r][j] = __builtin_nontemporal_load((const f32x4*)(x + (size_t)(m0 + r) * D) + lane + 64 * j);
#pragma unroll
        for (int r = 0; r < 4; ++r) {
            float s = 0.f;
#pragma unroll
            for (int j = 0; j < 4; ++j) s += (v[r][j][0] * v[r][j][0] + v[r][j][1] * v[r][j][1]) + (v[r][j][2] * v[r][j][2] + v[r][j][3] * v[r][j][3]);
            s = wave_sum(s);
            u32x2* o8 = (u32x2*)(H + (size_t)(m0 + r) * D) + lane;
#pragma unroll
            for (int j = 0; j < 4; ++j) { u32x2 w; w.x = pk2(v[r][j][0], v[r][j][1]); w.y = pk2(v[r][j][2], v[r][j][3]); o8[64 * j] = w; }
            if (lane < 16) ss0[(size_t)(m0 + r) * 16 + lane] = lane == 0 ? s : 0.f;
        }
    }
    LAS float* scr = (LAS float*)(lds + wave * P0_SCR);
    constexpr int I_FFN = 704;
    constexpr int I_ABIN = 16 * 48, I_ABOUT = 16 * 16, I_CIN = 16 * 64, I_COUT = 16 * 16;
    constexpr int NITEMS = 12 * I_FFN + I_ABIN + I_ABOUT + I_CIN + I_COUT;
    for (int it = gw; it < NITEMS; it += NGW) {
        int r = it;
        if (r < 12 * I_FFN) {
            const int mat = r / I_FFN, item = r % I_FFN, f = mat / 3, type = mat % 3;
            const int layer = f >> 1, post = f & 1;
            if (type < 2) {
                const float* Wg = post ? P.in[7] : P.in[2]; const float* Wu = post ? P.in[8] : P.in[3]; const float* W = (type == 0 ? Wg : Wu) + (size_t)layer * D * FF;
                const float* gain = (post ? P.in[6] : P.in[1]) + layer * D;
                const int nblk = FF / 64, kb = item / nblk, nb = item % nblk, n0 = 64 * nb;
                const int orow0 = (n0 >> 7) * 256 + (n0 & 127) + (type == 1 ? 128 : 0);
                p0_transpose_item(W, D, FF, gain, (bf16_t*)(ws + WS_GU) + (size_t)f * 5632 * 1024, 64 * kb, n0, orow0, scr, lane);
            } else {
                const float* W = (post ? P.in[9] : P.in[4]) + (size_t)layer * FF * D;
                const int nblk = D / 64, kb = item / nblk, nb = item % nblk, n0 = 64 * nb;
                p0_transpose_item(W, FF, D, nullptr, (bf16_t*)(ws + WS_DN) + (size_t)f * 1024 * 2816, 64 * kb, n0, n0, scr, lane);
            }
            continue;
        }
        r -= 12 * I_FFN;
        if (r < I_ABIN) { const int nblk = 48, kb = r / nblk, nb = r % nblk; p0_transpose_item(P.in[10], D, 3072, P.in[5], (bf16_t*)(ws + WS_ABIN), 64 * kb, 64 * nb, 64 * nb, scr, lane); continue; }
        r -= I_ABIN;
        if (r < I_ABOUT) { const int nblk = 16, kb = r / nblk, nb = r % nblk; p0_transpose_item(P.in[12], D, D, nullptr, (bf16_t*)(ws + WS_ABOUT), 64 * kb, 64 * nb, 64 * nb, scr, lane); continue; }
        r -= I_ABOUT;
        if (r < I_CIN) { const int nblk = 64, kb = r / nblk, nb = r % nblk; p0_transpose_item(P.in[13], D, 4096, P.in[5] + D, (bf16_t*)(ws + WS_CIN), 64 * kb, 64 * nb, 64 * nb, scr, lane); continue; }
        r -= I_CIN;
        { const int nblk = 16, kb = r / nblk, nb = r % nblk; p0_transpose_item(P.in[16], D, D, nullptr, (bf16_t*)(ws + WS_COUT), 64 * kb, 64 * nb, 64 * nb, scr, lane); }
    }
}
__device__ __forceinline__ void final_norm(const Ptrs& P, int gw, int NGW, int lane) {
    const float* ss = (const float*)(P.ws + WS_SS) + (size_t)6 * M * 16; const float* gain = P.in[17]; const bf16_t* H = (const bf16_t*)(P.ws + WS_H);
    f32x4 g[4];
#pragma unroll
    for (int j = 0; j < 4; ++j) g[j] = ((const f32x4*)gain)[lane + 64 * j];
    for (int m0 = gw * 4; m0 < M; m0 += NGW * 4) {
        u32x2 w[4][4]; float rs[4];
#pragma unroll
        for (int r = 0; r < 4; ++r) { rs[r] = pg8::row_rstd(ss, m0 + r);
#pragma unroll
            for (int j = 0; j < 4; ++j) w[r][j] = ((const u32x2*)(H + (size_t)(m0 + r) * D))[lane + 64 * j]; }
#pragma unroll
        for (int r = 0; r < 4; ++r) { f32x4* orow = (f32x4*)(P.out + (size_t)(m0 + r) * D) + lane;
#pragma unroll
            for (int j = 0; j < 4; ++j) { const f32x4 v = (f32x4){pg8::bf_lo(w[r][j].x), pg8::bf_hi(w[r][j].x), pg8::bf_lo(w[r][j].y), pg8::bf_hi(w[r][j].y)}; __builtin_nontemporal_store(v * rs[r] * g[j], orow + 64 * j); } }
    }
}
#define XB_TMO      128
#define XB_XCNT(j)  (256  + 64 * (j))
#define XB_XSUB(j)  (1280 + 64 * (j))
#define XB_XGEN(j)  (2304 + 64 * (j))
#define XB_TOP      3328
#define XB_TOPGEN   3392
#define XCD_BAR_WORDS 3456
#define XB_SPIN_CAP (1u << 18)

__device__ __forceinline__ unsigned xb_ld(unsigned* p)              { return __hip_atomic_load(p, __ATOMIC_RELAXED, __HIP_MEMORY_SCOPE_AGENT); }
__device__ __forceinline__ unsigned xb_add(unsigned* p, unsigned v) { return __hip_atomic_fetch_add(p, v, __ATOMIC_RELAXED, __HIP_MEMORY_SCOPE_AGENT); }
__device__ __forceinline__ unsigned xb_xcc_id() { return (unsigned)__builtin_amdgcn_s_getreg((3 << 11) | 20) & 0xFu; }
#define XB_SPIN(cond, bar) do { unsigned _sp = 0; while (cond) { __builtin_amdgcn_s_sleep(1); \
    if ((++_sp & 255u) == 0u) { if (xb_ld(&(bar)[XB_TMO])) break; if (_sp > XB_SPIN_CAP) { atomicAdd(&(bar)[XB_TMO], 1u); break; } } } } while (0)

struct XcdBarrier {
    unsigned* bar; unsigned x;
    volatile LAS unsigned* st;
};

__device__ __forceinline__ XcdBarrier xcd_barrier_post(unsigned* bar, volatile LAS unsigned* st) {
    XcdBarrier b; b.bar = bar; b.x = xb_xcc_id(); b.st = st;
    if (threadIdx.x == 0) (void)xb_add(&bar[XB_XCNT(b.x)], 1u);
    return b;
}
__device__ __forceinline__ void xcd_barrier_complete(unsigned* bar, unsigned x, unsigned& nloc, unsigned& nx) {
    const unsigned G = gridDim.x * gridDim.y * gridDim.z;
    unsigned sum, cnt, mine, sp = 0u;
    for (;;) {
        sum = 0u; cnt = 0u; mine = 0u;
#pragma unroll
        for (unsigned j = 0; j < 16; ++j) { const unsigned c = xb_ld(&bar[XB_XCNT(j)]); sum += c; cnt += (c > 0u) ? 1u : 0u; mine = (j == x) ? c : mine; }
        if (sum == G) break;
        __builtin_amdgcn_s_sleep(1);
        if ((++sp & 255u) == 0u) { if (xb_ld(&bar[XB_TMO])) break; if (sp > XB_SPIN_CAP) { atomicAdd(&bar[XB_TMO], 1u); break; } }
    }
    nloc = mine > 0u ? mine : 1u; nx = cnt > 0u ? cnt : 1u;
}

__device__ __forceinline__ void xcd_barrier(const XcdBarrier& b) {
    asm volatile("s_waitcnt vmcnt(0)" ::: "memory");
    __syncthreads();
    if (threadIdx.x == 0) {
        unsigned* bar = b.bar;
        __builtin_amdgcn_s_waitcnt(0);
        unsigned nloc = b.st[0], nx = b.st[1];
        if (nloc == 0u) { xcd_barrier_complete(bar, b.x, nloc, nx); b.st[0] = nloc; b.st[1] = nx; }
        const unsigned old = xb_add(&bar[XB_XSUB(b.x)], 1u);
        const unsigned gen = old / nloc;
        if (old + 1u == (gen + 1u) * nloc) {
            __builtin_amdgcn_fence(__ATOMIC_RELEASE, "agent");
            asm volatile("s_waitcnt vmcnt(0)" ::: "memory");
            const unsigned og = xb_add(&bar[XB_TOP], 1u);
            const unsigned tg = og / nx;
            if (og + 1u == (tg + 1u) * nx) xb_add(&bar[XB_TOPGEN], 1u);
            else XB_SPIN(xb_ld(&bar[XB_TOPGEN]) == tg, bar);
            __builtin_amdgcn_fence(__ATOMIC_ACQUIRE, "agent");
            xb_add(&bar[XB_XGEN(b.x)], 1u);
            asm volatile("s_waitcnt vmcnt(0)" ::: "memory");
        } else {
            XB_SPIN(xb_ld(&bar[XB_XGEN(b.x)]) == gen, bar);
            __builtin_amdgcn_fence(__ATOMIC_ACQUIRE, "agent");
            asm volatile("s_waitcnt vmcnt(0)" ::: "memory");
        }
    }
    __syncthreads();
}
__device__ __forceinline__ void unpack8(const u32x4 w, float (&v)[8]) {
    v[0] = pg8::bf_lo(w.x); v[1] = pg8::bf_hi(w.x); v[2] = pg8::bf_lo(w.y); v[3] = pg8::bf_hi(w.y); v[4] = pg8::bf_lo(w.z); v[5] = pg8::bf_hi(w.z); v[6] = pg8::bf_lo(w.w); v[7] = pg8::bf_hi(w.w);
}
__device__ __forceinline__ void conv_item(const bf16_t* PROJ, const float* cw, bf16_t* Y, int item, int lane) {
    const int r0 = item * 16, c0 = lane * 8;
    float w0[8], w1[8], w2[8];
#pragma unroll
    for (int j = 0; j < 8; ++j) { w0[j] = cw[c0 + j]; w1[j] = cw[512 + c0 + j]; w2[j] = cw[1024 + c0 + j]; }
    float um1[8], um2[8];
#pragma unroll
    for (int j = 0; j < 8; ++j) { um1[j] = 0.f; um2[j] = 0.f; }
    if ((r0 & (SEQ - 1)) != 0) {
        float a[8], b[8];
        const bf16_t* p2 = PROJ + (size_t)(r0 - 2) * 3072 + c0; unpack8(*(const u32x4*)(p2 + 512), a); unpack8(*(const u32x4*)(p2 + 1024), b);
#pragma unroll
        for (int j = 0; j < 8; ++j) um2[j] = a[j] * b[j];
        const bf16_t* p1 = PROJ + (size_t)(r0 - 1) * 3072 + c0; unpack8(*(const u32x4*)(p1 + 512), a); unpack8(*(const u32x4*)(p1 + 1024), b);
#pragma unroll
        for (int j = 0; j < 8; ++j) um1[j] = a[j] * b[j];
    }
#pragma unroll 4
    for (int r = 0; r < 16; ++r) {
        const bf16_t* p = PROJ + (size_t)(r0 + r) * 3072 + c0;
        float g[8], a[8], b[8], o[8];
        unpack8(*(const u32x4*)p, g); unpack8(*(const u32x4*)(p + 512), a); unpack8(*(const u32x4*)(p + 1024), b);
#pragma unroll
        for (int j = 0; j < 8; ++j) { const float u = a[j] * b[j]; o[j] = g[j] * (w0[j] * um2[j] + w1[j] * um1[j] + w2[j] * u); um2[j] = um1[j]; um1[j] = u; }
        u32x4 w; w.x = pk2(o[0], o[1]); w.y = pk2(o[2], o[3]); w.z = pk2(o[4], o[5]); w.w = pk2(o[6], o[7]);
        *(u32x4*)(Y + (size_t)(r0 + r) * 1024 + c0) = w;
    }
}
__device__ __forceinline__ s16x4 vtr(const LAS unsigned char* p) { typedef short v4i16_t __attribute__((ext_vector_type(4))); return __builtin_bit_cast(s16x4, __builtin_amdgcn_ds_read_tr16_b64_v4i16((LAS v4i16_t*)p)); }
__device__ __forceinline__ bf16x8 cat8(s16x4 a, s16x4 b) { bf16x8 r; r[0] = a[0]; r[1] = a[1]; r[2] = a[2]; r[3] = a[3]; r[4] = b[0]; r[5] = b[1]; r[6] = b[2]; r[7] = b[3]; return r; }
constexpr int AV_STRIDE = 144;
__device__ __forceinline__ void attn_unit(const bf16_t* PROJ, bf16_t* Y, int b, int h, int qb, LAS unsigned char* vlds, int lane) {
    const int r32 = lane & 31, hi = lane >> 5;
    const size_t rowbase = (size_t)b * SEQ;
    const int t0 = qb * 32;
    bf16x8 qf[4];
    { const bf16_t* qp = PROJ + (rowbase + t0 + r32) * 3072 + 1536 + h * 64 + 8 * hi;
#pragma unroll
      for (int kk = 0; kk < 4; ++kk) qf[kk] = *(const bf16x8*)(qp + 16 * kk); }
    f32x16 o0, o1;
#pragma unroll
    for (int i = 0; i < 16; ++i) { o0[i] = 0.f; o1[i] = 0.f; }
    float carry = 0.f;
    const int g4 = lane >> 4, li = lane & 15;
    const LAS unsigned char* trbase = vlds + (4 * (g4 >> 1) + (li >> 2)) * AV_STRIDE + (16 * (g4 & 1) + 4 * (li & 3)) * 2;
    bf16x8 kf[4]; u32x4 vr[4];
#define AT_LOAD(KF, VR, K0) do { const bf16_t* kp_ = PROJ + (rowbase + (K0) + r32) * 3072 + 2048 + h * 64 + 8 * hi; \
        _Pragma("unroll") for (int kk = 0; kk < 4; ++kk) KF[kk] = *(const bf16x8*)(kp_ + 16 * kk); \
        _Pragma("unroll") for (int j = 0; j < 4; ++j) VR[j] = *(const u32x4*)(PROJ + (rowbase + (K0) + (lane >> 3) + 8 * j) * 3072 + 2560 + h * 64 + 8 * (lane & 7)); } while (0)
    AT_LOAD(kf, vr, t0);
    for (int kt = qb; kt >= 0; --kt) {
#pragma unroll
        for (int j = 0; j < 4; ++j) *(LAS u32x4*)(vlds + ((lane >> 3) + 8 * j) * AV_STRIDE + 16 * (lane & 7)) = vr[j];
        bf16x8 kfn[4]; u32x4 vrn[4];
#pragma unroll
        for (int j = 0; j < 4; ++j) { kfn[j] = kf[j]; vrn[j] = vr[j]; }
        if (kt > 0) AT_LOAD(kfn, vrn, (kt - 1) * 32);
        f32x16 sc;
#pragma unroll
        for (int i = 0; i < 16; ++i) sc[i] = 0.f;
#pragma unroll
        for (int kk = 0; kk < 4; ++kk) sc = __builtin_amdgcn_mfma_f32_32x32x16_bf16(kf[kk], qf[kk], sc, 0, 0, 0);
        const bool diag = (kt == qb);
        float lk[16], lb[16];
#pragma unroll
        for (int r = 0; r < 16; ++r) {
            const float z = sc[r], az = __builtin_fabsf(z);
            const float L = __builtin_amdgcn_logf(1.0f + __builtin_amdgcn_exp2f(-az));
            float lbv = __builtin_fminf(z, 0.f) - L, lkv = lbv - z;
            if (diag) { const int key = (r & 3) + 8 * (r >> 2) + 4 * hi; if (!(key < r32)) { lkv = 0.f; lbv = -1.0e30f; } }
            lk[r] = lkv; lb[r] = lbv;
        }
        float gs[4], pg[4], T[4];
#pragma unroll
        for (int j = 0; j < 4; ++j) { gs[j] = (lk[4 * j] + lk[4 * j + 1]) + (lk[4 * j + 2] + lk[4 * j + 3]); pg[j] = __shfl_xor(gs[j], 32); T[j] = gs[j] + pg[j]; }
        float w[16];
        float suf = carry;
#pragma unroll
        for (int j = 3; j >= 0; --j) {
            float run = suf + (hi == 0 ? pg[j] : 0.f);
#pragma unroll
            for (int i = 3; i >= 0; --i) { w[4 * j + i] = __builtin_amdgcn_exp2f(lb[4 * j + i] + run); run += lk[4 * j + i]; }
            suf += T[j];
        }
        carry = suf;
        u32x4 p0, p1;
        p0.x = pk2(w[0], w[1]); p0.y = pk2(w[2], w[3]); p0.z = pk2(w[4], w[5]); p0.w = pk2(w[6], w[7]);
        p1.x = pk2(w[8], w[9]); p1.y = pk2(w[10], w[11]); p1.z = pk2(w[12], w[13]); p1.w = pk2(w[14], w[15]);
        const bf16x8 pf0 = __builtin_bit_cast(bf16x8, p0), pf1 = __builtin_bit_cast(bf16x8, p1);
        asm volatile("s_waitcnt lgkmcnt(0)" ::: "memory");
        const bf16x8 v00 = cat8(vtr(trbase), vtr(trbase + 8 * AV_STRIDE));
        const bf16x8 v01 = cat8(vtr(trbase + 16 * AV_STRIDE), vtr(trbase + 24 * AV_STRIDE));
        const bf16x8 v10 = cat8(vtr(trbase + 64), vtr(trbase + 8 * AV_STRIDE + 64));
        const bf16x8 v11 = cat8(vtr(trbase + 16 * AV_STRIDE + 64), vtr(trbase + 24 * AV_STRIDE + 64));
        o0 = __builtin_amdgcn_mfma_f32_32x32x16_bf16(v00, pf0, o0, 0, 0, 0);
        o0 = __builtin_amdgcn_mfma_f32_32x32x16_bf16(v01, pf1, o0, 0, 0, 0);
        o1 = __builtin_amdgcn_mfma_f32_32x32x16_bf16(v10, pf0, o1, 0, 0, 0);
        o1 = __builtin_amdgcn_mfma_f32_32x32x16_bf16(v11, pf1, o1, 0, 0, 0);
        if (__builtin_amdgcn_ballot_w64(carry > -160.0f) == 0ull) break;
#pragma unroll
        for (int j = 0; j < 4; ++j) { kf[j] = kfn[j]; vr[j] = vrn[j]; }
    }
#undef AT_LOAD
    bf16_t* yp = Y + (rowbase + t0 + r32) * 1024 + 512 + h * 64 + 4 * hi;
#pragma unroll
    for (int j = 0; j < 4; ++j) {
        u32x2 a; a.x = pk2(o0[4 * j], o0[4 * j + 1]); a.y = pk2(o0[4 * j + 2], o0[4 * j + 3]); *(u32x2*)(yp + 8 * j) = a;
        u32x2 c; c.x = pk2(o1[4 * j], o1[4 * j + 1]); c.y = pk2(o1[4 * j + 2], o1[4 * j + 3]); *(u32x2*)(yp + 32 + 8 * j) = c;
    }
}
__device__ __forceinline__ void mix0_phase(const Ptrs& P, LAS unsigned char* lds, int gw, int NGW, int wave, int lane) {
    const bf16_t* PROJ = (const bf16_t*)(P.ws + WS_PROJ); bf16_t* Y = (bf16_t*)(P.ws + WS_Y);
    LAS unsigned char* vlds = lds + wave * 8192;
#ifndef DBG_NO_ATTN
    for (int it = gw; it < BATCH * 8 * (SEQ / 32); it += NGW) { const int bh = it / (SEQ / 32), qb = it % (SEQ / 32); attn_unit(PROJ, Y, bh >> 3, bh & 7, qb, vlds, lane); }
#else
    for (int m = gw; m < M; m += NGW) { *(u32x4*)(Y + (size_t)m * 1024 + 512 + 8 * lane) = (u32x4){0u, 0u, 0u, 0u}; }
#endif
    for (int it = gw; it < M / 16; it += NGW) conv_item(PROJ, P.in[11], Y, it, lane);
}
constexpr int HS = 272;
constexpr int HL_QT = 0, HL_KT = 64 * HS, HL_KH = 2 * 64 * HS, HL_V = 3 * 64 * HS, HL_V2 = 4 * 64 * HS, HL_OUT = 4 * 64 * HS;
constexpr int HSC = 144;
constexpr int HL_SC = 5 * 64 * HS, HL_SEG = HL_SC + 64 * HSC, HL_DEC = HL_SEG + 8 * 128 * 4, HL_OSQ = HL_DEC + 512, HL_END = HL_OSQ + 64 * 8 * 4;
static_assert(HL_END <= 131072, "hgrn LDS map");
constexpr size_t WS_DTOT = 256 * 1024;
constexpr int HG_NCH = 16;
#define HG_BAR() do { asm volatile("s_waitcnt lgkmcnt(0)" ::: "memory"); __builtin_amdgcn_s_barrier(); asm volatile("" ::: "memory"); } while (0)
#define MFMA16(a, b, c) __builtin_amdgcn_mfma_f32_16x16x32_bf16((a), (b), (c), 0, 0, 0)
typedef float f32x2v __attribute__((ext_vector_type(2)));
template <bool FULL>
__device__ __forceinline__ void hgrn_unit(const Ptrs& P, LAS unsigned char* lds, int bh, int sc, int tid, int wave, int lane) {
    const bf16_t* Qs = (const bf16_t*)(P.ws + WS_QS); const float* LF = (const float*)(P.ws + WS_LF); const bf16_t* Iv = (const bf16_t*)(P.ws + WS_IV); const bf16_t* Gs = (const bf16_t*)(P.ws + WS_GS);
    bf16_t* Ob = (bf16_t*)P.out;
    float* SLOC = (float*)((unsigned char*)P.out + 64 * MiB);
    float* DTOT = (float*)(P.ws + WS_DTOT);
    const int b = bh >> 3, h = bh & 7, hc = h * 128;
    const int fr = lane & 15, fq = lane >> 4;
    const int kp = lane, seg = wave;
    f32x4 S[8];
    if (FULL && sc > 0) {
        const float* sp = SLOC + ((size_t)(bh * 4) << 14) + (16 * wave + fr) * 4;
        const float* dp = DTOT + (bh * 4) * 128 + 4 * fq;
#pragma unroll
        for (int kt = 0; kt < 8; ++kt) S[kt] = *(const f32x4*)(sp + (4 * kt + fq) * 512);
        for (int j = 1; j < sc; ++j) {
#pragma unroll
            for (int kt = 0; kt < 8; ++kt) S[kt] = S[kt] * *(const f32x4*)(dp + j * 128 + 16 * kt) + *(const f32x4*)(sp + ((size_t)j << 14) + (4 * kt + fq) * 512);
        }
    } else {
#pragma unroll
        for (int kt = 0; kt < 8; ++kt) S[kt] = (f32x4){0.f, 0.f, 0.f, 0.f};
    }
    LAS float* segtot = (LAS float*)(lds + HL_SEG); LAS float* dec = (LAS float*)(lds + HL_DEC); LAS float* osq = (LAS float*)(lds + HL_OSQ);
    f32x4 on0, on1;
    if (FULL) { const float* onp = P.in[15] + 8 * (tid & 15); on0 = *(const f32x4*)onp; on1 = *(const f32x4*)(onp + 4); }
    float dprod0 = 1.f, dprod1 = 1.f;
    f32x2v lf2[8]; unsigned q2[8]; u32x4 vch[2], gch[2];
    const size_t Rbase = (size_t)b * SEQ + (size_t)sc * (64 * HG_NCH);
#define HG_LOAD_E(R0_) do { _Pragma("unroll") for (int i = 0; i < 8; ++i) { const size_t off = ((R0_) + 8 * seg + i) * 1024 + hc + 2 * kp; lf2[i] = *(const f32x2v*)(LF + off); if (FULL) q2[i] = *(const unsigned*)(Qs + off); } \
        _Pragma("unroll") for (int j = 0; j < 2; ++j) { const int ch = tid + 512 * j; vch[j] = *(const u32x4*)(Iv + ((R0_) + (ch >> 4)) * 1024 + hc + 8 * (ch & 15)); } } while (0)
#define HG_LOAD_G(R0_) do { _Pragma("unroll") for (int j = 0; j < 2; ++j) { const int ch = tid + 512 * j; gch[j] = *(const u32x4*)(Gs + ((R0_) + (ch >> 4)) * 1024 + hc + 8 * (ch & 15)); } } while (0)
    HG_LOAD_E(Rbase);
    if (FULL) HG_LOAD_G(Rbase);
#pragma unroll 1
    for (int c = 0; c < HG_NCH; ++c) {
        const size_t R0 = Rbase + (size_t)c * 64;
        const int vimg = FULL ? HL_V : ((c & 1) ? HL_V2 : HL_V);
        f32x2v cs[8]; { f32x2v run = (f32x2v){0.f, 0.f};
#pragma unroll
          for (int i = 0; i < 8; ++i) { run += lf2[i]; cs[i] = run; } }
        *(LAS f32x2v*)(segtot + seg * 128 + 2 * kp) = cs[7];
#pragma unroll
        for (int j = 0; j < 2; ++j) { const int ch = tid + 512 * j; *(LAS u32x4*)(lds + vimg + (ch >> 4) * HS + 16 * (ch & 15)) = vch[j]; }
        HG_BAR();
        f32x2v pre = (f32x2v){0.f, 0.f}, tot = (f32x2v){0.f, 0.f};
#pragma unroll
        for (int s2 = 0; s2 < 8; ++s2) { const f32x2v v = *(const LAS f32x2v*)(segtot + s2 * 128 + 2 * kp); tot += v; if (s2 < seg) pre += v; }
        const float dl0 = __builtin_amdgcn_exp2f(tot[0]), dl1 = __builtin_amdgcn_exp2f(tot[1]);
        if (seg == 0) { *(LAS f32x2v*)(dec + 2 * kp) = (f32x2v){dl0, dl1}; dprod0 *= dl0; dprod1 *= dl1; }
#pragma unroll
        for (int i = 0; i < 8; ++i) {
            const float b0 = pre[0] + cs[i][0], b1 = pre[1] + cs[i][1];
            const float k0 = (1.0f - __builtin_amdgcn_exp2f(lf2[i][0])) * __builtin_amdgcn_exp2f(-b0), k1 = (1.0f - __builtin_amdgcn_exp2f(lf2[i][1])) * __builtin_amdgcn_exp2f(-b1);
            const int o = (8 * seg + i) * HS + 4 * kp;
            *(LAS unsigned*)(lds + HL_KH + o) = pk2(k0 * dl0, k1 * dl1);
            if (FULL) {
                *(LAS unsigned*)(lds + HL_KT + o) = pk2(k0, k1);
                *(LAS unsigned*)(lds + HL_QT + o) = pk2(pg8::bf_lo(q2[i]) * __builtin_amdgcn_exp2f(b0), pg8::bf_hi(q2[i]) * __builtin_amdgcn_exp2f(b1));
            }
        }
        if (c < HG_NCH - 1) HG_LOAD_E(R0 + 64);
        HG_BAR();
        f32x4 o[4];
        bf16x8 vf[2];
        if (FULL) {
            { const int tt = wave >> 1;
#pragma unroll
              for (int e = 0; e < 2; ++e) { const int st = 2 * (wave & 1) + e; const int t = 16 * tt + fr, s0 = 16 * st + 4 * fq;
                  u32x2 w = (u32x2){0u, 0u};
                  if (st <= tt) {
                      f32x4 a4 = (f32x4){0.f, 0.f, 0.f, 0.f};
#pragma unroll
                      for (int ks = 0; ks < 4; ++ks) {
                          const bf16x8 af = *(const LAS bf16x8*)(lds + HL_KT + (16 * st + fr) * HS + (32 * ks + 8 * fq) * 2);
                          const bf16x8 bfr = *(const LAS bf16x8*)(lds + HL_QT + (16 * tt + fr) * HS + (32 * ks + 8 * fq) * 2);
                          a4 = MFMA16(af, bfr, a4);
                      }
                      const float v0 = s0 + 0 <= t ? a4[0] : 0.f, v1 = s0 + 1 <= t ? a4[1] : 0.f, v2 = s0 + 2 <= t ? a4[2] : 0.f, v3 = s0 + 3 <= t ? a4[3] : 0.f;
                      w.x = pk2(v0, v1); w.y = pk2(v2, v3);
                  }
                  *(LAS u32x2*)(lds + HL_SC + t * HSC + s0 * 2) = w;
              } }
#pragma unroll
            for (int tt = 0; tt < 4; ++tt) o[tt] = (f32x4){0.f, 0.f, 0.f, 0.f};
#pragma unroll
            for (int ks = 0; ks < 4; ++ks) {
                u32x4 sb; sb.x = pk2(S[2 * ks][0], S[2 * ks][1]); sb.y = pk2(S[2 * ks][2], S[2 * ks][3]); sb.z = pk2(S[2 * ks + 1][0], S[2 * ks + 1][1]); sb.w = pk2(S[2 * ks + 1][2], S[2 * ks + 1][3]);
                const bf16x8 sfr = __builtin_bit_cast(bf16x8, sb);
#pragma unroll
                for (int tt = 0; tt < 4; ++tt) {
                    const LAS unsigned char* ap = lds + HL_QT + (16 * tt + fr) * HS + (32 * ks + 4 * fq) * 2;
                    const s16x4 a0 = *(const LAS s16x4*)ap, a1 = *(const LAS s16x4*)(ap + 32);
                    o[tt] = MFMA16(cat8(a0, a1), sfr, o[tt]);
                }
            }
        }
        { const LAS unsigned char* tb = lds + vimg + (8 * fq + (fr >> 2)) * HS + (16 * wave + 4 * (fr & 3)) * 2;
#pragma unroll
          for (int ss = 0; ss < 2; ++ss) vf[ss] = cat8(vtr(tb + (32 * ss) * HS), vtr(tb + (32 * ss + 4) * HS)); }
        f32x4 Sn[8];
#pragma unroll
        for (int kt = 0; kt < 8; ++kt) {
            const f32x4 d4 = *(const LAS f32x4*)(dec + 16 * kt + 4 * fq);
            f32x4 a4 = S[kt] * d4;
            const LAS unsigned char* tb = lds + HL_KH + (8 * fq + (fr >> 2)) * HS + (16 * kt + 4 * (fr & 3)) * 2;
#pragma unroll
            for (int ss = 0; ss < 2; ++ss) a4 = MFMA16(cat8(vtr(tb + (32 * ss) * HS), vtr(tb + (32 * ss + 4) * HS)), vf[ss], a4);
            Sn[kt] = a4;
        }
#pragma unroll
        for (int kt = 0; kt < 8; ++kt) S[kt] = Sn[kt];
        if (FULL) {
            HG_BAR();
#pragma unroll
            for (int ss = 0; ss < 2; ++ss)
#pragma unroll
                for (int tt = 0; tt < 4; ++tt) {
                    if (ss == 1 && tt < 2) continue;
                    const bf16x8 af = *(const LAS bf16x8*)(lds + HL_SC + (16 * tt + fr) * HSC + (32 * ss + 8 * fq) * 2);
                    o[tt] = MFMA16(af, vf[ss], o[tt]);
                }
#pragma unroll
            for (int tt = 0; tt < 4; ++tt)
#pragma unroll
                for (int r = 0; r < 4; ++r) { const int t = 16 * tt + 4 * fq + r; const float ov = o[tt][r]; float q = ov * ov;
                    *(LAS unsigned short*)(lds + HL_OUT + t * HS + (16 * wave + fr) * 2) = (unsigned short)f2bf(ov);
                    q += __shfl_xor(q, 1); q += __shfl_xor(q, 2); q += __shfl_xor(q, 4); q += __shfl_xor(q, 8);
                    if (fr == 0) osq[t * 8 + wave] = q; }
            HG_BAR();
#pragma unroll
            for (int j = 0; j < 2; ++j) { const int ch = tid + 512 * j, row = ch >> 4, c16 = ch & 15;
                const f32x4 qa = *(const LAS f32x4*)(osq + row * 8), qb = *(const LAS f32x4*)(osq + row * 8 + 4);
                const float rs = 1.0f / sqrtf((((qa[0] + qa[1]) + (qa[2] + qa[3])) + ((qb[0] + qb[1]) + (qb[2] + qb[3]))) * (1.0f / 128.0f) + 1e-6f);
                const u32x4 ow = *(const LAS u32x4*)(lds + HL_OUT + row * HS + 16 * c16);
                float ov[8], gv[8]; unpack8(ow, ov); unpack8(gch[j], gv);
                u32x4 w; w.x = pk2(ov[0] * rs * on0[0] * gv[0], ov[1] * rs * on0[1] * gv[1]); w.y = pk2(ov[2] * rs * on0[2] * gv[2], ov[3] * rs * on0[3] * gv[3]);
                w.z = pk2(ov[4] * rs * on1[0] * gv[4], ov[5] * rs * on1[1] * gv[5]); w.w = pk2(ov[6] * rs * on1[2] * gv[6], ov[7] * rs * on1[3] * gv[7]);
                *(u32x4*)(Ob + (R0 + row) * 1024 + hc + 8 * c16) = w; }
            if (c < HG_NCH - 1) HG_LOAD_G(R0 + 64);
        }
    }
    if (!FULL) {
        float* sp = SLOC + ((size_t)(bh * 4 + sc) << 14) + (16 * wave + fr) * 4;
#pragma unroll
        for (int kt = 0; kt < 8; ++kt) *(f32x4*)(sp + (4 * kt + fq) * 512) = S[kt];
        if (seg == 0) *(f32x2v*)(DTOT + (bh * 4 + sc) * 128 + 2 * kp) = (f32x2v){dprod0, dprod1};
    }
    HG_BAR();
#undef HG_LOAD_E
#undef HG_LOAD_G
}
__device__ __forceinline__ void hgrn_scan(const Ptrs& P, int gw, int NGW, int lane) {
    float* SLOC = (float*)((unsigned char*)P.out + 64 * MiB); const float* DTOT = (const float*)(P.ws + WS_DTOT);
    for (int it = gw; it < 64 * 64; it += NGW) {
        const int bh = it >> 6, e0 = (it & 63) * 256 + lane * 4, k0 = (e0 >> 9) * 4;
        f32x4 v[3], d[3];
#pragma unroll
        for (int s = 0; s < 3; ++s) { v[s] = *(const f32x4*)(SLOC + ((size_t)(bh * 4 + s) << 14) + e0); d[s] = *(const f32x4*)(DTOT + (bh * 4 + s) * 128 + k0); }
        f32x4 run = v[0];
#pragma unroll
        for (int s = 1; s < 3; ++s) { run = run * d[s] + v[s]; *(f32x4*)(SLOC + ((size_t)(bh * 4 + s) << 14) + e0) = run; }
    }
}
#ifndef MK_ONE_LAUNCH
#define MK_ONE_LAUNCH 1
#endif
#ifndef MK_XCD_BAR
#define MK_XCD_BAR 1
#endif
constexpr int N_PHASES = 18;
constexpr int FIN_LDS_OFF = 131072 + 4096;
constexpr int RS_TAB_OFF = 131072 + 1024;
struct Args { Ptrs p; int ph_lo, ph_hi; };
__global__ void __launch_bounds__(NTHREADS, 2) fwd_kernel(Args args) {
    extern __shared__ __attribute__((aligned(16))) unsigned char lds_raw[];
    LAS unsigned char* lds = (LAS unsigned char*)lds_raw;
    const Ptrs& P = args.p;
    const int tid = threadIdx.x, lane = tid & 63, wave = __builtin_amdgcn_readfirstlane(tid >> 6);
    const int G = gridDim.x, bx = blockIdx.x;
    const int vcu = (G % 8 == 0) ? (bx % 8) * (G / 8) + bx / 8 : bx;
    const int gw = vcu * NWAVES + wave, NGW = G * NWAVES;
    unsigned char* ws = P.ws;
    bf16_t* H = (bf16_t*)(ws + WS_H); bf16_t* HID = (bf16_t*)(ws + WS_HID); float* SS = (float*)(ws + WS_SS);
    const int lo = args.ph_lo, hi = args.ph_hi;
#if MK_XCD_BAR
    volatile LAS unsigned* MISC = (volatile LAS unsigned*)(lds + LDS_BYTES - 256);
    if (tid < 32) MISC[tid] = 0u;
#if MK_ONE_LAUNCH
    if (bx == 0) { unsigned* cw = (unsigned*)ws + 4096; for (int i = tid; i < 12288; i += NTHREADS) __hip_atomic_store(cw + i, 0u, __ATOMIC_RELAXED, __HIP_MEMORY_SCOPE_AGENT); }
    __syncthreads();
    XcdBarrier bar; bar.bar = (unsigned*)ws + 4096; bar.x = xb_xcc_id(); bar.st = MISC + 8;
#else
    __syncthreads();
    XcdBarrier bar = xcd_barrier_post((unsigned*)ws + 4096, MISC + 8);
#endif
#endif
#define IN(k) (lo <= (k) && (k) < hi)
#if MK_XCD_BAR
#define SEAM(k) do { if (IN(k) && IN((k) + 1)) { if ((k) == 0) { cg::this_grid().sync(); if (tid == 0) (void)xb_add(&bar.bar[XB_XCNT(bar.x)], 1u); } else xcd_barrier(bar); } } while (0)
#else
#define SEAM(k) do { if (IN(k) && IN((k) + 1)) { cg::this_grid().sync(); } } while (0)
#endif
#define SSB(i) (SS + (size_t)(i) * M * 16)
#define GEMM_GU(f, ssi) do { pg8::Gemm g{H, (const bf16_t*)(ws + WS_GU) + (size_t)(f) * 5632 * 1024, M, 5632, D}; pg8::StaticOrder S; S.init(M, 5632, G, bx); \
        pg8::EpiSwiGLU E{HID, pg8::rs_table_build(lds + RS_TAB_OFF, SSB(ssi), S, tid), FF}; pg8::gemm_phase<pg8::EpiSwiGLU, pg8::StaticOrder, true, true>(lds, g, S, E); } while (0)
#define GEMM_DN(f, sso) do { pg8::Gemm g{HID, (const bf16_t*)(ws + WS_DN) + (size_t)(f) * 1024 * 2816, M, D, FF}; pg8::StaticOrder S; S.init(M, D, G, bx); \
        pg8::EpiResid<false> E{H, SSB(sso), 0.5f, nullptr}; pg8::gemm_phase<pg8::EpiResid<false>, pg8::StaticOrder, true, true>(lds, g, S, E); } while (0)

    if (IN(0)) { p0_prologue(P, lds, gw, NGW, wave, lane); }
#ifdef PROBE_P0
    __syncthreads(); if (IN(0)) { p0_prologue(P, lds, gw, NGW, wave, lane); }
#endif
    SEAM(0);
#ifdef PROBE_EARLYBAR
    xcd_barrier(bar);
#endif
    if (IN(1)) { GEMM_GU(0, 0); }
#ifdef PROBE_LATE_WG
    if (bx == PROBE_LATE_WG) { for (int d_ = 0; d_ < 400; ++d_) __builtin_amdgcn_s_sleep(127); }
#endif
#ifdef PROBE_BAR10
#if PROBE_BAR10 == 2
    asm volatile("s_waitcnt vmcnt(0)" ::: "memory"); __syncthreads();
    if (tid == 0) { __builtin_amdgcn_fence(__ATOMIC_RELEASE, "agent"); asm volatile("s_waitcnt vmcnt(0)" ::: "memory"); __builtin_amdgcn_fence(__ATOMIC_ACQUIRE, "agent"); asm volatile("s_waitcnt vmcnt(0)" ::: "memory"); }
    __syncthreads();
#elif PROBE_BAR10 == 4
    cg::this_grid().sync();
#elif PROBE_BAR10 == 3
    asm volatile("s_waitcnt vmcnt(0)" ::: "memory"); __syncthreads(); __syncthreads();
#else
    for (int i_ = 0; i_ < PROBE_BAR10; ++i_) { xcd_barrier(bar); }
#endif
#endif
#ifdef PROBE_GU2X
    xcd_barrier(bar); if (IN(1)) { GEMM_GU(0, 0); }
#endif
    SEAM(1);
#ifdef PROBE_DN2X
    if (IN(2)) { pg8::Gemm g{HID, (const bf16_t*)(ws + WS_DN), M, D, FF}; pg8::StaticOrder S; S.init(M, D, G, bx);
        pg8::EpiResid<false> E{H, SSB(1), 0.0f, nullptr}; pg8::gemm_phase<pg8::EpiResid<false>, pg8::StaticOrder, true, true>(lds, g, S, E); }
    xcd_barrier(bar);
#endif
    if (IN(2)) { GEMM_DN(0, 1); }
    SEAM(2);
    if (IN(3)) { pg8::Gemm g{H, (const bf16_t*)(ws + WS_ABIN), M, 3072, D}; pg8::StaticOrder S; S.init(M, 3072, G, bx);
        pg8::EpiProjAB E{(bf16_t*)(ws + WS_PROJ), pg8::rs_table_build(lds + RS_TAB_OFF, SSB(1), S, tid), QSCALE}; pg8::gemm_phase<pg8::EpiProjAB, pg8::StaticOrder, true, true>(lds, g, S, E); }
    SEAM(3);
    if (IN(4)) { mix0_phase(P, lds, gw, NGW, wave, lane); }
#ifdef PROBE_P4
    if (IN(4)) { mix0_phase(P, lds, gw, NGW, wave, lane); }
#endif
    SEAM(4);
    if (IN(5)) { pg8::Gemm g{(const bf16_t*)(ws + WS_Y), (const bf16_t*)(ws + WS_ABOUT), M, D, D}; pg8::StaticOrder S; S.init(M, D, G, bx);
        pg8::EpiResid<false> E{H, SSB(2), 1.0f, nullptr}; pg8::gemm_phase<pg8::EpiResid<false>, pg8::StaticOrder, true, true>(lds, g, S, E); }
    SEAM(5);
#ifdef PROBE_BAR_AT5
    xcd_barrier(bar);
#endif
#ifdef PROBE_IDLE
    { const unsigned long long t0_ = __builtin_amdgcn_s_memrealtime(); while (__builtin_amdgcn_s_memrealtime() - t0_ < 100000ull) __builtin_amdgcn_s_sleep(64); }
#endif
    if (IN(6)) { GEMM_GU(1, 2); }
    SEAM(6);
#ifdef PROBE_BAR_AT6
    xcd_barrier(bar);
#endif
    if (IN(7)) { GEMM_DN(1, 3); }
    SEAM(7);
    if (IN(8)) { GEMM_GU(2, 3); }
    SEAM(8);
    if (IN(9)) { GEMM_DN(2, 4); }
    SEAM(9);
    if (IN(10)) { pg8::Gemm g{H, (const bf16_t*)(ws + WS_CIN), M, 4096, D}; pg8::StaticOrder S; S.init(M, 4096, G, bx);
        pg8::EpiProjC E{(bf16_t*)(ws + WS_QS), (float*)(ws + WS_LF), (bf16_t*)(ws + WS_IV), (bf16_t*)(ws + WS_GS), pg8::rs_table_build(lds + RS_TAB_OFF, SSB(4), S, tid), P.in[14]};
        pg8::gemm_phase<pg8::EpiProjC, pg8::StaticOrder, true, true>(lds, g, S, E); }
    SEAM(10);
    if (IN(11)) { const int bh = bx >> 2, sc = bx & 3; if (sc < 3 && bh < 64) hgrn_unit<false>(P, lds, bh, sc, tid, wave, lane); }
    SEAM(11);
    if (IN(13)) { const int bh = bx >> 2, sc = bx & 3; if (bh < 64) hgrn_unit<true>(P, lds, bh, sc, tid, wave, lane); }
    SEAM(13);
    if (IN(14)) { pg8::Gemm g{(const bf16_t*)P.out, (const bf16_t*)(ws + WS_COUT), M, D, D}; pg8::StaticOrder S; S.init(M, D, G, bx);
        pg8::EpiResid<false> E{H, SSB(5), 1.0f, nullptr}; pg8::gemm_phase<pg8::EpiResid<false>, pg8::StaticOrder, true, true>(lds, g, S, E); }
    SEAM(14);
    if (IN(15)) { GEMM_GU(3, 5); }
    SEAM(15);
    if (IN(16)) { pg8::Gemm g{HID, (const bf16_t*)(ws + WS_DN) + (size_t)3 * 1024 * 2816, M, D, FF}; pg8::StaticOrder S; S.init(M, D, G, bx);
        pg8::EpiFinalNorm E{H, P.out, P.in[17], 0.5f, SSB(6), (unsigned*)ws + 8192, lds + FIN_LDS_OFF};
        pg8::gemm_phase<pg8::EpiFinalNorm, pg8::StaticOrder, true, true>(lds, g, S, E); }
    if (IN(18)) {
        for (int m = gw; m < M; m += NGW) { const u32x2* hr = (const u32x2*)(H + (size_t)m * D) + lane; f32x4* orow = (f32x4*)(P.out + (size_t)m * D) + lane;
#pragma unroll
            for (int j = 0; j < 4; ++j) { const u32x2 w = hr[64 * j]; orow[64 * j] = (f32x4){pg8::bf_lo(w.x), pg8::bf_hi(w.x), pg8::bf_lo(w.y), pg8::bf_hi(w.y)}; } }
    }
}

extern "C" void kernel_launch(void* const* d_in, const int* in_sizes, int n_in, void* d_out, int out_size, void* d_ws, size_t ws_size, hipStream_t stream) {
    static int grid = 0;
    if (grid == 0) {
        if (n_in != 18 || in_sizes[0] != M * D || out_size != M * D || ws_size < WS_END) { fprintf(stderr, "kernel_launch: unexpected shapes (n_in %d, in0 %d, out %d, ws %zu)\n", n_in, n_in > 0 ? in_sizes[0] : -1, out_size, ws_size); grid = -1; return; }
        int dev = 0, cus = 0, per_cu = 0;
        hipGetDevice(&dev); hipDeviceGetAttribute(&cus, hipDeviceAttributeMultiprocessorCount, dev);
        if (hipFuncSetAttribute((const void*)fwd_kernel, hipFuncAttributeMaxDynamicSharedMemorySize, LDS_BYTES) != hipSuccess) { fprintf(stderr, "kernel_launch: hipFuncSetAttribute failed\n"); grid = -1; return; }
        if (hipOccupancyMaxActiveBlocksPerMultiprocessor(&per_cu, (const void*)fwd_kernel, NTHREADS, LDS_BYTES) != hipSuccess || per_cu < 1) { fprintf(stderr, "kernel_launch: occupancy query gives %d\n", per_cu); per_cu = 1; }
        (void)hipGetLastError();
        grid = cus;
    }
    if (grid < 0) return;
    Args a{};
    for (int i = 0; i < 18; ++i) a.p.in[i] = (const float*)d_in[i];
    a.p.out = (float*)d_out; a.p.ws = (unsigned char*)d_ws;
#if MK_ONE_LAUNCH
    a.ph_lo = 0; a.ph_hi = N_PHASES;
    void* kargs[] = {&a};
    hipError_t e = hipLaunchCooperativeKernel((const void*)fwd_kernel, dim3(grid), dim3(NTHREADS), kargs, LDS_BYTES, stream);
    if (e != hipSuccess) fprintf(stderr, "kernel_launch: cooperative launch failed: %s (grid %d)\n", hipGetErrorString(e), grid);
#else
#ifdef DBG_STOP
    for (int ph = 0; ph <= DBG_STOP; ++ph) { a.ph_lo = ph; a.ph_hi = ph + 1; hipLaunchKernelGGL(fwd_kernel, dim3(grid), dim3(NTHREADS), LDS_BYTES, stream, a); }
    a.ph_lo = 18; a.ph_hi = 19; hipLaunchKernelGGL(fwd_kernel, dim3(grid), dim3(NTHREADS), LDS_BYTES, stream, a);
#else
    for (int ph = 0; ph < N_PHASES; ++ph) { a.ph_lo = ph; a.ph_hi = ph + 1; hipLaunchKernelGGL(fwd_kernel, dim3(grid), dim3(NTHREADS), LDS_BYTES, stream, a); }
#endif
#endif
}
```
